# Optimizing an MI355X kernel written in HIP

```python
import jax, jax.numpy as jnp
from jax import lax
import numpy as np

D_MODEL = 1024
BATCH = 32
SEQ = 256
DEPTH = 2
DEC_BATCH = 4
DEC_SEQ = 4096
PAST_LEN = 512

GRID_W = 64
D_FF = 4 * D_MODEL
EPS = 1e-6
D_RNN = D_MODEL // 2
RNN_BLOCKS = 8
RNN_BLOCK = D_RNN // RNN_BLOCKS
CONV_W = 4
LRU_C = 8.0
D_POOL = D_MODEL // 2
POOL_WINDOWS = (2, 4, 8, 16)
POOL_GROUP = D_POOL // len(POOL_WINDOWS)
N_HEADS = 16
QK_NOPE = 64
QK_ROPE = 32
V_HEAD = 64
Q_RANK = 384
KV_RANK = 256
ROPE_BASE = 10000.0
Q_BLOCK = 128

kernel_name = "hybrid_rglru_pool_mla_dit_step"


def rms_norm(x, g):
    xf = x.astype(jnp.float32)
    y = xf * lax.rsqrt(jnp.mean(xf * xf, axis=-1, keepdims=True) + EPS)
    return (y * g.astype(jnp.float32)).astype(x.dtype)


def adaln(cond, w_mod, b_mod):
    m = jax.nn.silu(cond) @ w_mod + b_mod
    return [t[:, None, :] for t in jnp.split(m, 6, axis=-1)]


def modulate(x, g, shift, scale):
    return rms_norm(x, g) * (1 + scale) + shift


def sq_relu_mlp(h, w1, w2):
    return jnp.square(jax.nn.relu(h @ w1)) @ w2


def dwconv_centred(x, w, b):
    S = x.shape[1]
    left = CONV_W // 2
    xp = jnp.pad(x, ((0, 0), (left, CONV_W - 1 - left), (0, 0)))
    return b + sum(xp[:, k:k + S] * w[k] for k in range(CONV_W))


def rglru_scan(xc, w_a, b_a, w_i, b_i, lam, h0, reverse):
    B, S, _ = xc.shape
    xf = xc.astype(jnp.float32)
    xb = xf.reshape(B, S, RNN_BLOCKS, RNN_BLOCK)
    r = jax.nn.sigmoid(jnp.einsum('bsni,nij->bsnj', xb, w_a).reshape(B, S, D_RNN) + b_a)
    i = jax.nn.sigmoid(jnp.einsum('bsni,nij->bsnj', xb, w_i).reshape(B, S, D_RNN) + b_i)
    log_a = LRU_C * r * jax.nn.log_sigmoid(lam.astype(jnp.float32))
    a = jnp.exp(log_a)
    u = jnp.sqrt(-jnp.expm1(2.0 * log_a)) * (i * xf)
    if reverse:
        a, u = jnp.flip(a, axis=1), jnp.flip(u, axis=1)
    u = u.at[:, 0].add(a[:, 0] * h0.astype(jnp.float32))

    def combine(lhs, rhs):
        a1, b1 = lhs
        a2, b2 = rhs
        return a1 * a2, a2 * b1 + b2

    _, h = lax.associative_scan(combine, (a, u), axis=1)
    h_last = h[:, -1]
    if reverse:
        h = jnp.flip(h, axis=1)
    return h, h_last


def multiscale_pool(xp, w_pool, s_pool):
    B, S, _ = xp.shape
    xf = xp.astype(jnp.float32)
    cs = jnp.pad(jnp.cumsum(xf, axis=1), ((0, 0), (1, 0), (0, 0)))
    t = jnp.arange(S)
    outs = []
    for gi, w in enumerate(POOL_WINDOWS):
        left = w // 2
        right = w - 1 - left
        lo = jnp.maximum(t - left, 0)
        hi = jnp.minimum(t + right, S - 1) + 1
        sl = slice(gi * POOL_GROUP, (gi + 1) * POOL_GROUP)
        csg = cs[..., sl]
        mean = (csg[:, hi] - csg[:, lo]) / (hi - lo).astype(jnp.float32)[None, :, None]
        outs.append(mean - xf[..., sl])
    d = jnp.stack(outs, axis=2)
    y = jnp.einsum('bsgc,gcd->bsgd', d, w_pool).reshape(B, S, D_POOL)
    return (y * s_pool).astype(xp.dtype)


def lru_pool_mixer(h, p, h0_fwd, h0_bwd):
    z = h @ p['w_in']
    xr, gate, xpool = jnp.split(z, [D_RNN, 2 * D_RNN], axis=-1)
    xc = dwconv_centred(xr, p['conv_w'], p['conv_b'])
    hf, hf_last = rglru_scan(xc, p['lru_w_a'][0], p['lru_b_a'][0], p['lru_w_i'][0], p['lru_b_i'][0],
                             p['lru_lam'][0], h0_fwd, False)
    hb, hb_last = rglru_scan(xc, p['lru_w_a'][1], p['lru_b_a'][1], p['lru_w_i'][1], p['lru_b_i'][1],
                             p['lru_lam'][1], h0_bwd, True)
    y_rnn = (hf + hb).astype(h.dtype) * jax.nn.gelu(gate)
    y_pool = multiscale_pool(xpool, p['pool_w'], p['pool_scale'])
    out = jnp.concatenate([y_rnn, y_pool], axis=-1) @ p['w_out']
    return out, jnp.stack([hf_last, hb_last], axis=1)


def axial_angles(S):
    rows = S // GRID_W
    row = jnp.broadcast_to(jnp.arange(rows)[:, None], (rows, GRID_W)).reshape(-1).astype(jnp.float32)
    col = jnp.broadcast_to(jnp.arange(GRID_W)[None, :], (rows, GRID_W)).reshape(-1).astype(jnp.float32)
    half = QK_ROPE // 2
    inv = ROPE_BASE ** (-jnp.arange(0, half, 2, dtype=jnp.float32) / half)
    return row[:, None] * inv, col[:, None] * inv


def rope_rotate(x, ang):
    x1, x2 = jnp.split(x, 2, axis=-1)
    cos, sin = jnp.cos(ang), jnp.sin(ang)
    return jnp.concatenate([x1 * cos - x2 * sin, x2 * cos + x1 * sin], axis=-1)


def rope2d(x, ang_r, ang_c):
    xf = x.astype(jnp.float32)
    half = QK_ROPE // 2
    return jnp.concatenate([rope_rotate(xf[..., :half], ang_r),
                            rope_rotate(xf[..., half:], ang_c)], axis=-1).astype(x.dtype)


def mla_project(h, p):
    B, S, _ = h.shape
    z = h @ p['w_in']
    cq, ckv, kpe = jnp.split(z, [Q_RANK, Q_RANK + KV_RANK], axis=-1)
    q = (rms_norm(cq, p['g_q']) @ p['w_qb']).reshape(B, S, N_HEADS, QK_NOPE + QK_ROPE)
    return q[..., :QK_NOPE], q[..., QK_NOPE:], rms_norm(ckv, p['g_kv']), kpe


def mla_expand(ckv, w_kvb):
    B, S, _ = ckv.shape
    kv = (ckv @ w_kvb).reshape(B, S, N_HEADS, QK_NOPE + V_HEAD)
    return kv[..., :QK_NOPE], kv[..., QK_NOPE:]


def attend_blocked(q_nope, q_pe, k_nope, k_pe, v):
    B, S, H, _ = q_nope.shape
    nb = S // Q_BLOCK
    scale = (QK_NOPE + QK_ROPE) ** -0.5

    def block(args):
        qn, qp = args
        s = (jnp.einsum('bqhd,bkhd->bhqk', qn, k_nope)
             + jnp.einsum('bqhr,bkr->bhqk', qp, k_pe)).astype(jnp.float32) * scale
        pr = jax.nn.softmax(s, axis=-1).astype(v.dtype)
        return jnp.einsum('bhqk,bkhd->bqhd', pr, v)

    def to_blocks(t):
        return jnp.moveaxis(t.reshape(B, nb, Q_BLOCK, *t.shape[2:]), 1, 0)

    o = lax.map(block, (to_blocks(q_nope), to_blocks(q_pe)))
    return jnp.moveaxis(o, 0, 1).reshape(B, S, H * V_HEAD)


def mla_context(h, p):
    q_nope, q_pe, ckv, kpe = mla_project(h, p)
    k_nope, v = mla_expand(ckv, p['w_kvb'])
    o = attend_blocked(q_nope, q_pe, k_nope, kpe, v)
    return o @ p['w_out'], ckv, kpe


def mla_latent(h, p, ctx_ckv, ctx_kpe):
    S = h.shape[1]
    q_nope, q_pe, ckv, kpe = mla_project(h, p)
    ang_r, ang_c = axial_angles(S)
    q_pe = rope2d(q_pe, ang_r[:, None, :], ang_c[:, None, :])
    kpe = rope2d(kpe, ang_r, ang_c)
    k_lat, v_lat = mla_expand(ckv, p['w_kvb'])
    k_ctx, v_ctx = mla_expand(ctx_ckv.astype(h.dtype), p['w_kvb'])
    k_nope = jnp.concatenate([k_lat, k_ctx], axis=1)
    k_pe = jnp.concatenate([kpe, ctx_kpe.astype(h.dtype)], axis=1)
    v = jnp.concatenate([v_lat, v_ctx], axis=1)
    o = attend_blocked(q_nope, q_pe, k_nope, k_pe, v)
    return o @ p['w_out']


def setup_inputs(seed: int = 0) -> dict:
    key = jax.random.key(seed)
    ks = iter(jax.random.split(key, 64))
    nrm = lambda shape, s: jax.random.normal(next(ks), shape, jnp.float32) * s
    gain = lambda n: 1.0 + nrm((n,), 0.02)
    D = D_MODEL
    a0 = jax.random.uniform(next(ks), (2, D_RNN), jnp.float32, 0.9, 0.999)
    pa = a0 ** (1.0 / LRU_C)
    lam = jnp.log(pa) - jnp.log1p(-pa)
    return {
        "x_prompt": nrm((BATCH, SEQ, D), 1.0),
        "x_sample": nrm((DEC_BATCH, DEC_SEQ, D), 1.0),
        "state_l0_lru": nrm((DEC_BATCH, 2, D_RNN), 1.0),
        "cache_l1_ckv": nrm((DEC_BATCH, PAST_LEN, KV_RANK), 1.0),
        "cache_l1_kpe": nrm((DEC_BATCH, PAST_LEN, QK_ROPE), 1.0),
        "c": nrm((DEC_BATCH, D), 1.0),
        "c_ctx": nrm((D,), 1.0),
        "l0_w_mod": nrm((D, 6 * D), D ** -0.5),
        "l0_b_mod": nrm((6 * D,), 0.02),
        "l0_g_mix": gain(D),
        "l0_g_ffn": gain(D),
        "l0_w_in": nrm((D, 2 * D_RNN + D_POOL), D ** -0.5),
        "l0_conv_w": nrm((CONV_W, D_RNN), CONV_W ** -0.5),
        "l0_conv_b": nrm((D_RNN,), 0.02),
        "l0_lru_w_a": nrm((2, RNN_BLOCKS, RNN_BLOCK, RNN_BLOCK), RNN_BLOCK ** -0.5),
        "l0_lru_b_a": nrm((2, D_RNN), 0.02),
        "l0_lru_w_i": nrm((2, RNN_BLOCKS, RNN_BLOCK, RNN_BLOCK), RNN_BLOCK ** -0.5),
        "l0_lru_b_i": nrm((2, D_RNN), 0.02),
        "l0_lru_lam": lam,
        "l0_pool_w": nrm((len(POOL_WINDOWS), POOL_GROUP, POOL_GROUP), POOL_GROUP ** -0.5),
        "l0_pool_scale": gain(D_POOL),
        "l0_w_out": nrm((D_RNN + D_POOL, D), (D_RNN + D_POOL) ** -0.5),
        "l0_ffn_w1": nrm((D, D_FF), D ** -0.5),
        "l0_ffn_w2": nrm((D_FF, D), D_FF ** -0.5),
        "l1_w_mod": nrm((D, 6 * D), D ** -0.5),
        "l1_b_mod": nrm((6 * D,), 0.02),
        "l1_g_mix": gain(D),
        "l1_g_ffn": gain(D),
        "l1_w_in": nrm((D, Q_RANK + KV_RANK + QK_ROPE), D ** -0.5),
        "l1_g_q": gain(Q_RANK),
        "l1_w_qb": nrm((Q_RANK, N_HEADS * (QK_NOPE + QK_ROPE)), Q_RANK ** -0.5),
        "l1_g_kv": gain(KV_RANK),
        "l1_w_kvb": nrm((KV_RANK, N_HEADS * (QK_NOPE + V_HEAD)), KV_RANK ** -0.5),
        "l1_w_out": nrm((N_HEADS * V_HEAD, D), (N_HEADS * V_HEAD) ** -0.5),
        "l1_ffn_w1": nrm((D, D_FF), D ** -0.5),
        "l1_ffn_w2": nrm((D_FF, D), D_FF ** -0.5),
        "g_final": gain(D),
    }


def reference(x_prompt, x_sample, state_l0_lru, cache_l1_ckv, cache_l1_kpe, c, c_ctx,
              l0_w_mod, l0_b_mod, l0_g_mix, l0_g_ffn, l0_w_in, l0_conv_w, l0_conv_b,
              l0_lru_w_a, l0_lru_b_a, l0_lru_w_i, l0_lru_b_i, l0_lru_lam, l0_pool_w, l0_pool_scale,
              l0_w_out, l0_ffn_w1, l0_ffn_w2,
              l1_w_mod, l1_b_mod, l1_g_mix, l1_g_ffn, l1_w_in, l1_g_q, l1_w_qb, l1_g_kv, l1_w_kvb,
              l1_w_out, l1_ffn_w1, l1_ffn_w2, g_final):
    layers = [
        dict(w_mod=l0_w_mod, b_mod=l0_b_mod, g_mix=l0_g_mix, g_ffn=l0_g_ffn, w_in=l0_w_in,
             conv_w=l0_conv_w, conv_b=l0_conv_b, lru_w_a=l0_lru_w_a, lru_b_a=l0_lru_b_a,
             lru_w_i=l0_lru_w_i, lru_b_i=l0_lru_b_i, lru_lam=l0_lru_lam, pool_w=l0_pool_w,
             pool_scale=l0_pool_scale, w_out=l0_w_out, ffn_w1=l0_ffn_w1, ffn_w2=l0_ffn_w2),
        dict(w_mod=l1_w_mod, b_mod=l1_b_mod, g_mix=l1_g_mix, g_ffn=l1_g_ffn, w_in=l1_w_in,
             g_q=l1_g_q, w_qb=l1_w_qb, g_kv=l1_g_kv, w_kvb=l1_w_kvb, w_out=l1_w_out,
             ffn_w1=l1_ffn_w1, ffn_w2=l1_ffn_w2),
    ]
    caches = [(state_l0_lru,), (cache_l1_ckv, cache_l1_kpe)]
    xp, xs = x_prompt, x_sample
    new_state = []
    for l in range(DEPTH):
        p = layers[l]
        mp = adaln(c_ctx[None, :], p['w_mod'], p['b_mod'])
        ms = adaln(c, p['w_mod'], p['b_mod'])
        hp = modulate(xp, p['g_mix'], mp[0], mp[1])
        hs = modulate(xs, p['g_mix'], ms[0], ms[1])
        if l % 2 == 0:
            zeros = jnp.zeros((xp.shape[0], D_RNN), jnp.float32)
            op, st = lru_pool_mixer(hp, p, zeros, zeros)
            st_in = caches[l][0]
            os_, _ = lru_pool_mixer(hs, p, st_in[:, 0], st_in[:, 1])
            new_state.append(st.astype(xp.dtype))
        else:
            op, ckv, kpe = mla_context(hp, p)
            os_ = mla_latent(hs, p, caches[l][0], caches[l][1])
            new_state.append(ckv)
            new_state.append(kpe)
        xp = xp + mp[2] * op
        xs = xs + ms[2] * os_
        xp = xp + mp[5] * sq_relu_mlp(modulate(xp, p['g_ffn'], mp[3], mp[4]), p['ffn_w1'], p['ffn_w2'])
        xs = xs + ms[5] * sq_relu_mlp(modulate(xs, p['g_ffn'], ms[3], ms[4]), p['ffn_w1'], p['ffn_w2'])
    y_prompt = rms_norm(xp, g_final)
    y_sample = rms_norm(xs, g_final)
    new_lru, new_ckv, new_kpe = new_state[0], new_state[1], new_state[2]
    return (y_prompt, y_sample, new_lru, new_ckv, new_kpe)
```

```cpp
#include <hip/hip_runtime.h>
#include <hip/hip_cooperative_groups.h>
#include <cstdio>
#include <cstdint>
namespace cg = cooperative_groups;
#ifndef PROBE_PH
#define PROBE_PH -1
#endif

typedef unsigned short bf16_t;
typedef short bf16x8 __attribute__((ext_vector_type(8)));
typedef short s16x4 __attribute__((ext_vector_type(4)));
typedef float f32x4 __attribute__((ext_vector_type(4)));
typedef float f32x16 __attribute__((ext_vector_type(16)));
typedef unsigned u32x4 __attribute__((ext_vector_type(4)));
typedef unsigned u32x2 __attribute__((ext_vector_type(2)));

constexpr int DM = 1024, MP = 8192, MS = 16384, M = MP + MS, DFF = 4096;
constexpr int SEQ = 256, DSEQ = 4096, PAST = 512, NB_S = 4;
constexpr int KROWS = MP + NB_S * (DSEQ + PAST);
constexpr int SKEYS = DSEQ + PAST;
constexpr int MH = M / 2;
constexpr float EPS = 1e-6f;
constexpr int NPH = 24;

constexpr size_t MiB = 1u << 20;
constexpr size_t WS_MOD = 0;
constexpr size_t WS_ROPE = 256 * 1024;
constexpr size_t WS_LS8 = 260 * 1024;
constexpr size_t WS_SUM = 512 * 1024;
constexpr size_t WS_BAR = 3840 * 1024;
constexpr size_t WS_WB = 4 * MiB;
constexpr size_t WS_R1 = 26 * MiB;
constexpr size_t WS_H = WS_R1;
constexpr size_t WS_Z0 = WS_R1 + 48 * MiB;
constexpr size_t WS_U = WS_R1 + 48 * MiB;
constexpr size_t WS_KV = WS_R1;
constexpr size_t WS_Q = WS_R1 + 104 * MiB;
constexpr size_t WS_Z1 = WS_R1 + 104 * MiB;
constexpr size_t WS_CQN = WS_R1 + 176 * MiB;
constexpr size_t WS_CKVN = WS_R1 + 194 * MiB;
constexpr size_t WS_KPE = WS_R1 + 207 * MiB;
constexpr size_t WS_END = WS_R1 + 209 * MiB;
constexpr size_t W0_IN = 0, W0_OUT = 1572864, W0_W1 = 2621440, W0_W2 = 6815744, W0_G = 11010048, W0_P = 11141120;
constexpr size_t W1_IN = 0, W1_QB = 786432, W1_KVB = 1376256, W1_OUT = 1900544, W1_W1 = 2949120, W1_W2 = 7143424;
constexpr size_t O_Y = 0, O_LRU = 25165824, O_CKV = 25198592, O_KPE = 27295744;

struct Params {
  const float* in[37];
  float* out;
  unsigned char* ws;
  int p_lo, p_hi, coop, pad;
};

typedef const __attribute__((address_space(4))) Params* KP;
extern __shared__ __attribute__((aligned(16))) unsigned char dyn_shm[];
constexpr int LDS_MAIN = 139264;
constexpr int LDS_BYTES = LDS_MAIN + 16;

__device__ __forceinline__ unsigned cvtpk(float lo, float hi) {
  unsigned r; asm volatile("v_cvt_pk_bf16_f32 %0, %1, %2" : "=v"(r) : "v"(lo), "v"(hi)); return r;
}
__device__ __forceinline__ float bf2f(bf16_t b) { return __uint_as_float(((unsigned)b) << 16); }
__device__ __forceinline__ bf16_t f2bf(float f) { return (bf16_t)(cvtpk(f, f) & 0xffffu); }
__device__ __forceinline__ float sigmoidf_(float x) { return 1.f / (1.f + __expf(-x)); }
__device__ __forceinline__ float gelu_tanh(float x) {
  float u = 0.7978845608028654f * (x + 0.044715f * x * x * x);
  float e = __expf(2.f * u);
  float th = 1.f - 2.f / (e + 1.f);
  return 0.5f * x * (1.f + th);
}
__device__ __forceinline__ float lane_xor(float v, int lane, int o) { return __int_as_float(__builtin_amdgcn_ds_bpermute((lane ^ o) << 2, __float_as_int(v))); }
__device__ __forceinline__ float wave_sum(float v, int lane) {
#pragma unroll
  for (int o = 32; o > 0; o >>= 1) v += lane_xor(v, lane, o);
  return v;
}
__device__ __forceinline__ void my_sincos(float a, float& s, float& c) {
  float k = rintf(a * 0.63661977236758134f);
  float r = fmaf(k, -1.5707962513e+00f, a);
  r = fmaf(k, -7.5497894159e-08f, r);
  r = fmaf(k, -5.3903029534e-15f, r);
  float r2 = r * r;
  float sp = r + r * r2 * (-1.6666667163e-01f + r2 * (8.3333337680e-03f + r2 * (-1.9841270114e-04f + r2 * 2.7557314297e-06f)));
  float cp = 1.f + r2 * (-0.5f + r2 * (4.1666667908e-02f + r2 * (-1.3888889225e-03f + r2 * 2.4801587642e-05f)));
  int q = ((int)k) & 3;
  float ss = (q & 1) ? cp : sp, cc = (q & 1) ? sp : cp;
  s = (q & 2) ? -ss : ss;
  c = ((q + 1) & 2) ? -cc : cc;
}
__device__ __forceinline__ int bid_() { int b = blockIdx.x; asm volatile("" : "+s"(b)); return b; }
__device__ __forceinline__ int gdim_() { int g = gridDim.x; asm volatile("" : "+s"(g)); return g; }
__device__ __forceinline__ int tid_() { int t = threadIdx.x; asm volatile("" : "+v"(t)); return t; }
__device__ __forceinline__ int cond_of_row(int row) { return row < MP ? 0 : 1 + ((row - MP) >> 12); }


#define XB_TMO      128
#define XB_XCNT(j)  (256  + 64 * (j))
#define XB_XSUB(j)  (1280 + 64 * (j))
#define XB_XGEN(j)  (2304 + 64 * (j))
#define XB_TOP      3328
#define XB_TOPGEN   3392
#define XCD_BAR_WORDS 3456
#define XB_SPIN_CAP (1u << 20)
#define LAS __attribute__((address_space(3)))
__device__ __forceinline__ unsigned xb_ld(unsigned* p)              { return __hip_atomic_load(p, __ATOMIC_RELAXED, __HIP_MEMORY_SCOPE_AGENT); }
__device__ __forceinline__ unsigned xb_add(unsigned* p, unsigned v) { return __hip_atomic_fetch_add(p, v, __ATOMIC_RELAXED, __HIP_MEMORY_SCOPE_AGENT); }
__device__ __forceinline__ unsigned xb_xcc_id() { return (unsigned)__builtin_amdgcn_s_getreg((3 << 11) | 20) & 0xFu; }
#define XB_SPIN(cond, bar) do { unsigned _sp = 0; while (cond) { __builtin_amdgcn_s_sleep(1); \
    if ((++_sp & 255u) == 0u) { if (xb_ld(&(bar)[XB_TMO])) break; if (_sp > XB_SPIN_CAP) { atomicAdd(&(bar)[XB_TMO], 1u); break; } } } } while (0)
struct XcdBarrier { unsigned* bar; volatile LAS unsigned* st; };
__device__ __forceinline__ XcdBarrier xcd_barrier_post(unsigned* bar, volatile LAS unsigned* st) {
  XcdBarrier b; b.bar = bar; b.st = st;
  if (threadIdx.x == 0) (void)xb_add(&bar[XB_XCNT(xb_xcc_id())], 1u);
  return b;
}
__device__ __forceinline__ void xcd_barrier_complete(unsigned* bar, unsigned x, unsigned& nloc, unsigned& nx) {
  const unsigned G = (unsigned)gdim_();
  unsigned sum, cnt, mine, sp = 0u;
  for (;;) {
    sum = 0u; cnt = 0u; mine = 0u;
#pragma unroll
    for (unsigned j = 0; j < 16; ++j) { const unsigned c = xb_ld(&bar[XB_XCNT(j)]); sum += c; cnt += (c > 0u) ? 1u : 0u; mine = (j == x) ? c : mine; }
    if (sum == G) break;
    __builtin_amdgcn_s_sleep(1);
    if ((++sp & 255u) == 0u) { if (xb_ld(&bar[XB_TMO])) break; if (sp > XB_SPIN_CAP) { atomicAdd(&bar[XB_TMO], 1u); break; } }
  }
  nloc = mine > 0u ? mine : 1u; nx = cnt > 0u ? cnt : 1u;
}
__device__ __forceinline__ void xcd_barrier(const XcdBarrier& b) {
  asm volatile("s_waitcnt vmcnt(0)" ::: "memory");
  __syncthreads();
  if (threadIdx.x == 0) {
    unsigned* bar = b.bar; unsigned bx = xb_xcc_id(); asm volatile("" : "+s"(bx));
    __builtin_amdgcn_s_waitcnt(0);
    unsigned nloc = b.st[0], nx = b.st[1];
    if (nloc == 0u) { xcd_barrier_complete(bar, bx, nloc, nx); b.st[0] = nloc; b.st[1] = nx; }
    const unsigned old = xb_add(&bar[XB_XSUB(bx)], 1u);
    const unsigned gen = old / nloc;
    if (old + 1u == (gen + 1u) * nloc) {
      __builtin_amdgcn_fence(__ATOMIC_RELEASE, "agent");
      asm volatile("s_waitcnt vmcnt(0)" ::: "memory");
      const unsigned og = xb_add(&bar[XB_TOP], 1u);
      const unsigned tg = og / nx;
      if (og + 1u == (tg + 1u) * nx) xb_add(&bar[XB_TOPGEN], 1u);
      else XB_SPIN(xb_ld(&bar[XB_TOPGEN]) == tg, bar);
      __builtin_amdgcn_fence(__ATOMIC_ACQUIRE, "agent");
      xb_add(&bar[XB_XGEN(bx)], 1u);
      asm volatile("s_waitcnt vmcnt(0)" ::: "memory");
    } else {
      XB_SPIN(xb_ld(&bar[XB_XGEN(bx)]) == gen, bar);
      __builtin_amdgcn_fence(__ATOMIC_ACQUIRE, "agent");
      asm volatile("s_waitcnt vmcnt(0)" ::: "memory");
    }
  }
  __syncthreads();
}

constexpr int BM = 256, BK = 64, HALF = 128, HT = HALF * BK, NXCD = 8, WGM = 8;
__device__ __forceinline__ int lds_byte(int r, int c) {
  int st = (r >> 4) * 2 + (c >> 5), rr = r & 15, cc = c & 31, ob = rr * 64 + cc * 2;
  return st * 1024 + (ob ^ (((ob >> 9) & 1) << 5));
}
__device__ __forceinline__ void stage_rc(int b, int& R, int& C) {
  int st = b / 1024, sb = b % 1024, swz = sb ^ (((sb >> 9) & 1) << 5);
  R = (st >> 1) * 16 + swz / 64; C = (st & 1) * 32 + (swz % 64) / 2;
}

struct GemmDesc {
  const bf16_t* A; const bf16_t* Bt; int lda, ldb, Mrows, N, K;
  int mode;
  void* out; int ldc;
  const float* src0; const float* src1; const float* gate; int row_off; int dry;
};

__device__ __forceinline__ void gemm_epi(const GemmDesc& g, int row, int col, f32x4 v) {
#if PROBE_PH >= 0
  if (g.dry) return;
#endif
  if (g.mode == 0) {
    u32x2 w; w.x = cvtpk(v[0], v[1]); w.y = cvtpk(v[2], v[3]);
    *(u32x2*)((bf16_t*)g.out + (size_t)row * g.ldc + col) = w;
  } else if (g.mode == 1) {
    float a = fmaxf(v[0], 0.f), b = fmaxf(v[1], 0.f), c = fmaxf(v[2], 0.f), d = fmaxf(v[3], 0.f);
    u32x2 w; w.x = cvtpk(a * a, b * b); w.y = cvtpk(c * c, d * d);
    *(u32x2*)((bf16_t*)g.out + (size_t)row * g.ldc + col) = w;
  } else if (g.mode == 2) {
    int rg = row + g.row_off;
    const float* sp = rg < MP ? g.src0 + (size_t)rg * DM + col : g.src1 + (size_t)(rg - MP) * DM + col;
    f32x4 x = *(const f32x4*)sp;
    f32x4 gt = *(const f32x4*)(g.gate + cond_of_row(rg) * 6144 + col);
    *(f32x4*)((float*)g.out + (size_t)rg * DM + col) = x + gt * v;
  } else {
    *(f32x4*)((float*)g.out + (size_t)row * g.ldc + col) = v;
  }
}

template <int MF>
__device__ __forceinline__ void gemm_tile(const GemmDesc& g, int brow, int bcol) {
  constexpr int AH = MF * 32;
  bf16_t* shm = (bf16_t*)dyn_shm;
  const bf16_t* A = g.A; const bf16_t* Bt = g.Bt; const int lda = g.lda, ldb = g.ldb, K = g.K;
#define SA(b,h) (shm+((b)*2+(h))*HT)
#define SB(b,h) (shm+(4+(b)*2+(h))*HT)
#define STAGE(P,BASE,LD,VO,br,kt) do{const unsigned char* _ub=(const unsigned char*)(BASE)+((size_t)(br)*(LD)+(size_t)(kt)*BK)*2; \
    unsigned _vo=VO; asm volatile("":"+v"(_vo)); \
    __builtin_amdgcn_global_load_lds((const unsigned*)(_ub+_vo), (__attribute__((address_space(3))) unsigned*)((unsigned char*)(P)+tid*16),16,0,0); \
    __builtin_amdgcn_global_load_lds((const unsigned*)(_ub+(size_t)(LD)*128+_vo), (__attribute__((address_space(3))) unsigned*)((unsigned char*)(P)+tid*16+8192),16,0,0);}while(0)
#define LDA(dst,b,h) for(int m=0;m<MF;++m)for(int k=0;k<2;++k) \
    dst[m][k]=*reinterpret_cast<const bf16x8*>((char*)SA(b,h)+lds_byte(wr*(MF*16)+m*16+fr,k*32+fq*8))
#define LDB(dst,b,h) for(int n=0;n<2;++n)for(int k=0;k<2;++k) \
    dst[n][k]=*reinterpret_cast<const bf16x8*>((char*)SB(b,h)+lds_byte(wc*32+n*16+fr,k*32+fq*8))
#define MMA(ai,bj,At,Bt_) do{__builtin_amdgcn_s_setprio(1); \
    for(int m=0;m<MF;++m)for(int n=0;n<2;++n)for(int k=0;k<2;++k) \
      acc[ai][bj][m][n]=__builtin_amdgcn_mfma_f32_16x16x32_bf16(Bt_[n][k],At[m][k],acc[ai][bj][m][n],0,0,0); \
    __builtin_amdgcn_s_setprio(0);}while(0)
#define WAIT_V(n) asm volatile("s_waitcnt vmcnt(" #n ")":::"memory")
#define WAIT_L(n) asm volatile("s_waitcnt lgkmcnt(" #n ")":::"memory")
#define BAR __builtin_amdgcn_s_barrier()
#define SCHED __builtin_amdgcn_sched_barrier(0)
  const int tid = tid_();
  const int wid = __builtin_amdgcn_readfirstlane(tid >> 6), lane = tid & 63, wr = wid >> 2, wc = wid & 3, fr = lane & 15, fq = lane >> 4;
  unsigned voA, voB;
  { int r_, c_; stage_rc(tid * 16, r_, c_); voA = (unsigned)(r_ * lda + c_) * 2u; voB = (unsigned)(r_ * ldb + c_) * 2u; }
  f32x4 acc[2][2][MF][2] = {};
  bf16x8 At[MF][2], B0[2][2], B1[2][2];
  const int nt = K / BK;
  __syncthreads();
  STAGE(SB(0,0),Bt,ldb,voB,bcol,0); STAGE(SA(0,0),A,lda,voA,brow,0);
  STAGE(SB(0,1),Bt,ldb,voB,bcol+HALF,0); STAGE(SA(0,1),A,lda,voA,brow+AH,0);
  if(wr==1)BAR;
  WAIT_V(4); BAR;
  STAGE(SB(1,0),Bt,ldb,voB,bcol,1); STAGE(SA(1,0),A,lda,voA,brow,1); STAGE(SB(1,1),Bt,ldb,voB,bcol+HALF,1);
  WAIT_V(6); BAR;
  for(int t=0;t<nt-2;t+=2){
    LDB(B0,0,0); SCHED; LDA(At,0,0); STAGE(SA(1,1),A,lda,voA,brow+AH,t+1);
    if (MF == 4) WAIT_L(8); else WAIT_L(6); BAR; WAIT_L(0); MMA(0,0,At,B0); BAR; SCHED;
    LDB(B1,0,1); STAGE(SB(0,0),Bt,ldb,voB,bcol,t+2);
    BAR; WAIT_L(0); MMA(0,1,At,B1); BAR;
    LDA(At,0,1); STAGE(SA(0,0),A,lda,voA,brow,t+2);
    BAR; WAIT_L(0); MMA(1,0,At,B0); BAR; SCHED;
    STAGE(SB(0,1),Bt,ldb,voB,bcol+HALF,t+2);
    WAIT_V(6); BAR; MMA(1,1,At,B1); BAR;
    LDB(B0,1,0); SCHED; LDA(At,1,0); STAGE(SA(0,1),A,lda,voA,brow+AH,t+2);
    if (MF == 4) WAIT_L(8); else WAIT_L(6); BAR; WAIT_L(0); MMA(0,0,At,B0); BAR; SCHED;
    LDB(B1,1,1); STAGE(SB(1,0),Bt,ldb,voB,bcol,t+3);
    BAR; WAIT_L(0); MMA(0,1,At,B1); BAR;
    LDA(At,1,1); STAGE(SA(1,0),A,lda,voA,brow,t+3);
    BAR; WAIT_L(0); MMA(1,0,At,B0); BAR; SCHED;
    STAGE(SB(1,1),Bt,ldb,voB,bcol+HALF,t+3);
    WAIT_V(6); BAR; MMA(1,1,At,B1); BAR;
  }
  { LDB(B0,0,0); LDA(At,0,0); STAGE(SA(1,1),A,lda,voA,brow+AH,nt-1);
    BAR; WAIT_L(0); MMA(0,0,At,B0); BAR;
    LDB(B1,0,1); BAR; WAIT_L(0); MMA(0,1,At,B1); BAR;
    LDA(At,0,1); WAIT_V(4); BAR; WAIT_L(0); MMA(1,0,At,B0); MMA(1,1,At,B1); BAR; }
  { LDB(B0,1,0); LDA(At,1,0); WAIT_V(2); BAR; WAIT_L(0); MMA(0,0,At,B0); BAR;
    LDB(B1,1,1); WAIT_V(0); BAR; WAIT_L(0); MMA(0,1,At,B1); BAR;
    LDA(At,1,1); BAR; WAIT_L(0); MMA(1,0,At,B0); MMA(1,1,At,B1); BAR; }
  if(wr==0)BAR;
  const int tid2 = tid_(); const int wid2 = tid2 >> 6, lane2 = tid2 & 63;
  if (g.mode <= 1) {
    unsigned char* st = dyn_shm;
    const int lrow = (wid2 >> 2) * (MF * 16) + (lane2 & 15), lcol = (wid2 & 3) * 32 + (lane2 >> 4) * 4;
    const bool sq = g.mode == 1;
#pragma unroll
    for(int ai=0;ai<2;++ai)
#pragma unroll
      for(int m=0;m<MF;++m)
#pragma unroll
        for(int bj=0;bj<2;++bj)
#pragma unroll
          for(int n=0;n<2;++n) {
            f32x4 v = acc[ai][bj][m][n];
            if (sq) { v[0] = fmaxf(v[0], 0.f); v[1] = fmaxf(v[1], 0.f); v[2] = fmaxf(v[2], 0.f); v[3] = fmaxf(v[3], 0.f); v = v * v; }
            u32x2 w; w.x = cvtpk(v[0], v[1]); w.y = cvtpk(v[2], v[3]);
            *(u32x2*)(st + (lrow + ai * AH + m * 16) * 544 + (lcol + bj * HALF + n * 16) * 2) = w;
          }
    __syncthreads();
#if PROBE_PH >= 0
    if (!g.dry)
#endif
    {
      bf16_t* ob = (bf16_t*)g.out + (size_t)brow * g.ldc + bcol;
      const int r0 = wid2 * (MF * 8) + (lane2 >> 5), c16 = (lane2 & 31);
#pragma unroll 4
      for (int i = 0; i < MF * 4; ++i) {
        const int r = r0 + 2 * i;
        u32x4 w = *(const u32x4*)(st + r * 544 + c16 * 16);
        *(u32x4*)(ob + (size_t)r * g.ldc + c16 * 8) = w;
      }
    }
  } else {
  const int erow = brow + (wid2 >> 2) * (MF * 16) + (lane2 & 15), ecol = bcol + (wid2 & 3) * 32 + (lane2 >> 4) * 4;
#pragma unroll
  for(int ai=0;ai<2;++ai)
#pragma unroll
    for(int m=0;m<MF;++m)
#pragma unroll
      for(int bj=0;bj<2;++bj)
#pragma unroll
        for(int n=0;n<2;++n)
          gemm_epi(g, erow+ai*AH+m*16, ecol+bj*HALF+n*16, acc[ai][bj][m][n]);
  }
#undef SA
#undef SB
#undef STAGE
#undef LDA
#undef LDB
#undef MMA
}

__device__ __forceinline__ void tile_of(int L, int nM, int nN, int nwg, int th, int& brow, int& bcol) {
  int wgid = L;
  { const int q = nwg / NXCD, r = nwg % NXCD, xcd = wgid % NXCD, off = wgid / NXCD; wgid = (xcd < r ? xcd * (q + 1) : r * (q + 1) + (xcd - r) * q) + off; }
  const int nig = WGM * nN, gid = wgid / nig, fm = gid * WGM, gsz = (nM - fm) < WGM ? (nM - fm) : WGM;
  brow = (fm + ((wgid % nig) % gsz)) * th; bcol = ((wgid % nig) / gsz) * BM;
}
__device__ __forceinline__ void gemm_phase(const GemmDesc& g) {
  const int G = gdim_();
  const bool m3 = (g.Mrows % 192) == 0 && g.N <= 1536;
  const int th = m3 ? 192 : 256;
  const int nM = g.Mrows / th, nN = g.N / BM, nwg = nM * nN;
  for (int L = bid_(); L < nwg; L += G) {
    int brow, bcol; tile_of(L, nM, nN, nwg, th, brow, bcol);
    if (m3) gemm_tile<3>(g, brow, bcol); else gemm_tile<4>(g, brow, bcol);
  }
}

constexpr float ATT_SCALE = 0.10206207261596577f;
constexpr float ATT_THR = 8.f;
constexpr int SHM_V = 64 * 64 * 2, SHM_K = 64 * 128 * 2;
#define KSWZ(row, colB) ((row) * 256 + ((colB) ^ (((row) & 7) << 4)))
#define SBAR() __builtin_amdgcn_sched_barrier(0)
__device__ __forceinline__ int crow(int r, int hi) { return (r & 3) + 8 * (r >> 2) + 4 * hi; }

__device__ __forceinline__ void partialSM(f32x16& p0, f32x16& p1, float& m_reg, float& mn, float& alpha) {
  constexpr float C = ATT_SCALE * 1.4426950408889634f;
  float pmax = p0[0];
#pragma unroll
  for (int r = 1; r < 16; ++r) pmax = fmaxf(pmax, p0[r]);
#pragma unroll
  for (int r = 0; r < 16; ++r) pmax = fmaxf(pmax, p1[r]);
  { auto rr = __builtin_amdgcn_permlane32_swap(__float_as_uint(pmax), __float_as_uint(pmax), false, false);
    pmax = fmaxf(__uint_as_float(rr[0]), __uint_as_float(rr[1])); }
  if (__builtin_expect(__all(pmax - m_reg <= ATT_THR / ATT_SCALE), 1)) { mn = m_reg; alpha = 1.f; }
  else { mn = fmaxf(m_reg, pmax); alpha = __builtin_amdgcn_exp2f((m_reg - mn) * C); m_reg = mn; }
  float mnC = -mn * C;
#pragma unroll
  for (int r = 0; r < 16; ++r) p0[r] = fmaf(p0[r], C, mnC);
#pragma unroll
  for (int r = 0; r < 16; ++r) p1[r] = fmaf(p1[r], C, mnC);
#pragma unroll
  for (int r = 0; r < 16; ++r) p0[r] = __builtin_amdgcn_exp2f(p0[r]);
}
__device__ __forceinline__ void finishSM(f32x16& p0, f32x16& p1, float alpha, float& l_reg, bf16x8& pa0, bf16x8& pa1, bf16x8& pa2, bf16x8& pa3) {
#pragma unroll
  for (int r = 0; r < 16; ++r) p1[r] = __builtin_amdgcn_exp2f(p1[r]);
  float ps = 0;
#pragma unroll
  for (int r = 0; r < 16; ++r) ps += p0[r];
#pragma unroll
  for (int r = 0; r < 16; ++r) ps += p1[r];
  { auto rr = __builtin_amdgcn_permlane32_swap(__float_as_uint(ps), __float_as_uint(ps), false, false);
    ps = __uint_as_float(rr[0]) + __uint_as_float(rr[1]); }
  l_reg = l_reg * alpha + ps;
#define PK4(P, BASE, OUT) do { unsigned a0 = cvtpk(P[BASE + 0], P[BASE + 1]), a1 = cvtpk(P[BASE + 2], P[BASE + 3]);   \
    unsigned b0 = cvtpk(P[BASE + 4], P[BASE + 5]), b1 = cvtpk(P[BASE + 6], P[BASE + 7]);                              \
    auto r0 = __builtin_amdgcn_permlane32_swap(a0, b0, false, false); auto r1 = __builtin_amdgcn_permlane32_swap(a1, b1, false, false); \
    u32x4 w = {r0[0], r1[0], r0[1], r1[1]}; OUT = *reinterpret_cast<bf16x8*>(&w); } while (0)
  PK4(p0, 0, pa0); PK4(p0, 8, pa1); PK4(p1, 0, pa2); PK4(p1, 8, pa3);
#undef PK4
}
__device__ __forceinline__ void qkt(f32x16& p0, f32x16& p1, const unsigned char* Ks, const bf16x8* qr, int r32, int hi) {
  p0 = f32x16{}; p1 = f32x16{};
#pragma unroll
  for (int d0 = 0; d0 < 6; ++d0) { int cb = (d0 * 16 + hi * 8) * 2;
    bf16x8 b0 = *reinterpret_cast<const bf16x8*>(Ks + KSWZ(r32, cb));
    bf16x8 b1 = *reinterpret_cast<const bf16x8*>(Ks + KSWZ(32 + r32, cb));
    p0 = __builtin_amdgcn_mfma_f32_32x32x16_bf16(b0, qr[d0], p0, 0, 0, 0);
    p1 = __builtin_amdgcn_mfma_f32_32x32x16_bf16(b1, qr[d0], p1, 0, 0, 0); }
}
__device__ __forceinline__ int v_st(int k, int c) { const int kk = (k & ~0xC) | ((k & 4) << 1) | ((k & 8) >> 1); return ((kk >> 3) * 2 + (c >> 5)) * 512 + ((kk & 7) * 32 + (c & 31)) * 2; }
__device__ __forceinline__ int v_rd_base(int lane) { return ((lane & 3) << 3) | (((lane >> 2) & 3) << 6) | (((lane >> 4) & 1) << 5) | (((lane >> 5) & 1) << 8); }
constexpr int v_rd_off(int d0, int ks, int half) { return d0 * 512 + ks * 2048 + half * 1024; }
template <int OFF> __device__ __forceinline__ s16x4 tr_read(int vb) {
  s16x4 r; asm volatile("ds_read_b64_tr_b16 %0, %1 offset:%2" : "=&v"(r) : "v"(vb), "i"(OFF) : "memory"); return r;
}
__device__ __forceinline__ void pv_d0(f32x16* o, int vb, bf16x8 pa0, bf16x8 pa1, bf16x8 pa2, bf16x8 pa3) {
  const s16x4 l0 = tr_read<v_rd_off(0, 0, 0)>(vb), h0 = tr_read<v_rd_off(0, 0, 1)>(vb), l1 = tr_read<v_rd_off(0, 1, 0)>(vb), h1 = tr_read<v_rd_off(0, 1, 1)>(vb);
  const s16x4 l2 = tr_read<v_rd_off(0, 2, 0)>(vb), h2 = tr_read<v_rd_off(0, 2, 1)>(vb), l3 = tr_read<v_rd_off(0, 3, 0)>(vb), h3 = tr_read<v_rd_off(0, 3, 1)>(vb);
  const s16x4 m0 = tr_read<v_rd_off(1, 0, 0)>(vb), n0 = tr_read<v_rd_off(1, 0, 1)>(vb), m1 = tr_read<v_rd_off(1, 1, 0)>(vb), n1 = tr_read<v_rd_off(1, 1, 1)>(vb);
  const s16x4 m2 = tr_read<v_rd_off(1, 2, 0)>(vb), n2 = tr_read<v_rd_off(1, 2, 1)>(vb), m3 = tr_read<v_rd_off(1, 3, 0)>(vb), n3 = tr_read<v_rd_off(1, 3, 1)>(vb);
  asm volatile("s_waitcnt lgkmcnt(0)" ::: "memory"); SBAR();
#define PK(L, H) (bf16x8){L[0], L[1], L[2], L[3], H[0], H[1], H[2], H[3]}
  o[0] = __builtin_amdgcn_mfma_f32_32x32x16_bf16(pa0, PK(l0, h0), o[0], 0, 0, 0);
  o[1] = __builtin_amdgcn_mfma_f32_32x32x16_bf16(pa0, PK(m0, n0), o[1], 0, 0, 0);
  o[0] = __builtin_amdgcn_mfma_f32_32x32x16_bf16(pa1, PK(l1, h1), o[0], 0, 0, 0);
  o[1] = __builtin_amdgcn_mfma_f32_32x32x16_bf16(pa1, PK(m1, n1), o[1], 0, 0, 0);
  o[0] = __builtin_amdgcn_mfma_f32_32x32x16_bf16(pa2, PK(l2, h2), o[0], 0, 0, 0);
  o[1] = __builtin_amdgcn_mfma_f32_32x32x16_bf16(pa2, PK(m2, n2), o[1], 0, 0, 0);
  o[0] = __builtin_amdgcn_mfma_f32_32x32x16_bf16(pa3, PK(l3, h3), o[0], 0, 0, 0);
  o[1] = __builtin_amdgcn_mfma_f32_32x32x16_bf16(pa3, PK(m3, n3), o[1], 0, 0, 0);
#undef PK
}

__device__ __forceinline__ void attn_unit(bf16_t* Qrows, int h, const bf16_t* KVb, const bf16_t* KPb, int nkeys, bool rope, int s0, const float* ropetab, int dry) {
  unsigned char* lds = dyn_shm;
  const int tid = tid_(), wid = tid >> 6, lane = tid & 63, r32 = lane & 31, hi = lane >> 5;
  unsigned char* V_lds = lds; unsigned char* K_lds = lds + 2 * SHM_V;
  float* ws = (float*)(lds + 2 * SHM_V + 2 * SHM_K) + wid * 64; float* li_l = ws; float* al_l = ws + 32;
  float m_reg = -1e30f, l_reg = 0; f32x16 o[2] = {}; bf16x8 qr[6];
  __syncthreads();
  {
    const int row = wid * 32 + r32;
    const bf16_t* Qn = Qrows + (size_t)row * 1536 + h * 64 + hi * 8;
#pragma unroll
    for (int d0 = 0; d0 < 4; ++d0) qr[d0] = *reinterpret_cast<const bf16x8*>(Qn + d0 * 16);
    const bf16_t* Qp = Qrows + (size_t)row * 1536 + 1024 + h * 32;
    const int s = s0 + row;
#pragma unroll
    for (int blk = 0; blk < 2; ++blk) {
      bf16x8 x1 = *reinterpret_cast<const bf16x8*>(Qp + blk * 16), x2 = *reinterpret_cast<const bf16x8*>(Qp + blk * 16 + 8);
      if (rope) {
        const int pos = blk == 0 ? (s >> 6) : (s & 63);
        const float* tb = ropetab + pos * 16;
        float ov[8];
#pragma unroll
        for (int j = 0; j < 8; ++j) {
          float a = bf2f((bf16_t)x1[j]), b = bf2f((bf16_t)x2[j]), cs = tb[2 * j], sn = tb[2 * j + 1];
          ov[j] = hi == 0 ? a * cs - b * sn : b * cs + a * sn;
        }
        u32x4 w = {cvtpk(ov[0], ov[1]), cvtpk(ov[2], ov[3]), cvtpk(ov[4], ov[5]), cvtpk(ov[6], ov[7])};
        qr[4 + blk] = *reinterpret_cast<bf16x8*>(&w);
      } else {
        qr[4 + blk] = hi == 0 ? x1 : x2;
      }
    }
  }
  const int vrow = tid >> 3, vc = (tid & 7) * 8, vst = v_st(vrow, vc);
  const bf16_t* vsrc = KVb + (size_t)vrow * 2048 + h * 128 + 64 + vc;
  const bool kact = tid < 384;
  const int kr = kact ? tid / 12 : 0, kc = kact ? (tid % 12) * 8 : 0;
  const bf16_t* ksrc = kc < 64 ? KVb + (size_t)kr * 2048 + h * 128 + kc : KPb + (size_t)kr * 32 + (kc - 64);
  const long kstride = kc < 64 ? 2048 : 32;
  const int kst0 = KSWZ(kr, kc * 2), kst1 = KSWZ(32 + kr, kc * 2);
  const int vb0 = (int)(uintptr_t)V_lds + v_rd_base(lane);
  struct { bf16x8 vs, ks0, ks1; } sr_[2];
#define SLOAD(i, k0) do { sr_[i].vs = *reinterpret_cast<const bf16x8*>(vsrc + (size_t)(k0) * 2048); \
    if (kact) { sr_[i].ks0 = *reinterpret_cast<const bf16x8*>(ksrc + (long)(k0) * kstride); sr_[i].ks1 = *reinterpret_cast<const bf16x8*>(ksrc + (long)((k0) + 32) * kstride); } } while (0)
#define SWRITE(b, i) do { *(bf16x8*)(V_lds + (b) * SHM_V + vst) = sr_[i].vs; \
    if (kact) { *(bf16x8*)(K_lds + (b) * SHM_K + kst0) = sr_[i].ks0; *(bf16x8*)(K_lds + (b) * SHM_K + kst1) = sr_[i].ks1; } } while (0)
#define RESC(a) do { if (__any((a) < 1.f)) { if (hi == 0) al_l[r32] = (a); asm volatile("s_waitcnt lgkmcnt(0)" ::: "memory"); \
    for (int d = 0; d < 2; ++d) for (int r = 0; r < 16; ++r) o[d][r] *= al_l[crow(r, hi)]; } } while (0)
  f32x16 pA0, pA1, pB0, pB1; float mnA, mnB, alA, alB; bf16x8 pa0, pa1, pa2, pa3; const int NT = nkeys / 64;
  constexpr int SE = 0, SO = 1;
  SLOAD(SE, 0); SWRITE(0, SE); __syncthreads();
  qkt(pA0, pA1, K_lds, qr, r32, hi); partialSM(pA0, pA1, m_reg, mnA, alA);
  SLOAD(SO, 64); if (2 < NT) SLOAD(SE, 128);
  SWRITE(1, SO); __syncthreads();
  for (int j = 1; j + 1 < NT; j += 2) {
    SBAR(); qkt(pB0, pB1, K_lds + SHM_K, qr, r32, hi);
    finishSM(pA0, pA1, alA, l_reg, pa0, pa1, pa2, pa3); SBAR();
    SLOAD(SO, (j + 2) * 64); SBAR();
    pv_d0(o, vb0, pa0, pa1, pa2, pa3); partialSM(pB0, pB1, m_reg, mnB, alB);
    __syncthreads(); SWRITE(0, SE);
    RESC(alB); __syncthreads();
    SBAR(); qkt(pA0, pA1, K_lds, qr, r32, hi);
    finishSM(pB0, pB1, alB, l_reg, pa0, pa1, pa2, pa3); SBAR();
    if (j + 3 < NT) SLOAD(SE, (j + 3) * 64); SBAR();
    pv_d0(o, vb0 + SHM_V, pa0, pa1, pa2, pa3); partialSM(pA0, pA1, m_reg, mnA, alA);
    __syncthreads(); SWRITE(1, SO);
    RESC(alA); __syncthreads();
  }
  SBAR(); qkt(pB0, pB1, K_lds + SHM_K, qr, r32, hi);
  finishSM(pA0, pA1, alA, l_reg, pa0, pa1, pa2, pa3); SBAR();
  pv_d0(o, vb0, pa0, pa1, pa2, pa3); partialSM(pB0, pB1, m_reg, mnB, alB);
  __syncthreads(); RESC(alB);
  finishSM(pB0, pB1, alB, l_reg, pa0, pa1, pa2, pa3); SBAR();
  pv_d0(o, vb0 + SHM_V, pa0, pa1, pa2, pa3);
  if (hi == 0) li_l[r32] = l_reg; asm volatile("s_waitcnt lgkmcnt(0)" ::: "memory");
  float rli[16];
#pragma unroll
  for (int r = 0; r < 16; ++r) rli[r] = __builtin_amdgcn_rcpf(li_l[crow(r, hi)]);
  bf16_t* Ow = Qrows + (size_t)(wid * 32) * 1536 + h * 64;
  if (!dry)
#pragma unroll
  for (int r = 0; r < 16; ++r) { int orow = crow(r, hi);
#pragma unroll
    for (int d0 = 0; d0 < 2; ++d0) Ow[(size_t)orow * 1536 + d0 * 32 + r32] = f2bf(o[d0][r] * rli[r]); }
#undef SLOAD
#undef SWRITE
#undef RESC
}

__device__ __forceinline__ void attn_phase(KP p, int dry) {
  bf16_t* Q = (bf16_t*)(p->ws + WS_Q); const bf16_t* KV = (const bf16_t*)(p->ws + WS_KV); const bf16_t* KP = (const bf16_t*)(p->ws + WS_KPE);
  const float* ropetab = (const float*)(p->ws + WS_ROPE);
  const int xcd = bid_() & 7, slot = bid_() >> 3;
  const int G = gdim_();
  const int nit = G == 256 ? 6 : (1536 + G - 1) / G;
  for (int i = 0; i < nit; ++i) {
    int u;
    if (G == 256) u = i < 4 ? ((i * 16 + xcd * 2 + (slot >> 4)) << 4) + (slot & 15) : 1024 + (i - 4) * 256 + xcd * 32 + slot;
    else { u = bid_() + i * G; if (u >= 1536) break; }
    const bool samp = u < 1024;
    const int pair = samp ? u >> 4 : u - 1024, qb = samp ? u & 15 : 0, b = pair >> 4, h = pair & 15;
    const size_t qrow = samp ? (size_t)(MP + b * DSEQ + qb * 256) : (size_t)(b * SEQ);
    const size_t krow = samp ? (size_t)(MP + b * SKEYS) : (size_t)(b * SEQ);
    attn_unit(Q + qrow * 1536, h, KV + krow * 2048, KP + krow * 32, samp ? SKEYS : SEQ, samp, qb * 256, ropetab, dry);
  }
}

__device__ void mod_gemv_item(KP p, int it) {
  float* lds = (float*)dyn_shm;
  const int l = it / 96, n0 = (it % 96) * 64, tid = tid_();
  const float* wmod = p->in[l == 0 ? 7 : 24]; const float* bmod = p->in[l == 0 ? 8 : 25];
  __syncthreads();
  for (int e = tid; e < 5 * 1024; e += 512) { int c = e >> 10, k = e & 1023; float v = c == 0 ? p->in[6][k] : p->in[5][(c - 1) * 1024 + k]; lds[e] = v / (1.f + __expf(-v)); }
  __syncthreads();
  const int col = tid & 63, ks = tid >> 6;
  float a0 = 0, a1 = 0, a2 = 0, a3 = 0, a4 = 0;
  const float* wp = wmod + (size_t)(ks * 128) * 6144 + n0 + col;
#pragma unroll 8
  for (int k = 0; k < 128; ++k) { float w = wp[(size_t)k * 6144]; int kk = ks * 128 + k;
    a0 += lds[kk] * w; a1 += lds[1024 + kk] * w; a2 += lds[2048 + kk] * w; a3 += lds[3072 + kk] * w; a4 += lds[4096 + kk] * w; }
  float* red = lds + 5 * 1024;
  red[(ks * 5 + 0) * 64 + col] = a0; red[(ks * 5 + 1) * 64 + col] = a1; red[(ks * 5 + 2) * 64 + col] = a2; red[(ks * 5 + 3) * 64 + col] = a3; red[(ks * 5 + 4) * 64 + col] = a4;
  __syncthreads();
  if (tid < 320) { int c = tid >> 6, cc = tid & 63; float s = 0;
#pragma unroll
    for (int k8 = 0; k8 < 8; ++k8) s += red[(k8 * 5 + c) * 64 + cc];
    ((float*)(p->ws + WS_MOD))[(l * 5 + c) * 6144 + n0 + cc] = s + bmod[n0 + cc]; }
}

struct CvtMat { const float* src; int K, N, Npad; bf16_t* dst; int ldk, perm; };
__device__ __forceinline__ CvtMat get_mat(KP p, int layer, int i) {
  bf16_t* WB = (bf16_t*)(p->ws + WS_WB);
  if (layer == 0) {
    switch (i) {
      case 0: return CvtMat{p->in[11], 1024, 1536, 1536, WB + W0_IN, 1024, 0};
      case 1: return CvtMat{p->in[21], 1024, 1024, 1024, WB + W0_OUT, 1024, 0};
      case 2: return CvtMat{p->in[22], 1024, 4096, 4096, WB + W0_W1, 1024, 0};
      default: return CvtMat{p->in[23], 4096, 1024, 1024, WB + W0_W2, 4096, 0};
    }
  } else {
    switch (i) {
      case 0: return CvtMat{p->in[28], 1024, 672, 768, WB + W1_IN, 1024, 0};
      case 1: return CvtMat{p->in[30], 384, 1536, 1536, WB + W1_QB, 384, 1};
      case 2: return CvtMat{p->in[32], 256, 2048, 2048, WB + W1_KVB, 256, 0};
      case 3: return CvtMat{p->in[33], 1024, 1024, 1024, WB + W1_OUT, 1024, 0};
      case 4: return CvtMat{p->in[34], 1024, 4096, 4096, WB + W1_W1, 1024, 0};
      default: return CvtMat{p->in[35], 4096, 1024, 1024, WB + W1_W2, 4096, 0};
    }
  }
}
struct CvtTile { const float* src; int K, N; bf16_t* dst; int ldk, perm, k0, n0; };
__device__ __forceinline__ CvtTile cvt_desc(KP p, int layer, int t, int total) {
  bf16_t* WB = (bf16_t*)(p->ws + WS_WB);
  const int nm = layer == 0 ? 4 : 6;
  if (t < total) {
    int tt = t, i = 0;
    for (; i < nm - 1; ++i) { CvtMat m = get_mat(p, layer, i); int c = (m.K / 64) * (m.Npad / 64); if (tt < c) break; tt -= c; }
    const CvtMat m = get_mat(p, layer, i);
    const int nn = m.Npad / 64;
    return CvtTile{m.src, m.K, m.N, m.dst, m.ldk, m.perm, (tt / nn) * 64, (tt % nn) * 64};
  }
  const int e = t - total;
  if (e < 32) {
    const int dg = e >> 3, nb = e & 7, dir = dg >> 1, gate = dg & 1;
    return CvtTile{p->in[gate == 0 ? 14 : 16] + (size_t)(dir * 8 + nb) * 4096, 64, 64, WB + W0_G + (size_t)e * 4096, 64, 0, 0, 0};
  }
  const int e2 = e - 32, gi = e2 >> 2, q = e2 & 3;
  return CvtTile{p->in[19] + (size_t)gi * 16384, 128, 128, WB + W0_P + (size_t)gi * 16384, 128, 0, (q >> 1) * 64, (q & 1) * 64};
}
__device__ __forceinline__ void cvt_load(const CvtTile& d, int tid, f32x4& v0, f32x4& v1) {
  const int kk = tid >> 4, n4 = (tid & 15) * 4;
  const f32x4 zero = {0.f, 0.f, 0.f, 0.f};
  const bool ok = d.n0 + n4 < d.N;
  const float* sp = d.src + (size_t)(d.k0 + kk) * d.N + d.n0 + (ok ? n4 : 0);
  v0 = ok ? *(const f32x4*)sp : zero;
  v1 = ok ? *(const f32x4*)(sp + (size_t)32 * d.N) : zero;
}
__device__ void cvt_weights(KP p, int layer, int start, int stride) {
  float* tile = (float*)dyn_shm;
  const int total = layer == 0 ? 384 + 256 + 1024 + 1024 : 192 + 144 + 128 + 256 + 1024 + 1024;
  const int all = total + (layer == 0 ? 32 + 16 : 0);
  const int tid = tid_();
  int t = start;
  if (t >= all) return;
  CvtTile d = cvt_desc(p, layer, t, total);
  f32x4 v0, v1; cvt_load(d, tid, v0, v1);
  for (;;) {
    const int kk = tid >> 4, n4 = (tid & 15) * 4;
    __syncthreads();
    tile[kk * 65 + n4 + 0] = v0[0]; tile[kk * 65 + n4 + 1] = v0[1]; tile[kk * 65 + n4 + 2] = v0[2]; tile[kk * 65 + n4 + 3] = v0[3];
    tile[(kk + 32) * 65 + n4 + 0] = v1[0]; tile[(kk + 32) * 65 + n4 + 1] = v1[1]; tile[(kk + 32) * 65 + n4 + 2] = v1[2]; tile[(kk + 32) * 65 + n4 + 3] = v1[3];
    __syncthreads();
    const int tn = t + stride; const bool more = tn < all;
    CvtTile dn = d;
    if (more) { dn = cvt_desc(p, layer, tn, total); cvt_load(dn, tid, v0, v1); }
    {
      int n = tid >> 3, k8 = (tid & 7) * 8, ng = d.n0 + n;
      if (d.perm) { int hh = ng / 96, dd = ng % 96; ng = dd < 64 ? hh * 64 + dd : 1024 + hh * 32 + (dd - 64); }
      float v[8];
#pragma unroll
      for (int j = 0; j < 8; ++j) v[j] = tile[(k8 + j) * 65 + n];
      u32x4 w = {cvtpk(v[0], v[1]), cvtpk(v[2], v[3]), cvtpk(v[4], v[5]), cvtpk(v[6], v[7])};
      *(u32x4*)(d.dst + (size_t)ng * d.ldk + d.k0 + k8) = w;
    }
    if (!more) break;
    t = tn; d = dn;
  }
}

__device__ __forceinline__ void mod_row_store(bf16_t* H, int row, int lane, const f32x4 (&x)[4], const f32x4 (&gv)[4], float ss, const float* modl, int chunk_shift) {
  const float rstd = rsqrtf(ss * (1.f / DM) + EPS);
  const float* mc = modl + cond_of_row(row) * 6144 + chunk_shift * 1024;
#pragma unroll
  for (int i = 0; i < 4; ++i) {
    const int col = (i * 64 + lane) * 4;
    f32x4 sh = *(const f32x4*)(mc + col), sc = *(const f32x4*)(mc + 1024 + col);
    f32x4 y = x[i] * rstd * gv[i] * (sc + 1.f) + sh;
    u32x2 w; w.x = cvtpk(y[0], y[1]); w.y = cvtpk(y[2], y[3]);
    *(u32x2*)(H + (size_t)row * DM + col) = w;
  }
}
__device__ void modulate_phase(KP p, const float* src0, const float* src1, const float* g, const float* modl, int chunk_shift) {
  bf16_t* H = (bf16_t*)(p->ws + WS_H);
  const int tid = tid_(); const int wid = tid >> 6, lane = tid & 63;
  f32x4 gv[4];
#pragma unroll
  for (int i = 0; i < 4; ++i) gv[i] = *(const f32x4*)(g + (i * 64 + lane) * 4);
  const int stride = gdim_() * 8;
  for (int row = bid_() * 8 + wid; row < M; row += 2 * stride) {
    const int row2 = row + stride; const bool v2 = row2 < M; const int r2 = v2 ? row2 : row;
    const float* xp = row < MP ? src0 + (size_t)row * DM : src1 + (size_t)(row - MP) * DM;
    const float* xq = r2 < MP ? src0 + (size_t)r2 * DM : src1 + (size_t)(r2 - MP) * DM;
    f32x4 x[4], z[4]; float ss = 0, s2 = 0;
#pragma unroll
    for (int i = 0; i < 4; ++i) { x[i] = *(const f32x4*)(xp + (i * 64 + lane) * 4); z[i] = *(const f32x4*)(xq + (i * 64 + lane) * 4); }
#pragma unroll
    for (int i = 0; i < 4; ++i) { ss += x[i][0] * x[i][0] + x[i][1] * x[i][1] + x[i][2] * x[i][2] + x[i][3] * x[i][3]; s2 += z[i][0] * z[i][0] + z[i][1] * z[i][1] + z[i][2] * z[i][2] + z[i][3] * z[i][3]; }
    ss = wave_sum(ss, lane); s2 = wave_sum(s2, lane);
    mod_row_store(H, row, lane, x, gv, ss, modl, chunk_shift);
    if (v2) mod_row_store(H, row2, lane, z, gv, s2, modl, chunk_shift);
  }
}
__device__ void final_norm_phase(KP p, int dry) {
  float* X = p->out; const float* g = p->in[36];
  const int tid = tid_(); const int wid = tid >> 6, lane = tid & 63;
  f32x4 gv[4];
#pragma unroll
  for (int i = 0; i < 4; ++i) gv[i] = *(const f32x4*)(g + (i * 64 + lane) * 4);
  const int stride = gdim_() * 8;
  for (int row = bid_() * 8 + wid; row < M; row += 2 * stride) {
    const int row2 = row + stride; const bool v2 = row2 < M; const int r2 = v2 ? row2 : row;
    float* xp = X + (size_t)row * DM; float* xq = X + (size_t)r2 * DM;
    f32x4 x[4], z[4]; float ss = 0, s2 = 0;
#pragma unroll
    for (int i = 0; i < 4; ++i) { x[i] = *(const f32x4*)(xp + (i * 64 + lane) * 4); z[i] = *(const f32x4*)(xq + (i * 64 + lane) * 4); }
#pragma unroll
    for (int i = 0; i < 4; ++i) { ss += x[i][0] * x[i][0] + x[i][1] * x[i][1] + x[i][2] * x[i][2] + x[i][3] * x[i][3]; s2 += z[i][0] * z[i][0] + z[i][1] * z[i][1] + z[i][2] * z[i][2] + z[i][3] * z[i][3]; }
    ss = wave_sum(ss, lane); s2 = wave_sum(s2, lane);
    const float rstd = rsqrtf(ss * (1.f / DM) + EPS), rstd2 = rsqrtf(s2 * (1.f / DM) + EPS);
    if (!dry) {
#pragma unroll
      for (int i = 0; i < 4; ++i) *(f32x4*)(xp + (i * 64 + lane) * 4) = x[i] * rstd * gv[i];
      if (v2) {
#pragma unroll
        for (int i = 0; i < 4; ++i) *(f32x4*)(xq + (i * 64 + lane) * 4) = z[i] * rstd2 * gv[i];
      }
    }
  }
}
struct L1Row { f32x4 qa, qb, kv; float kp; };
__device__ __forceinline__ void l1_row_load(const float* Z1, int row, int lane, L1Row& r) {
  const float* z = Z1 + (size_t)row * 768;
  const f32x4 zero = {0.f, 0.f, 0.f, 0.f};
  r.qa = lane < 48 ? *(const f32x4*)(z + lane * 4) : zero;
  r.qb = lane < 48 ? *(const f32x4*)(z + 192 + lane * 4) : zero;
  r.kv = *(const f32x4*)(z + 384 + lane * 4);
  r.kp = lane < 32 ? z[640 + lane] : 0.f;
}
__device__ __forceinline__ void l1_row_finish(KP p, int row, int lane, const L1Row& r, const f32x4& gqa, const f32x4& gqb, const f32x4& gk) {
  bf16_t* CQN = (bf16_t*)(p->ws + WS_CQN); bf16_t* CKVN = (bf16_t*)(p->ws + WS_CKVN); bf16_t* KPE = (bf16_t*)(p->ws + WS_KPE);
  const float* ropetab = (const float*)(p->ws + WS_ROPE);
  float ss = r.qa[0] * r.qa[0] + r.qa[1] * r.qa[1] + r.qa[2] * r.qa[2] + r.qa[3] * r.qa[3] + r.qb[0] * r.qb[0] + r.qb[1] * r.qb[1] + r.qb[2] * r.qb[2] + r.qb[3] * r.qb[3];
  ss = wave_sum(ss, lane);
  const float rstd = rsqrtf(ss * (1.f / 384) + EPS);
  if (lane < 48) {
    const f32x4 ya = r.qa * rstd * gqa, yb = r.qb * rstd * gqb;
    u32x2 wa; wa.x = cvtpk(ya[0], ya[1]); wa.y = cvtpk(ya[2], ya[3]);
    u32x2 wb; wb.x = cvtpk(yb[0], yb[1]); wb.y = cvtpk(yb[2], yb[3]);
    *(u32x2*)(CQN + (size_t)row * 384 + lane * 4) = wa; *(u32x2*)(CQN + (size_t)row * 384 + 192 + lane * 4) = wb;
  }
  const float s2 = wave_sum(r.kv[0] * r.kv[0] + r.kv[1] * r.kv[1] + r.kv[2] * r.kv[2] + r.kv[3] * r.kv[3], lane);
  const float r2 = rsqrtf(s2 * (1.f / 256) + EPS);
  const f32x4 y = r.kv * r2 * gk;
  int krow; bool rope; int s = 0;
  if (row < MP) { krow = row; rope = false; *(f32x4*)(p->out + O_CKV + (size_t)row * 256 + lane * 4) = y; }
  else { int b = (row - MP) >> 12; s = (row - MP) & 4095; krow = MP + b * SKEYS + s; rope = true; }
  u32x2 w; w.x = cvtpk(y[0], y[1]); w.y = cvtpk(y[2], y[3]);
  *(u32x2*)(CKVN + (size_t)krow * 256 + lane * 4) = w;
  const float kp = r.kp;
  const float partner = lane_xor(kp, lane, 8);
  if (!rope) { if (lane < 32) { p->out[O_KPE + (size_t)row * 32 + lane] = kp; KPE[(size_t)krow * 32 + lane] = f2bf(kp); } }
  else if (lane < 32) {
    int pos = lane < 16 ? (s >> 6) : (s & 63); int j = lane & 7;
    float cs = ropetab[pos * 16 + 2 * j], sn = ropetab[pos * 16 + 2 * j + 1];
    float ov = (lane & 8) == 0 ? kp * cs - partner * sn : kp * cs + partner * sn;
    KPE[(size_t)krow * 32 + lane] = f2bf(ov);
  }
}
__device__ void l1_rows_phase(KP p) {
  const float* Z1 = (const float*)(p->ws + WS_Z1);
  bf16_t* CKVN = (bf16_t*)(p->ws + WS_CKVN); bf16_t* KPE = (bf16_t*)(p->ws + WS_KPE);
  const int tid = tid_(); const int wid = tid >> 6, lane = tid & 63;
  const int l48 = lane < 48 ? lane : 0;
  const f32x4 gqa = *(const f32x4*)(p->in[29] + l48 * 4), gqb = *(const f32x4*)(p->in[29] + 192 + l48 * 4), gk = *(const f32x4*)(p->in[31] + lane * 4);
  const int stride = gdim_() * 8;
  for (int row = bid_() * 8 + wid; row < M; row += 2 * stride) {
    const int row2 = row + stride; const bool v2 = row2 < M;
    L1Row ra, rb;
    l1_row_load(Z1, row, lane, ra); l1_row_load(Z1, v2 ? row2 : row, lane, rb);
    l1_row_finish(p, row, lane, ra, gqa, gqb, gk);
    if (v2) l1_row_finish(p, row2, lane, rb, gqa, gqb, gk);
  }
  for (int idx = bid_() * 8 + wid; idx < NB_S * PAST; idx += stride) {
    const int b = idx >> 9, j = idx & 511, krow = MP + b * SKEYS + DSEQ + j;
    f32x4 kv = *(const f32x4*)(p->in[3] + ((size_t)(b * PAST + j)) * 256 + lane * 4);
    u32x2 w; w.x = cvtpk(kv[0], kv[1]); w.y = cvtpk(kv[2], kv[3]);
    *(u32x2*)(CKVN + (size_t)krow * 256 + lane * 4) = w;
    if (lane < 32) KPE[(size_t)krow * 32 + lane] = f2bf(p->in[4][((size_t)(b * PAST + j)) * 32 + lane]);
  }
}

__device__ __forceinline__ float fast_sigmoid(float x) { return __builtin_amdgcn_rcpf(1.f + __expf(-x)); }
__device__ __forceinline__ float fast_gelu(float x) {
  float u = 0.7978845608028654f * (x + 0.044715f * x * x * x);
  float e = __expf(2.f * u);
  float th = 1.f - 2.f * __builtin_amdgcn_rcpf(e + 1.f);
  return 0.5f * x * (1.f + th);
}
__device__ __forceinline__ float bperm(int srclane, float v) { return __int_as_float(__builtin_amdgcn_ds_bpermute(srclane << 2, __float_as_int(v))); }
__device__ __forceinline__ void scan4(float& P, float& H, int lane, int stepl, int oq) {
  { const float Pp = bperm(lane - stepl, P), Hp = bperm(lane - stepl, H); if (oq >= 1) { H = P * Hp + H; P = Pp * P; } }
  { const float Pp = bperm(lane - 2 * stepl, P), Hp = bperm(lane - 2 * stepl, H); if (oq >= 2) { H = P * Hp + H; P = Pp * P; } }
}
__device__ void lru_item(KP p, int cidx, int nb, int mode) {
  const bf16_t* Z0 = (const bf16_t*)(p->ws + WS_Z0); bf16_t* H = (bf16_t*)(p->ws + WS_H);
  const bf16_t* Wg = (const bf16_t*)(p->ws + WS_WB) + W0_G;
  const float* LS8 = (const float*)(p->ws + WS_LS8);
  float2* SUM = (float2*)(p->ws + WS_SUM);
  float* xrL = (float*)dyn_shm;
  float* xc = xrL + 67 * 64;
  bf16_t* xcb = (bf16_t*)(xc + 64 * 64);
  float* Hs = (float*)(xcb + 64 * 72);
  const int tid = tid_(), lane = tid & 63, fr = lane & 15, fq = lane >> 4;
  const int wid = __builtin_amdgcn_readfirstlane(tid >> 6), dir = wid >> 2, wq = wid & 3;
  const int t0 = cidx * 64;
  int s0, s1, bsamp = -1;
  if (t0 < MP) { s0 = (t0 / SEQ) * SEQ; s1 = s0 + SEQ; } else { bsamp = (t0 - MP) / DSEQ; s0 = MP + bsamp * DSEQ; s1 = s0 + DSEQ; }
  const int c0 = s0 / 64, c1 = s1 / 64;
  const int chc = tid & 63, cgc = nb * 64 + chc;
  const int ch = wq * 16 + fr, cg_ = nb * 64 + ch;
  const int oq = dir ? 3 - fq : fq, stepl = dir ? -16 : 16, lastl = fr + (dir ? 0 : 48);
  unsigned xv[5];
#pragma unroll
  for (int i = 0; i < 5; ++i) { int e = tid + i * 512; int r = e >> 5, c2 = (e & 31) * 2, t = t0 - 2 + r;
    xv[i] = (e < 67 * 32 && t >= s0 && t < s1) ? *(const unsigned*)(Z0 + (size_t)t * 1536 + nb * 64 + c2) : 0u; }
  const float* cw = p->in[12];
  const float w0 = cw[cgc], w1 = cw[512 + cgc], w2 = cw[1024 + cgc], w3 = cw[1536 + cgc], bb = p->in[13][cgc];
  const float ba = p->in[15][dir * 512 + cg_], bi = p->in[17][dir * 512 + cg_], l8 = LS8[dir * 512 + cg_];
  bf16x8 wa[2], wi[2];
  { const bf16_t* pa = Wg + (size_t)((dir * 2 + 0) * 8 + nb) * 4096 + (size_t)ch * 64 + fq * 8; const bf16_t* pi = pa + 8 * 4096;
    wa[0] = *(const bf16x8*)pa; wa[1] = *(const bf16x8*)(pa + 32); wi[0] = *(const bf16x8*)pi; wi[1] = *(const bf16x8*)(pi + 32); }
  unsigned gz[4] = {0u, 0u, 0u, 0u};
  if (mode == 1) {
#pragma unroll
    for (int i = 0; i < 4; ++i) { int e = tid + i * 512; int t = e >> 5, c2 = (e & 31) * 2; gz[i] = *(const unsigned*)(Z0 + (size_t)(t0 + t) * 1536 + 512 + nb * 64 + c2); }
  }
  float cP = 1.f, cH = 0.f;
  if (mode == 1) {
    int lo, hi;
    if (dir == 0) { const int n = cidx - c0, q = (n + 3) >> 2; lo = c0 + fq * q; hi = lo + q < cidx ? lo + q : cidx;
      for (int c = lo; c < hi; c += 4) { float2 sm[4];
#pragma unroll
        for (int j = 0; j < 4; ++j) sm[j] = (c + j < hi) ? SUM[((size_t)(c + j) * 2) * 512 + cg_] : make_float2(1.f, 0.f);
#pragma unroll
        for (int j = 0; j < 4; ++j) { cH = sm[j].x * cH + sm[j].y; cP *= sm[j].x; } }
    } else { const int n = c1 - 1 - cidx, q = (n + 3) >> 2; hi = c1 - 1 - fq * q; lo = hi - q > cidx ? hi - q : cidx;
      for (int c = hi; c > lo; c -= 4) { float2 sm[4];
#pragma unroll
        for (int j = 0; j < 4; ++j) sm[j] = (c - j > lo) ? SUM[((size_t)(c - j) * 2 + 1) * 512 + cg_] : make_float2(1.f, 0.f);
#pragma unroll
        for (int j = 0; j < 4; ++j) { cH = sm[j].x * cH + sm[j].y; cP *= sm[j].x; } }
    }
  }
  __syncthreads();
#pragma unroll
  for (int i = 0; i < 5; ++i) { int e = tid + i * 512; if (e < 67 * 32) { int r = e >> 5, c2 = (e & 31) * 2;
    xrL[r * 64 + c2] = bf2f((bf16_t)(xv[i] & 0xffff)); xrL[r * 64 + c2 + 1] = bf2f((bf16_t)(xv[i] >> 16)); } }
  __syncthreads();
#pragma unroll
  for (int i = 0; i < 8; ++i) { int t = (tid >> 6) + 8 * i;
    float v = bb + w0 * xrL[t * 64 + chc] + w1 * xrL[(t + 1) * 64 + chc] + w2 * xrL[(t + 2) * 64 + chc] + w3 * xrL[(t + 3) * 64 + chc];
    xc[t * 64 + chc] = v; xcb[t * 72 + chc] = f2bf(v); }
  __syncthreads();
  float av[4][4], uv[4][4], Pt[4], Ht[4], Pe[4], He[4];
#pragma unroll
  for (int mt = 0; mt < 4; ++mt) {
    const bf16x8 a0 = *(const bf16x8*)(xcb + (mt * 16 + fr) * 72 + fq * 8), a1 = *(const bf16x8*)(xcb + (mt * 16 + fr) * 72 + 32 + fq * 8);
    f32x4 ga = {0.f, 0.f, 0.f, 0.f}, gi = {0.f, 0.f, 0.f, 0.f};
    ga = __builtin_amdgcn_mfma_f32_16x16x32_bf16(a0, wa[0], ga, 0, 0, 0); ga = __builtin_amdgcn_mfma_f32_16x16x32_bf16(a1, wa[1], ga, 0, 0, 0);
    gi = __builtin_amdgcn_mfma_f32_16x16x32_bf16(a0, wi[0], gi, 0, 0, 0); gi = __builtin_amdgcn_mfma_f32_16x16x32_bf16(a1, wi[1], gi, 0, 0, 0);
#pragma unroll
    for (int j = 0; j < 4; ++j) {
      const float ea = 1.f + __expf(fminf(-(ga[j] + ba), 40.f)), ei = 1.f + __expf(fminf(-(gi[j] + bi), 40.f));
      const float rc = __builtin_amdgcn_rcpf(ea * ei);
      const float r = rc * ei, ii = rc * ea;
      const float la = r * l8;
      const float a = __expf(la);
      const float x2 = 2.f * la;
      const float om = x2 > -0.25f ? -x2 * (1.f + x2 * 0.5f * (1.f + x2 * (1.f / 3.f) * (1.f + x2 * 0.25f * (1.f + x2 * 0.2f * (1.f + x2 * (1.f / 6.f)))))) : 1.f - a * a;
      av[mt][j] = a; uv[mt][j] = __builtin_amdgcn_sqrtf(fmaxf(om, 0.f)) * ii * xc[(mt * 16 + fq * 4 + j) * 64 + ch];
    }
    float P = 1.f, Hh = 0.f;
    if (dir == 0) {
#pragma unroll
      for (int j = 0; j < 4; ++j) { Hh = av[mt][j] * Hh + uv[mt][j]; P *= av[mt][j]; }
    } else {
#pragma unroll
      for (int j = 3; j >= 0; --j) { Hh = av[mt][j] * Hh + uv[mt][j]; P *= av[mt][j]; }
    }
    scan4(P, Hh, lane, stepl, oq);
    const float Pp = bperm(lane - stepl, P), Hp = bperm(lane - stepl, Hh);
    Pe[mt] = oq >= 1 ? Pp : 1.f; He[mt] = oq >= 1 ? Hp : 0.f;
    Pt[mt] = bperm(lastl, P); Ht[mt] = bperm(lastl, Hh);
  }
  if (mode == 0) {
    float P = 1.f, Hh = 0.f;
    if (dir == 0) {
#pragma unroll
      for (int mt = 0; mt < 4; ++mt) { Hh = Pt[mt] * Hh + Ht[mt]; P *= Pt[mt]; }
    } else {
#pragma unroll
      for (int mt = 3; mt >= 0; --mt) { Hh = Pt[mt] * Hh + Ht[mt]; P *= Pt[mt]; }
    }
    if (fq == 0) SUM[((size_t)cidx * 2 + dir) * 512 + cg_] = make_float2(P, Hh);
    return;
  }
  scan4(cP, cH, lane, 16, fq);
  const float tP = bperm(fr + 48, cP), tH = bperm(fr + 48, cH);
  float c = bsamp >= 0 ? p->in[2][(bsamp * 2 + dir) * 512 + cg_] : 0.f;
  c = tP * c + tH;
  float* hp = Hs + dir * 4096 + ch;
  if (dir == 0) {
#pragma unroll
    for (int mt = 0; mt < 4; ++mt) { float s = Pe[mt] * c + He[mt];
#pragma unroll
      for (int j = 0; j < 4; ++j) { s = av[mt][j] * s + uv[mt][j]; hp[(mt * 16 + fq * 4 + j) * 64] = s; }
      c = Pt[mt] * c + Ht[mt]; }
    if (bsamp < 0 && cidx == c1 - 1 && fq == 0) p->out[O_LRU + (size_t)((t0 / SEQ) * 2 + 0) * 512 + cg_] = c;
  } else {
#pragma unroll
    for (int mt = 3; mt >= 0; --mt) { float s = Pe[mt] * c + He[mt];
#pragma unroll
      for (int j = 3; j >= 0; --j) { s = av[mt][j] * s + uv[mt][j]; hp[(mt * 16 + fq * 4 + j) * 64] = s; }
      c = Pt[mt] * c + Ht[mt]; }
    if (bsamp < 0 && cidx == c0 && fq == 0) p->out[O_LRU + (size_t)((t0 / SEQ) * 2 + 1) * 512 + cg_] = c;
  }
  __syncthreads();
#pragma unroll
  for (int i = 0; i < 4; ++i) { int e = tid + i * 512; int t = e >> 5, c2 = (e & 31) * 2;
    float g0 = bf2f((bf16_t)(gz[i] & 0xffff)), g1 = bf2f((bf16_t)(gz[i] >> 16));
    float y0 = (Hs[t * 64 + c2] + Hs[4096 + t * 64 + c2]) * fast_gelu(g0);
    float y1 = (Hs[t * 64 + c2 + 1] + Hs[4096 + t * 64 + c2 + 1]) * fast_gelu(g1);
    *(unsigned*)(H + (size_t)(t0 + t) * DM + nb * 64 + c2) = cvtpk(y0, y1); }
}

__device__ void pool_item(KP p, int cidx, int gi) {
  const bf16_t* Z0 = (const bf16_t*)(p->ws + WS_Z0); bf16_t* H = (bf16_t*)(p->ws + WS_H);
  const bf16_t* Wp = (const bf16_t*)(p->ws + WS_WB) + W0_P + (size_t)gi * 16384;
  float* xp = (float*)dyn_shm;
  bf16_t* dL = (bf16_t*)(xp + 80 * 128);
  const int tid = tid_(), wid = tid >> 6, lane = tid & 63, fr = lane & 15, fq = lane >> 4;
  const int t0 = cidx * 64;
  int s0, s1;
  if (t0 < MP) { s0 = (t0 / SEQ) * SEQ; s1 = s0 + SEQ; } else { int b = (t0 - MP) / DSEQ; s0 = MP + b * DSEQ; s1 = s0 + DSEQ; }
  __syncthreads();
  for (int e = tid; e < 80 * 64; e += 512) { int r = e >> 6, c2 = (e & 63) * 2, t = t0 - 8 + r;
    float a = 0.f, b = 0.f;
    if (t >= s0 && t < s1) { unsigned v = *(const unsigned*)(Z0 + (size_t)t * 1536 + 1024 + gi * 128 + c2); a = bf2f((bf16_t)(v & 0xffff)); b = bf2f((bf16_t)(v >> 16)); }
    xp[r * 128 + c2] = a; xp[r * 128 + c2 + 1] = b; }
  __syncthreads();
  const int w = 2 << gi, left = w >> 1, right = w - 1 - left;
  {
    const int c = tid & 127, tq = tid >> 7, tb = tq * 16;
    float S = 0.f;
    for (int k = tb - left; k <= tb + right; ++k) S += xp[(k + 8) * 128 + c];
#pragma unroll
    for (int i = 0; i < 16; ++i) { const int t = tb + i, tg = t0 + t;
      const int lo = tg - left < s0 ? s0 : tg - left, hi = tg + right > s1 - 1 ? s1 - 1 : tg + right;
      const float d = S * __builtin_amdgcn_rcpf((float)(hi - lo + 1)) - xp[(t + 8) * 128 + c];
      dL[t * 136 + c] = f2bf(d);
      S += xp[(t + 1 + right + 8) * 128 + c] - xp[(t - left + 8) * 128 + c]; }
  }
  __syncthreads();
  {
    bf16x8 wf[4];
#pragma unroll
    for (int ks = 0; ks < 4; ++ks) wf[ks] = *(const bf16x8*)(Wp + (size_t)(wid * 16 + fr) * 128 + ks * 32 + fq * 8);
    const f32x4 sc = *(const f32x4*)(p->in[20] + gi * 128 + wid * 16 + fq * 4);
#pragma unroll
    for (int mt = 0; mt < 4; ++mt) {
      f32x4 acc = {0.f, 0.f, 0.f, 0.f};
#pragma unroll
      for (int ks = 0; ks < 4; ++ks) {
        bf16x8 df = *(const bf16x8*)(dL + (mt * 16 + fr) * 136 + ks * 32 + fq * 8);
        acc = __builtin_amdgcn_mfma_f32_16x16x32_bf16(wf[ks], df, acc, 0, 0, 0);
      }
      acc = acc * sc;
      u32x2 o; o.x = cvtpk(acc[0], acc[1]); o.y = cvtpk(acc[2], acc[3]);
      *(u32x2*)(H + (size_t)(t0 + mt * 16 + fr) * DM + 512 + gi * 128 + wid * 16 + fq * 4) = o;
    }
  }
}

__global__ void __launch_bounds__(512, 2) fwd_megakernel(Params kparams) {
  cg::grid_group grid = cg::this_grid();
  KP p = (KP)__builtin_amdgcn_kernarg_segment_ptr();
  unsigned char* ws = p->ws;
  bf16_t* WB = (bf16_t*)(ws + WS_WB);
  bf16_t* H = (bf16_t*)(ws + WS_H);
  float* X = p->out;
  const float* MOD = (const float*)(ws + WS_MOD);
  volatile LAS unsigned* xst = (volatile LAS unsigned*)(dyn_shm + LDS_MAIN);
  if (threadIdx.x == 0) { xst[0] = 0u; xst[1] = 0u; }
  __syncthreads();
  (void)xcd_barrier_post((unsigned*)(ws + WS_BAR), xst);
  int rep = 0;
  const int p_lo = p->p_lo, p_hi = p->p_hi, probe = p->pad, coop = p->coop;
  for (int ph = p_lo; ph < p_hi; ++ph) {
    asm volatile("" : "+s"(p));
    const int G = gdim_(), bid = bid_();
    unsigned char* ws = p->ws; bf16_t* WB = (bf16_t*)(ws + WS_WB); bf16_t* H = (bf16_t*)(ws + WS_H); float* X = p->out; const float* MOD = (const float*)(ws + WS_MOD);
#if PROBE_PH >= 0
    const int dry = (ph == probe && rep == 0) ? 1 : 0;
#else
    const int dry = 0;
#endif
    if (PROBE_PH == 99 && probe == 99 && ph == 1) { XcdBarrier xb; xb.bar = (unsigned*)(ws + WS_BAR); xb.st = (volatile LAS unsigned*)(dyn_shm + LDS_MAIN); for (int q = 0; q < 10; ++q) xcd_barrier(xb); }
    GemmDesc g1{nullptr, nullptr, 0, 0, 0, 0, 0, 0, nullptr, 0, nullptr, nullptr, nullptr, 0, 0};
    bool isg = false;
    const float* MODL = MOD + (ph >= 11 ? 5 * 6144 : 0);
    const bf16_t* U = (const bf16_t*)(ws + WS_U);
    switch (ph) {
      case 0: {
        for (int it = bid; it < 192; it += G) mod_gemv_item(p, it);
        if (bid == G - 1) { int t = tid_(); int pos = t >> 3, j = t & 7;
          float inv = exp2f(-(float)j * 0.125f * 13.287712379549449f);
          float s, c; my_sincos((float)pos * inv, s, c);
          float* rt = (float*)(ws + WS_ROPE); rt[t * 2] = c; rt[t * 2 + 1] = s; }
        if (bid == G - 2) { int t = tid_(); float* l8 = (float*)(ws + WS_LS8);
          for (int e = t; e < 1024; e += 512) l8[e] = -8.f * log1pf(__expf(-p->in[18][e])); }
      } break;
      case 2: g1 = GemmDesc{H, WB + W0_IN, 1024, 1024, M, 1536, 1024, 0, ws + WS_Z0, 1536, nullptr, nullptr, nullptr, 0, 0}; isg = true; break;
      case 5: g1 = GemmDesc{H, WB + W0_OUT, 1024, 1024, M, 1024, 1024, 2, X, 1024, p->in[0], p->in[1], MOD + 2 * 1024, 0, 0}; isg = true; break;
      case 7: case 9: case 19: case 21: { int ro = (ph == 7 || ph == 19) ? 0 : MH;
        g1 = GemmDesc{H + (size_t)ro * DM, WB + (ph < 11 ? W0_W1 : W1_W1), 1024, 1024, MH, 4096, 1024, 1, ws + WS_U, 4096, nullptr, nullptr, nullptr, 0, 0}; isg = true; } break;
      case 8: case 10: case 20: case 22: { int ro = (ph == 8 || ph == 20) ? 0 : MH;
        g1 = GemmDesc{U, WB + (ph < 11 ? W0_W2 : W1_W2), 4096, 4096, MH, 1024, 4096, 2, X, 1024, X, X + (size_t)MP * DM, MODL + 5 * 1024, ro, 0}; isg = true; } break;
      case 12: g1 = GemmDesc{H, WB + W1_IN, 1024, 1024, M, 768, 1024, 3, ws + WS_Z1, 768, nullptr, nullptr, nullptr, 0, 0}; isg = true; break;
      case 13: l1_rows_phase(p); break;
      case 14: g1 = GemmDesc{(const bf16_t*)(ws + WS_CQN), WB + W1_QB, 384, 384, M, 1536, 384, 0, ws + WS_Q, 1536, nullptr, nullptr, nullptr, 0, 0}; isg = true; break;
      case 15: g1 = GemmDesc{(const bf16_t*)(ws + WS_CKVN), WB + W1_KVB, 256, 256, KROWS, 2048, 256, 0, ws + WS_KV, 2048, nullptr, nullptr, nullptr, 0, 0}; isg = true; break;
#ifndef NO_ATTN
      case 16: attn_phase(p, dry); break;
#endif
      case 17: g1 = GemmDesc{(const bf16_t*)(ws + WS_Q), WB + W1_OUT, 1536, 1024, M, 1024, 1024, 2, X, 1024, X, X + (size_t)MP * DM, MODL + 2 * 1024, 0, 0}; isg = true; break;
      case 23: final_norm_phase(p, dry); break;
      default: break;
    }
    if (ph == 1 || ph == 6 || ph == 11 || ph == 18) {
      const bool first = ph == 1;
      modulate_phase(p, first ? p->in[0] : X, first ? p->in[1] : X + (size_t)MP * DM, p->in[ph == 1 ? 9 : ph == 6 ? 10 : ph == 11 ? 26 : 27], MODL, (ph == 1 || ph == 11) ? 0 : 3);
    }
    if (ph == 0 || ph == 11) cvt_weights(p, ph == 0 ? 0 : 1, ph == 0 ? (bid + G - 192 % G) % G : bid, G);
#ifndef NO_LRU
    if (ph == 3 || ph == 4) {
      const int nit = ph == 3 ? 3072 + 1536 : 3072;
      for (int it = bid; it < nit; it += G) { if (it < 3072) lru_item(p, it >> 3, it & 7, ph - 3); else pool_item(p, (it - 3072) >> 2, (it - 3072) & 3); }
    }
#endif
#ifndef NO_GEMM
    g1.dry = (dry && g1.mode == 2 && ph != 5) ? 1 : 0;
    if (isg) gemm_phase(g1);
#endif
    if (coop && ph + 1 < p_hi && ph != 14) {
      if (ph == 0 && !dry) grid.sync(); else { XcdBarrier xb; xb.bar = (unsigned*)(ws + WS_BAR); xb.st = (volatile LAS unsigned*)(dyn_shm + LDS_MAIN); xcd_barrier(xb); } }
#if PROBE_PH >= 0
    if (dry) { rep = 1; --ph; }
#endif
  }
}

#ifndef MK_SPLIT
#define MK_SPLIT 0
#endif
extern "C" void kernel_launch(void* const* d_in, const int* in_sizes, int n_in, void* d_out, int out_size, void* d_ws, size_t ws_size, hipStream_t stream) {
  static int grid = 0;
  if (grid == 0) {
    if (n_in != 37 || ws_size < WS_END) { fprintf(stderr, "kernel_launch: bad n_in %d or ws %zu < %zu\n", n_in, ws_size, (size_t)WS_END); grid = -1; return; }
    int dev = 0, cus = 0, per_cu = 0;
    hipGetDevice(&dev); hipDeviceGetAttribute(&cus, hipDeviceAttributeMultiprocessorCount, dev);
    if (hipFuncSetAttribute((const void*)fwd_megakernel, hipFuncAttributeMaxDynamicSharedMemorySize, LDS_BYTES) != hipSuccess) { fprintf(stderr, "kernel_launch: hipFuncSetAttribute failed\n"); grid = -1; return; }
    if (hipOccupancyMaxActiveBlocksPerMultiprocessor(&per_cu, (const void*)fwd_megakernel, 512, LDS_BYTES) != hipSuccess || per_cu < 1) { fprintf(stderr, "kernel_launch: occupancy query gave %d\n", per_cu); grid = -1; return; }
    grid = cus;
  }
  if (grid < 0) return;
  if (hipMemsetAsync((char*)d_ws + WS_BAR, 0, XCD_BAR_WORDS * 4, stream) != hipSuccess) { fprintf(stderr, "kernel_launch: memset failed\n"); return; }
  Params p{};
  for (int i = 0; i < 37; ++i) p.in[i] = (const float*)d_in[i];
  p.out = (float*)d_out; p.ws = (unsigned char*)d_ws; p.pad = PROBE_PH;
#if MK_SPLIT
  for (int ph = 0; ph < NPH; ++ph) {
    p.p_lo = ph; p.p_hi = ph + 1; p.coop = 0;
    hipLaunchKernelGGL(fwd_megakernel, dim3(grid), dim3(512), LDS_BYTES, stream, p);
  }
#else
  p.p_lo = 0; p.p_hi = NPH; p.coop = 1;
  void* args[] = {&p};
  hipError_t e = hipLaunchCooperativeKernel((const void*)fwd_megakernel, dim3(grid), dim3(512), args, LDS_BYTES, stream);
  if (e != hipSuccess) fprintf(stderr, "cooperative launch failed: %s (grid %d)\n", hipGetErrorString(e), grid);
#endif
}
```

```cpp
#include <hip/hip_runtime.h>
#include <hip/hip_cooperative_groups.h>
#include <cstdio>
#include <cstdint>
namespace cg = cooperative_groups;
#ifndef PROBE_PH
#define PROBE_PH -1
#endif

typedef unsigned short bf16_t;
typedef short bf16x8 __attribute__((ext_vector_type(8)));
typedef short s16x4 __attribute__((ext_vector_type(4)));
typedef float f32x4 __attribute__((ext_vector_type(4)));
typedef float f32x16 __attribute__((ext_vector_type(16)));
typedef unsigned u32x4 __attribute__((ext_vector_type(4)));
typedef unsigned u32x2 __attribute__((ext_vector_type(2)));

constexpr int DM = 1024, MP = 8192, MS = 16384, M = MP + MS, DFF = 4096;
constexpr int SEQ = 256, DSEQ = 4096, PAST = 512, NB_S = 4;
constexpr int KROWS = MP + NB_S * (DSEQ + PAST);
constexpr int SKEYS = DSEQ + PAST;
constexpr int MH = M / 2;
constexpr float EPS = 1e-6f;
constexpr int NPH = 24;

constexpr size_t MiB = 1u << 20;
constexpr size_t WS_MOD = 0;
constexpr size_t WS_ROPE = 256 * 1024;
constexpr size_t WS_LS8 = 260 * 1024;
constexpr size_t WS_SUM = 512 * 1024;
constexpr size_t WS_BAR = 3840 * 1024;
constexpr size_t WS_WB = 4 * MiB;
constexpr size_t WS_R1 = 26 * MiB;
constexpr size_t WS_H = WS_R1;
constexpr size_t WS_Z0 = WS_R1 + 48 * MiB;
constexpr size_t WS_U = WS_R1 + 48 * MiB;
constexpr size_t WS_KV = WS_R1;
constexpr size_t WS_Q = WS_R1 + 104 * MiB;
constexpr size_t WS_Z1 = WS_R1 + 104 * MiB;
constexpr size_t WS_CQN = WS_R1 + 176 * MiB;
constexpr size_t WS_CKVN = WS_R1 + 194 * MiB;
constexpr size_t WS_KPE = WS_R1 + 207 * MiB;
constexpr size_t WS_END = WS_R1 + 209 * MiB;
constexpr size_t W0_IN = 0, W0_OUT = 1572864, W0_W1 = 2621440, W0_W2 = 6815744, W0_G = 11010048, W0_P = 11141120;
constexpr size_t W1_IN = 0, W1_QB = 786432, W1_KVB = 1376256, W1_OUT = 1900544, W1_W1 = 2949120, W1_W2 = 7143424;
constexpr size_t O_Y = 0, O_LRU = 25165824, O_CKV = 25198592, O_KPE = 27295744;

struct Params {
  const float* in[37];
  float* out;
  unsigned char* ws;
  int p_lo, p_hi, coop, pad;
};

typedef const __attribute__((address_space(4))) Params* KP;
extern __shared__ __attribute__((aligned(16))) unsigned char dyn_shm[];
constexpr int LDS_MAIN = 139264;
constexpr int LDS_BYTES = LDS_MAIN + 16;

__device__ __forceinline__ unsigned cvtpk(float lo, float hi) {
  unsigned r; asm volatile("v_cvt_pk_bf16_f32 %0, %1, %2" : "=v"(r) : "v"(lo), "v"(hi)); return r;
}
__device__ __forceinline__ float bf2f(bf16_t b) { return __uint_as_float(((unsigned)b) << 16); }
__device__ __forceinline__ bf16_t f2bf(float f) { return (bf16_t)(cvtpk(f, f) & 0xffffu); }
__device__ __forceinline__ float sigmoidf_(float x) { return 1.f / (1.f + __expf(-x)); }
__device__ __forceinline__ float gelu_tanh(float x) {
  float u = 0.7978845608028654f * (x + 0.044715f * x * x * x);
  float e = __expf(2.f * u);
  float th = 1.f - 2.f / (e + 1.f);
  return 0.5f * x * (1.f + th);
}
__device__ __forceinline__ float lane_xor(float v, int lane, int o) { return __int_as_float(__builtin_amdgcn_ds_bpermute((lane ^ o) << 2, __float_as_int(v))); }
__device__ __forceinline__ float wave_sum(float v, int lane) {
#pragma unroll
  for (int o = 32; o > 0; o >>= 1) v += lane_xor(v, lane, o);
  return v;
}
__device__ __forceinline__ void my_sincos(float a, float& s, float& c) {
  float k = rintf(a * 0.63661977236758134f);
  float r = fmaf(k, -1.5707962513e+00f, a);
  r = fmaf(k, -7.5497894159e-08f, r);
  r = fmaf(k, -5.3903029534e-15f, r);
  float r2 = r * r;
  float sp = r + r * r2 * (-1.6666667163e-01f + r2 * (8.3333337680e-03f + r2 * (-1.9841270114e-04f + r2 * 2.7557314297e-06f)));
  float cp = 1.f + r2 * (-0.5f + r2 * (4.1666667908e-02f + r2 * (-1.3888889225e-03f + r2 * 2.4801587642e-05f)));
  int q = ((int)k) & 3;
  float ss = (q & 1) ? cp : sp, cc = (q & 1) ? sp : cp;
  s = (q & 2) ? -ss : ss;
  c = ((q + 1) & 2) ? -cc : cc;
}
__device__ __forceinline__ int bid_() { int b = blockIdx.x; asm volatile("" : "+s"(b)); return b; }
__device__ __forceinline__ int gdim_() { int g = gridDim.x; asm volatile("" : "+s"(g)); return g; }
__device__ __forceinline__ int tid_() { int t = threadIdx.x; asm volatile("" : "+v"(t)); return t; }
__device__ __forceinline__ int cond_of_row(int row) { return row < MP ? 0 : 1 + ((row - MP) >> 12); }


#define XB_TMO      128
#define XB_XCNT(j)  (256  + 64 * (j))
#define XB_XSUB(j)  (1280 + 64 * (j))
#define XB_XGEN(j)  (2304 + 64 * (j))
#define XB_TOP      3328
#define XB_TOPGEN   3392
#define XCD_BAR_WORDS 3456
#define XB_SPIN_CAP (1u << 20)
#define LAS __attribute__((address_space(3)))
__device__ __forceinline__ unsigned xb_ld(unsigned* p)              { return __hip_atomic_load(p, __ATOMIC_RELAXED, __HIP_MEMORY_SCOPE_AGENT); }
__device__ __forceinline__ unsigned xb_add(unsigned* p, unsigned v) { return __hip_atomic_fetch_add(p, v, __ATOMIC_RELAXED, __HIP_MEMORY_SCOPE_AGENT); }
__device__ __forceinline__ unsigned xb_xcc_id() { return (unsigned)__builtin_amdgcn_s_getreg((3 << 11) | 20) & 0xFu; }
#define XB_SPIN(cond, bar) do { unsigned _sp = 0; while (cond) { __builtin_amdgcn_s_sleep(1); \
    if ((++_sp & 255u) == 0u) { if (xb_ld(&(bar)[XB_TMO])) break; if (_sp > XB_SPIN_CAP) { atomicAdd(&(bar)[XB_TMO], 1u); break; } } } } while (0)
struct XcdBarrier { unsigned* bar; volatile LAS unsigned* st; };
__device__ __forceinline__ XcdBarrier xcd_barrier_post(unsigned* bar, volatile LAS unsigned* st) {
  XcdBarrier b; b.bar = bar; b.st = st;
  if (threadIdx.x == 0) (void)xb_add(&bar[XB_XCNT(xb_xcc_id())], 1u);
  return b;
}
__device__ __forceinline__ void xcd_barrier_complete(unsigned* bar, unsigned x, unsigned& nloc, unsigned& nx) {
  const unsigned G = (unsigned)gdim_();
  unsigned sum, cnt, mine, sp = 0u;
  for (;;) {
    sum = 0u; cnt = 0u; mine = 0u;
#pragma unroll
    for (unsigned j = 0; j < 16; ++j) { const unsigned c = xb_ld(&bar[XB_XCNT(j)]); sum += c; cnt += (c > 0u) ? 1u : 0u; mine = (j == x) ? c : mine; }
    if (sum == G) break;
    __builtin_amdgcn_s_sleep(1);
    if ((++sp & 255u) == 0u) { if (xb_ld(&bar[XB_TMO])) break; if (sp > XB_SPIN_CAP) { atomicAdd(&bar[XB_TMO], 1u); break; } }
  }
  nloc = mine > 0u ? mine : 1u; nx = cnt > 0u ? cnt : 1u;
}
__device__ __forceinline__ void xcd_barrier(const XcdBarrier& b) {
  asm volatile("s_waitcnt vmcnt(0)" ::: "memory");
  __syncthreads();
  if (threadIdx.x == 0) {
    unsigned* bar = b.bar; unsigned bx = xb_xcc_id(); asm volatile("" : "+s"(bx));
    __builtin_amdgcn_s_waitcnt(0);
    unsigned nloc = b.st[0], nx = b.st[1];
    if (nloc == 0u) { xcd_barrier_complete(bar, bx, nloc, nx); b.st[0] = nloc; b.st[1] = nx; }
    const unsigned old = xb_add(&bar[XB_XSUB(bx)], 1u);
    const unsigned gen = old / nloc;
    if (old + 1u == (gen + 1u) * nloc) {
      __builtin_amdgcn_fence(__ATOMIC_RELEASE, "agent");
      asm volatile("s_waitcnt vmcnt(0)" ::: "memory");
      const unsigned og = xb_add(&bar[XB_TOP], 1u);
      const unsigned tg = og / nx;
      if (og + 1u == (tg + 1u) * nx) xb_add(&bar[XB_TOPGEN], 1u);
      else XB_SPIN(xb_ld(&bar[XB_TOPGEN]) == tg, bar);
      __builtin_amdgcn_fence(__ATOMIC_ACQUIRE, "agent");
      xb_add(&bar[XB_XGEN(bx)], 1u);
      asm volatile("s_waitcnt vmcnt(0)" ::: "memory");
    } else {
      XB_SPIN(xb_ld(&bar[XB_XGEN(bx)]) == gen, bar);
      __builtin_amdgcn_fence(__ATOMIC_ACQUIRE, "agent");
      asm volatile("s_waitcnt vmcnt(0)" ::: "memory");
    }
  }
  __syncthreads();
}

constexpr int BM = 256, BK = 64, HALF = 128, HT = HALF * BK, NXCD = 8, WGM = 8;
__device__ __forceinline__ int lds_byte(int r, int c) {
  int st = (r >> 4) * 2 + (c >> 5), rr = r & 15, cc = c & 31, ob = rr * 64 + cc * 2;
  return st * 1024 + (ob ^ (((ob >> 9) & 1) << 5));
}
__device__ __forceinline__ void stage_rc(int b, int& R, int& C) {
  int st = b / 1024, sb = b % 1024, swz = sb ^ (((sb >> 9) & 1) << 5);
  R = (st >> 1) * 16 + swz / 64; C = (st & 1) * 32 + (swz % 64) / 2;
}

struct GemmDesc {
  const bf16_t* A; const bf16_t* Bt; int lda, ldb, Mrows, N, K;
  int mode;
  void* out; int ldc;
  const float* src0; const float* src1; const float* gate; int row_off; int dry;
};

__device__ __forceinline__ void gemm_epi(const GemmDesc& g, int row, int col, f32x4 v) {
#if PROBE_PH >= 0
  if (g.dry) return;
#endif
  if (g.mode == 0) {
    u32x2 w; w.x = cvtpk(v[0], v[1]); w.y = cvtpk(v[2], v[3]);
    *(u32x2*)((bf16_t*)g.out + (size_t)row * g.ldc + col) = w;
  } else if (g.mode == 1) {
    float a = fmaxf(v[0], 0.f), b = fmaxf(v[1], 0.f), c = fmaxf(v[2], 0.f), d = fmaxf(v[3], 0.f);
    u32x2 w; w.x = cvtpk(a * a, b * b); w.y = cvtpk(c * c, d * d);
    *(u32x2*)((bf16_t*)g.out + (size_t)row * g.ldc + col) = w;
  } else if (g.mode == 2) {
    int rg = row + g.row_off;
    const float* sp = rg < MP ? g.src0 + (size_t)rg * DM + col : g.src1 + (size_t)(rg - MP) * DM + col;
    f32x4 x = *(const f32x4*)sp;
    f32x4 gt = *(const f32x4*)(g.gate + cond_of_row(rg) * 6144 + col);
    *(f32x4*)((float*)g.out + (size_t)rg * DM + col) = x + gt * v;
  } else {
    *(f32x4*)((float*)g.out + (size_t)row * g.ldc + col) = v;
  }
}

template <int MF>
__device__ __forceinline__ void gemm_tile(const GemmDesc& g, int brow, int bcol) {
  constexpr int AH = MF * 32;
  bf16_t* shm = (bf16_t*)dyn_shm;
  const bf16_t* A = g.A; const bf16_t* Bt = g.Bt; const int lda = g.lda, ldb = g.ldb, K = g.K;
#define SA(b,h) (shm+((b)*2+(h))*HT)
#define SB(b,h) (shm+(4+(b)*2+(h))*HT)
#define STAGE(P,BASE,LD,VO,br,kt) do{const unsigned char* _ub=(const unsigned char*)(BASE)+((size_t)(br)*(LD)+(size_t)(kt)*BK)*2; \
    unsigned _vo=VO; asm volatile("":"+v"(_vo)); \
    __builtin_amdgcn_global_load_lds((const unsigned*)(_ub+_vo), (__attribute__((address_space(3))) unsigned*)((unsigned char*)(P)+tid*16),16,0,0); \
    __builtin_amdgcn_global_load_lds((const unsigned*)(_ub+(size_t)(LD)*128+_vo), (__attribute__((address_space(3))) unsigned*)((unsigned char*)(P)+tid*16+8192),16,0,0);}while(0)
#define LDA(dst,b,h) for(int m=0;m<MF;++m)for(int k=0;k<2;++k) \
    dst[m][k]=*reinterpret_cast<const bf16x8*>((char*)SA(b,h)+lds_byte(wr*(MF*16)+m*16+fr,k*32+fq*8))
#define LDB(dst,b,h) for(int n=0;n<2;++n)for(int k=0;k<2;++k) \
    dst[n][k]=*reinterpret_cast<const bf16x8*>((char*)SB(b,h)+lds_byte(wc*32+n*16+fr,k*32+fq*8))
#define MMA(ai,bj,At,Bt_) do{__builtin_amdgcn_s_setprio(1); \
    for(int m=0;m<MF;++m)for(int n=0;n<2;++n)for(int k=0;k<2;++k) \
      acc[ai][bj][m][n]=__builtin_amdgcn_mfma_f32_16x16x32_bf16(Bt_[n][k],At[m][k],acc[ai][bj][m][n],0,0,0); \
    __builtin_amdgcn_s_setprio(0);}while(0)
#define WAIT_V(n) asm volatile("s_waitcnt vmcnt(" #n ")":::"memory")
#define WAIT_L(n) asm volatile("s_waitcnt lgkmcnt(" #n ")":::"memory")
#define BAR __builtin_amdgcn_s_barrier()
#define SCHED __builtin_amdgcn_sched_barrier(0)
  const int tid = tid_();
  const int wid = __builtin_amdgcn_readfirstlane(tid >> 6), lane = tid & 63, wr = wid >> 2, wc = wid & 3, fr = lane & 15, fq = lane >> 4;
  unsigned voA, voB;
  { int r_, c_; stage_rc(tid * 16, r_, c_); voA = (unsigned)(r_ * lda + c_) * 2u; voB = (unsigned)(r_ * ldb + c_) * 2u; }
  f32x4 acc[2][2][MF][2] = {};
  bf16x8 At[MF][2], B0[2][2], B1[2][2];
  const int nt = K / BK;
  __syncthreads();
  STAGE(SB(0,0),Bt,ldb,voB,bcol,0); STAGE(SA(0,0),A,lda,voA,brow,0);
  STAGE(SB(0,1),Bt,ldb,voB,bcol+HALF,0); STAGE(SA(0,1),A,lda,voA,brow+AH,0);
  if(wr==1)BAR;
  WAIT_V(4); BAR;
  STAGE(SB(1,0),Bt,ldb,voB,bcol,1); STAGE(SA(1,0),A,lda,voA,brow,1); STAGE(SB(1,1),Bt,ldb,voB,bcol+HALF,1);
  WAIT_V(6); BAR;
  for(int t=0;t<nt-2;t+=2){
    LDB(B0,0,0); SCHED; LDA(At,0,0); STAGE(SA(1,1),A,lda,voA,brow+AH,t+1);
    if (MF == 4) WAIT_L(8); else WAIT_L(6); BAR; WAIT_L(0); MMA(0,0,At,B0); BAR; SCHED;
    LDB(B1,0,1); STAGE(SB(0,0),Bt,ldb,voB,bcol,t+2);
    BAR; WAIT_L(0); MMA(0,1,At,B1); BAR;
    LDA(At,0,1); STAGE(SA(0,0),A,lda,voA,brow,t+2);
    BAR; WAIT_L(0); MMA(1,0,At,B0); BAR; SCHED;
    STAGE(SB(0,1),Bt,ldb,voB,bcol+HALF,t+2);
    WAIT_V(6); BAR; MMA(1,1,At,B1); BAR;
    LDB(B0,1,0); SCHED; LDA(At,1,0); STAGE(SA(0,1),A,lda,voA,brow+AH,t+2);
    if (MF == 4) WAIT_L(8); else WAIT_L(6); BAR; WAIT_L(0); MMA(0,0,At,B0); BAR; SCHED;
    LDB(B1,1,1); STAGE(SB(1,0),Bt,ldb,voB,bcol,t+3);
    BAR; WAIT_L(0); MMA(0,1,At,B1); BAR;
    LDA(At,1,1); STAGE(SA(1,0),A,lda,voA,brow,t+3);
    BAR; WAIT_L(0); MMA(1,0,At,B0); BAR; SCHED;
    STAGE(SB(1,1),Bt,ldb,voB,bcol+HALF,t+3);
    WAIT_V(6); BAR; MMA(1,1,At,B1); BAR;
  }
  { LDB(B0,0,0); LDA(At,0,0); STAGE(SA(1,1),A,lda,voA,brow+AH,nt-1);
    BAR; WAIT_L(0); MMA(0,0,At,B0); BAR;
    LDB(B1,0,1); BAR; WAIT_L(0); MMA(0,1,At,B1); BAR;
    LDA(At,0,1); WAIT_V(4); BAR; WAIT_L(0); MMA(1,0,At,B0); MMA(1,1,At,B1); BAR; }
  { LDB(B0,1,0); LDA(At,1,0); WAIT_V(2); BAR; WAIT_L(0); MMA(0,0,At,B0); BAR;
    LDB(B1,1,1); WAIT_V(0); BAR; WAIT_L(0); MMA(0,1,At,B1); BAR;
    LDA(At,1,1); BAR; WAIT_L(0); MMA(1,0,At,B0); MMA(1,1,At,B1); BAR; }
  if(wr==0)BAR;
  const int tid2 = tid_(); const int wid2 = tid2 >> 6, lane2 = tid2 & 63;
  if (g.mode <= 1) {
    unsigned char* st = dyn_shm;
    const int lrow = (wid2 >> 2) * (MF * 16) + (lane2 & 15), lcol = (wid2 & 3) * 32 + (lane2 >> 4) * 4;
    const bool sq = g.mode == 1;
#pragma unroll
    for(int ai=0;ai<2;++ai)
#pragma unroll
      for(int m=0;m<MF;++m)
#pragma unroll
        for(int bj=0;bj<2;++bj)
#pragma unroll
          for(int n=0;n<2;++n) {
            f32x4 v = acc[ai][bj][m][n];
            if (sq) { v[0] = fmaxf(v[0], 0.f); v[1] = fmaxf(v[1], 0.f); v[2] = fmaxf(v[2], 0.f); v[3] = fmaxf(v[3], 0.f); v = v * v; }
            u32x2 w; w.x = cvtpk(v[0], v[1]); w.y = cvtpk(v[2], v[3]);
            *(u32x2*)(st + (lrow + ai * AH + m * 16) * 544 + (lcol + bj * HALF + n * 16) * 2) = w;
          }
    __syncthreads();
#if PROBE_PH >= 0
    if (!g.dry)
#endif
    {
      bf16_t* ob = (bf16_t*)g.out + (size_t)brow * g.ldc + bcol;
      const int r0 = wid2 * (MF * 8) + (lane2 >> 5), c16 = (lane2 & 31);
#pragma unroll 4
      for (int i = 0; i < MF * 4; ++i) {
        const int r = r0 + 2 * i;
        u32x4 w = *(const u32x4*)(st + r * 544 + c16 * 16);
        *(u32x4*)(ob + (size_t)r * g.ldc + c16 * 8) = w;
      }
    }
  } else {
  const int erow = brow + (wid2 >> 2) * (MF * 16) + (lane2 & 15), ecol = bcol + (wid2 & 3) * 32 + (lane2 >> 4) * 4;
#pragma unroll
  for(int ai=0;ai<2;++ai)
#pragma unroll
    for(int m=0;m<MF;++m)
#pragma unroll
      for(int bj=0;bj<2;++bj)
#pragma unroll
        for(int n=0;n<2;++n)
          gemm_epi(g, erow+ai*AH+m*16, ecol+bj*HALF+n*16, acc[ai][bj][m][n]);
  }
#undef SA
#undef SB
#undef STAGE
#undef LDA
#undef LDB
#undef MMA
}

__device__ __forceinline__ void tile_of(int L, int nM, int nN, int nwg, int th, int& brow, int& bcol) {
  int wgid = L;
  { const int q = nwg / NXCD, r = nwg % NXCD, xcd = wgid % NXCD, off = wgid / NXCD; wgid = (xcd < r ? xcd * (q + 1) : r * (q + 1) + (xcd - r) * q) + off; }
  const int nig = WGM * nN, gid = wgid / nig, fm = gid * WGM, gsz = (nM - fm) < WGM ? (nM - fm) : WGM;
  brow = (fm + ((wgid % nig) % gsz)) * th; bcol = ((wgid % nig) / gsz) * BM;
}
__device__ __forceinline__ void gemm_phase(const GemmDesc& g) {
  const int G = gdim_();
  const bool m3 = (g.Mrows % 192) == 0 && g.N <= 1536;
  const int th = m3 ? 192 : 256;
  const int nM = g.Mrows / th, nN = g.N / BM, nwg = nM * nN;
  for (int L = bid_(); L < nwg; L += G) {
    int brow, bcol; tile_of(L, nM, nN, nwg, th, brow, bcol);
    if (m3) gemm_tile<3>(g, brow, bcol); else gemm_tile<4>(g, brow, bcol);
  }
}

constexpr float ATT_SCALE = 0.10206207261596577f;
constexpr float ATT_THR = 8.f;
constexpr int SHM_V = 64 * 64 * 2, SHM_K = 64 * 128 * 2;
#define KSWZ(row, colB) ((row) * 256 + ((colB) ^ (((row) & 7) << 4)))
#define SBAR() __builtin_amdgcn_sched_barrier(0)
__device__ __forceinline__ int crow(int r, int hi) { return (r & 3) + 8 * (r >> 2) + 4 * hi; }

__device__ __forceinline__ void partialSM(f32x16& p0, f32x16& p1, float& m_reg, float& alpha, bool first) {
  constexpr float THRL = ATT_THR * 1.4426950408889634f;
  float pmax = p0[0];
#pragma unroll
  for (int r = 1; r < 16; ++r) pmax = fmaxf(pmax, p0[r]);
#pragma unroll
  for (int r = 0; r < 16; ++r) pmax = fmaxf(pmax, p1[r]);
  { auto rr = __builtin_amdgcn_permlane32_swap(__float_as_uint(pmax), __float_as_uint(pmax), false, false);
    pmax = fmaxf(__uint_as_float(rr[0]), __uint_as_float(rr[1])); }
  if (first) {
    alpha = 0.f; m_reg = pmax;
#pragma unroll
    for (int r = 0; r < 16; ++r) p0[r] -= pmax;
#pragma unroll
    for (int r = 0; r < 16; ++r) p1[r] -= pmax;
  } else if (__builtin_expect(__all(pmax <= THRL), 1)) { alpha = 1.f; }
  else { const float d = fmaxf(pmax, 0.f); alpha = __builtin_amdgcn_exp2f(-d); m_reg += d;
#pragma unroll
    for (int r = 0; r < 16; ++r) p0[r] -= d;
#pragma unroll
    for (int r = 0; r < 16; ++r) p1[r] -= d;
  }
#pragma unroll
  for (int r = 0; r < 16; ++r) p0[r] = __builtin_amdgcn_exp2f(p0[r]);
}
__device__ __forceinline__ void finishSM(f32x16& p0, f32x16& p1, float alpha, float& l_reg, bf16x8& pa0, bf16x8& pa1, bf16x8& pa2, bf16x8& pa3) {
#pragma unroll
  for (int r = 0; r < 16; ++r) p1[r] = __builtin_amdgcn_exp2f(p1[r]);
  float ps = 0;
#pragma unroll
  for (int r = 0; r < 16; ++r) ps += p0[r];
#pragma unroll
  for (int r = 0; r < 16; ++r) ps += p1[r];
  { auto rr = __builtin_amdgcn_permlane32_swap(__float_as_uint(ps), __float_as_uint(ps), false, false);
    ps = __uint_as_float(rr[0]) + __uint_as_float(rr[1]); }
  l_reg = l_reg * alpha + ps;
#define PK4(P, BASE, OUT) do { unsigned a0 = cvtpk(P[BASE + 0], P[BASE + 1]), a1 = cvtpk(P[BASE + 2], P[BASE + 3]);   \
    unsigned b0 = cvtpk(P[BASE + 4], P[BASE + 5]), b1 = cvtpk(P[BASE + 6], P[BASE + 7]);                              \
    auto r0 = __builtin_amdgcn_permlane32_swap(a0, b0, false, false); auto r1 = __builtin_amdgcn_permlane32_swap(a1, b1, false, false); \
    u32x4 w = {r0[0], r1[0], r0[1], r1[1]}; OUT = *reinterpret_cast<bf16x8*>(&w); } while (0)
  PK4(p0, 0, pa0); PK4(p0, 8, pa1); PK4(p1, 0, pa2); PK4(p1, 8, pa3);
#undef PK4
}
__device__ __forceinline__ void qkt(f32x16& p0, f32x16& p1, const unsigned char* Ks, const bf16x8* qr, int r32, int hi, float init) {
#pragma unroll
  for (int r = 0; r < 16; ++r) { p0[r] = init; p1[r] = init; }
#pragma unroll
  for (int d0 = 0; d0 < 6; ++d0) { int cb = (d0 * 16 + hi * 8) * 2;
    bf16x8 b0 = *reinterpret_cast<const bf16x8*>(Ks + KSWZ(r32, cb));
    bf16x8 b1 = *reinterpret_cast<const bf16x8*>(Ks + KSWZ(32 + r32, cb));
    p0 = __builtin_amdgcn_mfma_f32_32x32x16_bf16(b0, qr[d0], p0, 0, 0, 0);
    p1 = __builtin_amdgcn_mfma_f32_32x32x16_bf16(b1, qr[d0], p1, 0, 0, 0); }
}
__device__ __forceinline__ int v_st(int k, int c) { const int kk = (k & ~0xC) | ((k & 4) << 1) | ((k & 8) >> 1); return ((kk >> 3) * 2 + (c >> 5)) * 512 + ((kk & 7) * 32 + (c & 31)) * 2; }
__device__ __forceinline__ int v_rd_base(int lane) { return ((lane & 3) << 3) | (((lane >> 2) & 3) << 6) | (((lane >> 4) & 1) << 5) | (((lane >> 5) & 1) << 8); }
constexpr int v_rd_off(int d0, int ks, int half) { return d0 * 512 + ks * 2048 + half * 1024; }
template <int OFF> __device__ __forceinline__ s16x4 tr_read(int vb) {
  s16x4 r; asm volatile("ds_read_b64_tr_b16 %0, %1 offset:%2" : "=&v"(r) : "v"(vb), "i"(OFF) : "memory"); return r;
}
__device__ __forceinline__ void pv_d0(f32x16* o, int vb, bf16x8 pa0, bf16x8 pa1, bf16x8 pa2, bf16x8 pa3) {
  const s16x4 l0 = tr_read<v_rd_off(0, 0, 0)>(vb), h0 = tr_read<v_rd_off(0, 0, 1)>(vb), l1 = tr_read<v_rd_off(0, 1, 0)>(vb), h1 = tr_read<v_rd_off(0, 1, 1)>(vb);
  const s16x4 l2 = tr_read<v_rd_off(0, 2, 0)>(vb), h2 = tr_read<v_rd_off(0, 2, 1)>(vb), l3 = tr_read<v_rd_off(0, 3, 0)>(vb), h3 = tr_read<v_rd_off(0, 3, 1)>(vb);
  const s16x4 m0 = tr_read<v_rd_off(1, 0, 0)>(vb), n0 = tr_read<v_rd_off(1, 0, 1)>(vb), m1 = tr_read<v_rd_off(1, 1, 0)>(vb), n1 = tr_read<v_rd_off(1, 1, 1)>(vb);
  const s16x4 m2 = tr_read<v_rd_off(1, 2, 0)>(vb), n2 = tr_read<v_rd_off(1, 2, 1)>(vb), m3 = tr_read<v_rd_off(1, 3, 0)>(vb), n3 = tr_read<v_rd_off(1, 3, 1)>(vb);
  asm volatile("s_waitcnt lgkmcnt(0)" ::: "memory"); SBAR();
#define PK(L, H) (bf16x8){L[0], L[1], L[2], L[3], H[0], H[1], H[2], H[3]}
  o[0] = __builtin_amdgcn_mfma_f32_32x32x16_bf16(pa0, PK(l0, h0), o[0], 0, 0, 0);
  o[1] = __builtin_amdgcn_mfma_f32_32x32x16_bf16(pa0, PK(m0, n0), o[1], 0, 0, 0);
  o[0] = __builtin_amdgcn_mfma_f32_32x32x16_bf16(pa1, PK(l1, h1), o[0], 0, 0, 0);
  o[1] = __builtin_amdgcn_mfma_f32_32x32x16_bf16(pa1, PK(m1, n1), o[1], 0, 0, 0);
  o[0] = __builtin_amdgcn_mfma_f32_32x32x16_bf16(pa2, PK(l2, h2), o[0], 0, 0, 0);
  o[1] = __builtin_amdgcn_mfma_f32_32x32x16_bf16(pa2, PK(m2, n2), o[1], 0, 0, 0);
  o[0] = __builtin_amdgcn_mfma_f32_32x32x16_bf16(pa3, PK(l3, h3), o[0], 0, 0, 0);
  o[1] = __builtin_amdgcn_mfma_f32_32x32x16_bf16(pa3, PK(m3, n3), o[1], 0, 0, 0);
#undef PK
}

__device__ __forceinline__ void attn_unit(bf16_t* Qrows, int h, const bf16_t* KVb, const bf16_t* KPb, int nkeys, bool rope, int s0, const float* ropetab, int dry) {
  unsigned char* lds = dyn_shm;
  const int tid = tid_(), wid = tid >> 6, lane = tid & 63, r32 = lane & 31, hi = lane >> 5;
  unsigned char* V_lds = lds; unsigned char* K_lds = lds + 2 * SHM_V;
  float* ws = (float*)(lds + 2 * SHM_V + 2 * SHM_K) + wid * 64; float* li_l = ws; float* al_l = ws + 32;
  float m_reg = -1e30f, l_reg = 0; f32x16 o[2] = {}; bf16x8 qr[6];
  __syncthreads();
  {
    const int row = wid * 32 + r32;
    const bf16_t* Qn = Qrows + (size_t)row * 1536 + h * 64 + hi * 8;
#pragma unroll
    for (int d0 = 0; d0 < 4; ++d0) qr[d0] = *reinterpret_cast<const bf16x8*>(Qn + d0 * 16);
    const bf16_t* Qp = Qrows + (size_t)row * 1536 + 1024 + h * 32;
    const int s = s0 + row;
#pragma unroll
    for (int blk = 0; blk < 2; ++blk) {
      bf16x8 x1 = *reinterpret_cast<const bf16x8*>(Qp + blk * 16), x2 = *reinterpret_cast<const bf16x8*>(Qp + blk * 16 + 8);
      if (rope) {
        const int pos = blk == 0 ? (s >> 6) : (s & 63);
        const float* tb = ropetab + pos * 16;
        float ov[8];
#pragma unroll
        for (int j = 0; j < 8; ++j) {
          float a = bf2f((bf16_t)x1[j]), b = bf2f((bf16_t)x2[j]), cs = tb[2 * j], sn = tb[2 * j + 1];
          ov[j] = hi == 0 ? a * cs - b * sn : b * cs + a * sn;
        }
        u32x4 w = {cvtpk(ov[0], ov[1]), cvtpk(ov[2], ov[3]), cvtpk(ov[4], ov[5]), cvtpk(ov[6], ov[7])};
        qr[4 + blk] = *reinterpret_cast<bf16x8*>(&w);
      } else {
        qr[4 + blk] = hi == 0 ? x1 : x2;
      }
    }
  }
  const int vrow = tid >> 3, vc = (tid & 7) * 8, vst = v_st(vrow, vc);
  const bf16_t* vsrc = KVb + (size_t)vrow * 2048 + h * 128 + 64 + vc;
  const bool kact = tid < 384;
  const int kr = kact ? tid / 12 : 0, kc = kact ? (tid % 12) * 8 : 0;
  const bf16_t* ksrc = kc < 64 ? KVb + (size_t)kr * 2048 + h * 128 + kc : KPb + (size_t)kr * 32 + (kc - 64);
  const long kstride = kc < 64 ? 2048 : 32;
  const int kst0 = KSWZ(kr, kc * 2), kst1 = KSWZ(32 + kr, kc * 2);
  const int vb0 = (int)(uintptr_t)V_lds + v_rd_base(lane);
  struct { bf16x8 vs, ks0, ks1; } sr_[2];
#define SLOAD(i, k0) do { sr_[i].vs = *reinterpret_cast<const bf16x8*>(vsrc + (size_t)(k0) * 2048); \
    if (kact) { sr_[i].ks0 = *reinterpret_cast<const bf16x8*>(ksrc + (long)(k0) * kstride); sr_[i].ks1 = *reinterpret_cast<const bf16x8*>(ksrc + (long)((k0) + 32) * kstride); } } while (0)
#define SWRITE(b, i) do { *(bf16x8*)(V_lds + (b) * SHM_V + vst) = sr_[i].vs; \
    if (kact) { *(bf16x8*)(K_lds + (b) * SHM_K + kst0) = sr_[i].ks0; *(bf16x8*)(K_lds + (b) * SHM_K + kst1) = sr_[i].ks1; } } while (0)
#define RESC(a) do { if (__any((a) < 1.f)) { if (hi == 0) al_l[r32] = (a); asm volatile("s_waitcnt lgkmcnt(0)" ::: "memory"); \
    for (int d = 0; d < 2; ++d) for (int r = 0; r < 16; ++r) o[d][r] *= al_l[crow(r, hi)]; } } while (0)
  f32x16 pA0, pA1, pB0, pB1; float alA, alB; bf16x8 pa0, pa1, pa2, pa3; const int NT = nkeys / 64;
  constexpr int SE = 0, SO = 1;
  SLOAD(SE, 0); SWRITE(0, SE); __syncthreads();
  qkt(pA0, pA1, K_lds, qr, r32, hi, 0.f); partialSM(pA0, pA1, m_reg, alA, true);
  SLOAD(SO, 64); if (2 < NT) SLOAD(SE, 128);
  SWRITE(1, SO); __syncthreads();
  for (int j = 1; j + 1 < NT; j += 2) {
    SBAR(); qkt(pB0, pB1, K_lds + SHM_K, qr, r32, hi, -m_reg);
    finishSM(pA0, pA1, alA, l_reg, pa0, pa1, pa2, pa3); SBAR();
    SLOAD(SO, (j + 2) * 64); SBAR();
    pv_d0(o, vb0, pa0, pa1, pa2, pa3); partialSM(pB0, pB1, m_reg, alB, false);
    __syncthreads(); SWRITE(0, SE);
    RESC(alB); __syncthreads();
    SBAR(); qkt(pA0, pA1, K_lds, qr, r32, hi, -m_reg);
    finishSM(pB0, pB1, alB, l_reg, pa0, pa1, pa2, pa3); SBAR();
    if (j + 3 < NT) SLOAD(SE, (j + 3) * 64); SBAR();
    pv_d0(o, vb0 + SHM_V, pa0, pa1, pa2, pa3); partialSM(pA0, pA1, m_reg, alA, false);
    __syncthreads(); SWRITE(1, SO);
    RESC(alA); __syncthreads();
  }
  SBAR(); qkt(pB0, pB1, K_lds + SHM_K, qr, r32, hi, -m_reg);
  finishSM(pA0, pA1, alA, l_reg, pa0, pa1, pa2, pa3); SBAR();
  pv_d0(o, vb0, pa0, pa1, pa2, pa3); partialSM(pB0, pB1, m_reg, alB, false);
  __syncthreads(); RESC(alB);
  finishSM(pB0, pB1, alB, l_reg, pa0, pa1, pa2, pa3); SBAR();
  pv_d0(o, vb0 + SHM_V, pa0, pa1, pa2, pa3);
  if (hi == 0) li_l[r32] = l_reg; asm volatile("s_waitcnt lgkmcnt(0)" ::: "memory");
  float rli[16];
#pragma unroll
  for (int r = 0; r < 16; ++r) rli[r] = __builtin_amdgcn_rcpf(li_l[crow(r, hi)]);
  bf16_t* Ow = Qrows + (size_t)(wid * 32) * 1536 + h * 64;
  if (!dry)
#pragma unroll
  for (int r = 0; r < 16; ++r) { int orow = crow(r, hi);
#pragma unroll
    for (int d0 = 0; d0 < 2; ++d0) Ow[(size_t)orow * 1536 + d0 * 32 + r32] = f2bf(o[d0][r] * rli[r]); }
#undef SLOAD
#undef SWRITE
#undef RESC
}

__device__ __forceinline__ void attn_phase(KP p, int dry) {
  bf16_t* Q = (bf16_t*)(p->ws + WS_Q); const bf16_t* KV = (const bf16_t*)(p->ws + WS_KV); const bf16_t* KP = (const bf16_t*)(p->ws + WS_KPE);
  const float* ropetab = (const float*)(p->ws + WS_ROPE);
  const int xcd = bid_() & 7, slot = bid_() >> 3;
  const int G = gdim_();
  const int nit = G == 256 ? 6 : (1536 + G - 1) / G;
  for (int i = 0; i < nit; ++i) {
    int u;
    if (G == 256) u = i < 4 ? ((i * 16 + xcd * 2 + (slot >> 4)) << 4) + (slot & 15) : 1024 + (i - 4) * 256 + xcd * 32 + slot;
    else { u = bid_() + i * G; if (u >= 1536) break; }
    const bool samp = u < 1024;
    const int pair = samp ? u >> 4 : u - 1024, qb = samp ? u & 15 : 0, b = pair >> 4, h = pair & 15;
    const size_t qrow = samp ? (size_t)(MP + b * DSEQ + qb * 256) : (size_t)(b * SEQ);
    const size_t krow = samp ? (size_t)(MP + b * SKEYS) : (size_t)(b * SEQ);
    attn_unit(Q + qrow * 1536, h, KV + krow * 2048, KP + krow * 32, samp ? SKEYS : SEQ, samp, qb * 256, ropetab, dry);
  }
}

__device__ void mod_gemv_item(KP p, int it) {
  float* lds = (float*)dyn_shm;
  const int l = it / 96, n0 = (it % 96) * 64, tid = tid_();
  const float* wmod = p->in[l == 0 ? 7 : 24]; const float* bmod = p->in[l == 0 ? 8 : 25];
  __syncthreads();
  for (int e = tid; e < 5 * 1024; e += 512) { int c = e >> 10, k = e & 1023; float v = c == 0 ? p->in[6][k] : p->in[5][(c - 1) * 1024 + k]; lds[e] = v / (1.f + __expf(-v)); }
  __syncthreads();
  const int col = tid & 63, ks = tid >> 6;
  float a0 = 0, a1 = 0, a2 = 0, a3 = 0, a4 = 0;
  const float* wp = wmod + (size_t)(ks * 128) * 6144 + n0 + col;
#pragma unroll 8
  for (int k = 0; k < 128; ++k) { float w = wp[(size_t)k * 6144]; int kk = ks * 128 + k;
    a0 += lds[kk] * w; a1 += lds[1024 + kk] * w; a2 += lds[2048 + kk] * w; a3 += lds[3072 + kk] * w; a4 += lds[4096 + kk] * w; }
  float* red = lds + 5 * 1024;
  red[(ks * 5 + 0) * 64 + col] = a0; red[(ks * 5 + 1) * 64 + col] = a1; red[(ks * 5 + 2) * 64 + col] = a2; red[(ks * 5 + 3) * 64 + col] = a3; red[(ks * 5 + 4) * 64 + col] = a4;
  __syncthreads();
  if (tid < 320) { int c = tid >> 6, cc = tid & 63; float s = 0;
#pragma unroll
    for (int k8 = 0; k8 < 8; ++k8) s += red[(k8 * 5 + c) * 64 + cc];
    ((float*)(p->ws + WS_MOD))[(l * 5 + c) * 6144 + n0 + cc] = s + bmod[n0 + cc]; }
}

struct CvtMat { const float* src; int K, N, Npad; bf16_t* dst; int ldk, perm; };
__device__ __forceinline__ CvtMat get_mat(KP p, int layer, int i) {
  bf16_t* WB = (bf16_t*)(p->ws + WS_WB);
  if (layer == 0) {
    switch (i) {
      case 0: return CvtMat{p->in[11], 1024, 1536, 1536, WB + W0_IN, 1024, 0};
      case 1: return CvtMat{p->in[21], 1024, 1024, 1024, WB + W0_OUT, 1024, 0};
      case 2: return CvtMat{p->in[22], 1024, 4096, 4096, WB + W0_W1, 1024, 0};
      default: return CvtMat{p->in[23], 4096, 1024, 1024, WB + W0_W2, 4096, 0};
    }
  } else {
    switch (i) {
      case 0: return CvtMat{p->in[28], 1024, 672, 768, WB + W1_IN, 1024, 0};
      case 1: return CvtMat{p->in[30], 384, 1536, 1536, WB + W1_QB, 384, 1};
      case 2: return CvtMat{p->in[32], 256, 2048, 2048, WB + W1_KVB, 256, 0};
      case 3: return CvtMat{p->in[33], 1024, 1024, 1024, WB + W1_OUT, 1024, 0};
      case 4: return CvtMat{p->in[34], 1024, 4096, 4096, WB + W1_W1, 1024, 0};
      default: return CvtMat{p->in[35], 4096, 1024, 1024, WB + W1_W2, 4096, 0};
    }
  }
}
struct CvtTile { const float* src; int K, N; bf16_t* dst; int ldk, perm, k0, n0; };
__device__ __forceinline__ CvtTile cvt_desc(KP p, int layer, int t, int total) {
  bf16_t* WB = (bf16_t*)(p->ws + WS_WB);
  const int nm = layer == 0 ? 4 : 6;
  if (t < total) {
    int tt = t, i = 0;
    for (; i < nm - 1; ++i) { CvtMat m = get_mat(p, layer, i); int c = (m.K / 64) * (m.Npad / 64); if (tt < c) break; tt -= c; }
    const CvtMat m = get_mat(p, layer, i);
    const int nn = m.Npad / 64;
    return CvtTile{m.src, m.K, m.N, m.dst, m.ldk, m.perm, (tt / nn) * 64, (tt % nn) * 64};
  }
  const int e = t - total;
  if (e < 32) {
    const int dg = e >> 3, nb = e & 7, dir = dg >> 1, gate = dg & 1;
    return CvtTile{p->in[gate == 0 ? 14 : 16] + (size_t)(dir * 8 + nb) * 4096, 64, 64, WB + W0_G + (size_t)e * 4096, 64, 0, 0, 0};
  }
  const int e2 = e - 32, gi = e2 >> 2, q = e2 & 3;
  return CvtTile{p->in[19] + (size_t)gi * 16384, 128, 128, WB + W0_P + (size_t)gi * 16384, 128, 0, (q >> 1) * 64, (q & 1) * 64};
}
__device__ __forceinline__ void cvt_load(const CvtTile& d, int tid, f32x4& v0, f32x4& v1) {
  const int kk = tid >> 4, n4 = (tid & 15) * 4;
  const f32x4 zero = {0.f, 0.f, 0.f, 0.f};
  const bool ok = d.n0 + n4 < d.N;
  const float* sp = d.src + (size_t)(d.k0 + kk) * d.N + d.n0 + (ok ? n4 : 0);
  v0 = ok ? *(const f32x4*)sp : zero;
  v1 = ok ? *(const f32x4*)(sp + (size_t)32 * d.N) : zero;
}
__device__ void cvt_weights(KP p, int layer, int start, int stride) {
  float* tile = (float*)dyn_shm;
  const int total = layer == 0 ? 384 + 256 + 1024 + 1024 : 192 + 144 + 128 + 256 + 1024 + 1024;
  const int all = total + (layer == 0 ? 32 + 16 : 0);
  const int tid = tid_();
  int t = start;
  if (t >= all) return;
  CvtTile d = cvt_desc(p, layer, t, total);
  f32x4 v0, v1; cvt_load(d, tid, v0, v1);
  for (;;) {
    const int kk = tid >> 4, n4 = (tid & 15) * 4;
    __syncthreads();
    tile[kk * 65 + n4 + 0] = v0[0]; tile[kk * 65 + n4 + 1] = v0[1]; tile[kk * 65 + n4 + 2] = v0[2]; tile[kk * 65 + n4 + 3] = v0[3];
    tile[(kk + 32) * 65 + n4 + 0] = v1[0]; tile[(kk + 32) * 65 + n4 + 1] = v1[1]; tile[(kk + 32) * 65 + n4 + 2] = v1[2]; tile[(kk + 32) * 65 + n4 + 3] = v1[3];
    __syncthreads();
    const int tn = t + stride; const bool more = tn < all;
    CvtTile dn = d;
    if (more) { dn = cvt_desc(p, layer, tn, total); cvt_load(dn, tid, v0, v1); }
    {
      int n = tid >> 3, k8 = (tid & 7) * 8, ng = d.n0 + n;
      if (d.perm) { int hh = ng / 96, dd = ng % 96; ng = dd < 64 ? hh * 64 + dd : 1024 + hh * 32 + (dd - 64); }
      float v[8];
#pragma unroll
      for (int j = 0; j < 8; ++j) v[j] = tile[(k8 + j) * 65 + n];
      const float wsc = d.perm ? ATT_SCALE * 1.4426950408889634f : 1.f;
      u32x4 w = {cvtpk(v[0] * wsc, v[1] * wsc), cvtpk(v[2] * wsc, v[3] * wsc), cvtpk(v[4] * wsc, v[5] * wsc), cvtpk(v[6] * wsc, v[7] * wsc)};
      *(u32x4*)(d.dst + (size_t)ng * d.ldk + d.k0 + k8) = w;
    }
    if (!more) break;
    t = tn; d = dn;
  }
}

__device__ __forceinline__ void mod_row_store(bf16_t* H, int row, int lane, const f32x4 (&x)[4], const f32x4 (&gv)[4], float ss, const float* modl, int chunk_shift) {
  const float rstd = rsqrtf(ss * (1.f / DM) + EPS);
  const float* mc = modl + cond_of_row(row) * 6144 + chunk_shift * 1024;
#pragma unroll
  for (int i = 0; i < 4; ++i) {
    const int col = (i * 64 + lane) * 4;
    f32x4 sh = *(const f32x4*)(mc + col), sc = *(const f32x4*)(mc + 1024 + col);
    f32x4 y = x[i] * rstd * gv[i] * (sc + 1.f) + sh;
    u32x2 w; w.x = cvtpk(y[0], y[1]); w.y = cvtpk(y[2], y[3]);
    *(u32x2*)(H + (size_t)row * DM + col) = w;
  }
}
__device__ void modulate_phase(KP p, const float* src0, const float* src1, const float* g, const float* modl, int chunk_shift) {
  bf16_t* H = (bf16_t*)(p->ws + WS_H);
  const int tid = tid_(); const int wid = tid >> 6, lane = tid & 63;
  f32x4 gv[4];
#pragma unroll
  for (int i = 0; i < 4; ++i) gv[i] = *(const f32x4*)(g + (i * 64 + lane) * 4);
  const int stride = gdim_() * 8;
  for (int row = bid_() * 8 + wid; row < M; row += 2 * stride) {
    const int row2 = row + stride; const bool v2 = row2 < M; const int r2 = v2 ? row2 : row;
    const float* xp = row < MP ? src0 + (size_t)row * DM : src1 + (size_t)(row - MP) * DM;
    const float* xq = r2 < MP ? src0 + (size_t)r2 * DM : src1 + (size_t)(r2 - MP) * DM;
    f32x4 x[4], z[4]; float ss = 0, s2 = 0;
#pragma unroll
    for (int i = 0; i < 4; ++i) { x[i] = *(const f32x4*)(xp + (i * 64 + lane) * 4); z[i] = *(const f32x4*)(xq + (i * 64 + lane) * 4); }
#pragma unroll
    for (int i = 0; i < 4; ++i) { ss += x[i][0] * x[i][0] + x[i][1] * x[i][1] + x[i][2] * x[i][2] + x[i][3] * x[i][3]; s2 += z[i][0] * z[i][0] + z[i][1] * z[i][1] + z[i][2] * z[i][2] + z[i][3] * z[i][3]; }
    ss = wave_sum(ss, lane); s2 = wave_sum(s2, lane);
    mod_row_store(H, row, lane, x, gv, ss, modl, chunk_shift);
    if (v2) mod_row_store(H, row2, lane, z, gv, s2, modl, chunk_shift);
  }
}
__device__ void final_norm_phase(KP p, int dry) {
  float* X = p->out; const float* g = p->in[36];
  const int tid = tid_(); const int wid = tid >> 6, lane = tid & 63;
  f32x4 gv[4];
#pragma unroll
  for (int i = 0; i < 4; ++i) gv[i] = *(const f32x4*)(g + (i * 64 + lane) * 4);
  const int stride = gdim_() * 8;
  for (int row = bid_() * 8 + wid; row < M; row += 2 * stride) {
    const int row2 = row + stride; const bool v2 = row2 < M; const int r2 = v2 ? row2 : row;
    float* xp = X + (size_t)row * DM; float* xq = X + (size_t)r2 * DM;
    f32x4 x[4], z[4]; float ss = 0, s2 = 0;
#pragma unroll
    for (int i = 0; i < 4; ++i) { x[i] = *(const f32x4*)(xp + (i * 64 + lane) * 4); z[i] = *(const f32x4*)(xq + (i * 64 + lane) * 4); }
#pragma unroll
    for (int i = 0; i < 4; ++i) { ss += x[i][0] * x[i][0] + x[i][1] * x[i][1] + x[i][2] * x[i][2] + x[i][3] * x[i][3]; s2 += z[i][0] * z[i][0] + z[i][1] * z[i][1] + z[i][2] * z[i][2] + z[i][3] * z[i][3]; }
    ss = wave_sum(ss, lane); s2 = wave_sum(s2, lane);
    const float rstd = rsqrtf(ss * (1.f / DM) + EPS), rstd2 = rsqrtf(s2 * (1.f / DM) + EPS);
    if (!dry) {
#pragma unroll
      for (int i = 0; i < 4; ++i) *(f32x4*)(xp + (i * 64 + lane) * 4) = x[i] * rstd * gv[i];
      if (v2) {
#pragma unroll
        for (int i = 0; i < 4; ++i) *(f32x4*)(xq + (i * 64 + lane) * 4) = z[i] * rstd2 * gv[i];
      }
    }
  }
}
struct L1Row { f32x4 qa, qb, kv; float kp; };
__device__ __forceinline__ void l1_row_load(const float* Z1, int row, int lane, L1Row& r) {
  const float* z = Z1 + (size_t)row * 768;
  const f32x4 zero = {0.f, 0.f, 0.f, 0.f};
  r.qa = lane < 48 ? *(const f32x4*)(z + lane * 4) : zero;
  r.qb = lane < 48 ? *(const f32x4*)(z + 192 + lane * 4) : zero;
  r.kv = *(const f32x4*)(z + 384 + lane * 4);
  r.kp = lane < 32 ? z[640 + lane] : 0.f;
}
__device__ __forceinline__ void l1_row_finish(KP p, int row, int lane, const L1Row& r, const f32x4& gqa, const f32x4& gqb, const f32x4& gk) {
  bf16_t* CQN = (bf16_t*)(p->ws + WS_CQN); bf16_t* CKVN = (bf16_t*)(p->ws + WS_CKVN); bf16_t* KPE = (bf16_t*)(p->ws + WS_KPE);
  const float* ropetab = (const float*)(p->ws + WS_ROPE);
  float ss = r.qa[0] * r.qa[0] + r.qa[1] * r.qa[1] + r.qa[2] * r.qa[2] + r.qa[3] * r.qa[3] + r.qb[0] * r.qb[0] + r.qb[1] * r.qb[1] + r.qb[2] * r.qb[2] + r.qb[3] * r.qb[3];
  ss = wave_sum(ss, lane);
  const float rstd = rsqrtf(ss * (1.f / 384) + EPS);
  if (lane < 48) {
    const f32x4 ya = r.qa * rstd * gqa, yb = r.qb * rstd * gqb;
    u32x2 wa; wa.x = cvtpk(ya[0], ya[1]); wa.y = cvtpk(ya[2], ya[3]);
    u32x2 wb; wb.x = cvtpk(yb[0], yb[1]); wb.y = cvtpk(yb[2], yb[3]);
    *(u32x2*)(CQN + (size_t)row * 384 + lane * 4) = wa; *(u32x2*)(CQN + (size_t)row * 384 + 192 + lane * 4) = wb;
  }
  const float s2 = wave_sum(r.kv[0] * r.kv[0] + r.kv[1] * r.kv[1] + r.kv[2] * r.kv[2] + r.kv[3] * r.kv[3], lane);
  const float r2 = rsqrtf(s2 * (1.f / 256) + EPS);
  const f32x4 y = r.kv * r2 * gk;
  int krow; bool rope; int s = 0;
  if (row < MP) { krow = row; rope = false; *(f32x4*)(p->out + O_CKV + (size_t)row * 256 + lane * 4) = y; }
  else { int b = (row - MP) >> 12; s = (row - MP) & 4095; krow = MP + b * SKEYS + s; rope = true; }
  u32x2 w; w.x = cvtpk(y[0], y[1]); w.y = cvtpk(y[2], y[3]);
  *(u32x2*)(CKVN + (size_t)krow * 256 + lane * 4) = w;
  const float kp = r.kp;
  const float partner = lane_xor(kp, lane, 8);
  if (!rope) { if (lane < 32) { p->out[O_KPE + (size_t)row * 32 + lane] = kp; KPE[(size_t)krow * 32 + lane] = f2bf(kp); } }
  else if (lane < 32) {
    int pos = lane < 16 ? (s >> 6) : (s & 63); int j = lane & 7;
    float cs = ropetab[pos * 16 + 2 * j], sn = ropetab[pos * 16 + 2 * j + 1];
    float ov = (lane & 8) == 0 ? kp * cs - partner * sn : kp * cs + partner * sn;
    KPE[(size_t)krow * 32 + lane] = f2bf(ov);
  }
}
__device__ void l1_rows_phase(KP p) {
  const float* Z1 = (const float*)(p->ws + WS_Z1);
  bf16_t* CKVN = (bf16_t*)(p->ws + WS_CKVN); bf16_t* KPE = (bf16_t*)(p->ws + WS_KPE);
  const int tid = tid_(); const int wid = tid >> 6, lane = tid & 63;
  const int l48 = lane < 48 ? lane : 0;
  const f32x4 gqa = *(const f32x4*)(p->in[29] + l48 * 4), gqb = *(const f32x4*)(p->in[29] + 192 + l48 * 4), gk = *(const f32x4*)(p->in[31] + lane * 4);
  const int stride = gdim_() * 8;
  for (int row = bid_() * 8 + wid; row < M; row += 2 * stride) {
    const int row2 = row + stride; const bool v2 = row2 < M;
    L1Row ra, rb;
    l1_row_load(Z1, row, lane, ra); l1_row_load(Z1, v2 ? row2 : row, lane, rb);
    l1_row_finish(p, row, lane, ra, gqa, gqb, gk);
    if (v2) l1_row_finish(p, row2, lane, rb, gqa, gqb, gk);
  }
  for (int idx = bid_() * 8 + wid; idx < NB_S * PAST; idx += stride) {
    const int b = idx >> 9, j = idx & 511, krow = MP + b * SKEYS + DSEQ + j;
    f32x4 kv = *(const f32x4*)(p->in[3] + ((size_t)(b * PAST + j)) * 256 + lane * 4);
    u32x2 w; w.x = cvtpk(kv[0], kv[1]); w.y = cvtpk(kv[2], kv[3]);
    *(u32x2*)(CKVN + (size_t)krow * 256 + lane * 4) = w;
    if (lane < 32) KPE[(size_t)krow * 32 + lane] = f2bf(p->in[4][((size_t)(b * PAST + j)) * 32 + lane]);
  }
}

__device__ __forceinline__ float fast_sigmoid(float x) { return __builtin_amdgcn_rcpf(1.f + __expf(-x)); }
__device__ __forceinline__ float fast_gelu(float x) {
  float u = 0.7978845608028654f * (x + 0.044715f * x * x * x);
  float e = __expf(2.f * u);
  float th = 1.f - 2.f * __builtin_amdgcn_rcpf(e + 1.f);
  return 0.5f * x * (1.f + th);
}
__device__ __forceinline__ float bperm(int srclane, float v) { return __int_as_float(__builtin_amdgcn_ds_bpermute(srclane << 2, __float_as_int(v))); }
__device__ __forceinline__ void scan4(float& P, float& H, int lane, int stepl, int oq) {
  { const float Pp = bperm(lane - stepl, P), Hp = bperm(lane - stepl, H); if (oq >= 1) { H = P * Hp + H; P = Pp * P; } }
  { const float Pp = bperm(lane - 2 * stepl, P), Hp = bperm(lane - 2 * stepl, H); if (oq >= 2) { H = P * Hp + H; P = Pp * P; } }
}
__device__ void lru_item(KP p, int cidx, int nb, int mode) {
  const bf16_t* Z0 = (const bf16_t*)(p->ws + WS_Z0); bf16_t* H = (bf16_t*)(p->ws + WS_H);
  const bf16_t* Wg = (const bf16_t*)(p->ws + WS_WB) + W0_G;
  const float* LS8 = (const float*)(p->ws + WS_LS8);
  float2* SUM = (float2*)(p->ws + WS_SUM);
  float* xrL = (float*)dyn_shm;
  float* xc = xrL + 67 * 64;
  bf16_t* xcb = (bf16_t*)(xc + 64 * 64);
  float* Hs = (float*)(xcb + 64 * 72);
  const int tid = tid_(), lane = tid & 63, fr = lane & 15, fq = lane >> 4;
  const int wid = __builtin_amdgcn_readfirstlane(tid >> 6), dir = wid >> 2, wq = wid & 3;
  const int t0 = cidx * 64;
  int s0, s1, bsamp = -1;
  if (t0 < MP) { s0 = (t0 / SEQ) * SEQ; s1 = s0 + SEQ; } else { bsamp = (t0 - MP) / DSEQ; s0 = MP + bsamp * DSEQ; s1 = s0 + DSEQ; }
  const int c0 = s0 / 64, c1 = s1 / 64;
  const int chc = tid & 63, cgc = nb * 64 + chc;
  const int ch = wq * 16 + fr, cg_ = nb * 64 + ch;
  const int oq = dir ? 3 - fq : fq, stepl = dir ? -16 : 16, lastl = fr + (dir ? 0 : 48);
  unsigned xv[5];
#pragma unroll
  for (int i = 0; i < 5; ++i) { int e = tid + i * 512; int r = e >> 5, c2 = (e & 31) * 2, t = t0 - 2 + r;
    xv[i] = (e < 67 * 32 && t >= s0 && t < s1) ? *(const unsigned*)(Z0 + (size_t)t * 1536 + nb * 64 + c2) : 0u; }
  const float* cw = p->in[12];
  const float w0 = cw[cgc], w1 = cw[512 + cgc], w2 = cw[1024 + cgc], w3 = cw[1536 + cgc], bb = p->in[13][cgc];
  const float ba = p->in[15][dir * 512 + cg_], bi = p->in[17][dir * 512 + cg_], l8 = LS8[dir * 512 + cg_];
  bf16x8 wa[2], wi[2];
  { const bf16_t* pa = Wg + (size_t)((dir * 2 + 0) * 8 + nb) * 4096 + (size_t)ch * 64 + fq * 8; const bf16_t* pi = pa + 8 * 4096;
    wa[0] = *(const bf16x8*)pa; wa[1] = *(const bf16x8*)(pa + 32); wi[0] = *(const bf16x8*)pi; wi[1] = *(const bf16x8*)(pi + 32); }
  unsigned gz[4] = {0u, 0u, 0u, 0u};
  if (mode == 1) {
#pragma unroll
    for (int i = 0; i < 4; ++i) { int e = tid + i * 512; int t = e >> 5, c2 = (e & 31) * 2; gz[i] = *(const unsigned*)(Z0 + (size_t)(t0 + t) * 1536 + 512 + nb * 64 + c2); }
  }
  float cP = 1.f, cH = 0.f;
  if (mode == 1) {
    int lo, hi;
    if (dir == 0) { const int n = cidx - c0, q = (n + 3) >> 2; lo = c0 + fq * q; hi = lo + q < cidx ? lo + q : cidx;
      for (int c = lo; c < hi; c += 4) { float2 sm[4];
#pragma unroll
        for (int j = 0; j < 4; ++j) sm[j] = (c + j < hi) ? SUM[((size_t)(c + j) * 2) * 512 + cg_] : make_float2(1.f, 0.f);
#pragma unroll
        for (int j = 0; j < 4; ++j) { cH = sm[j].x * cH + sm[j].y; cP *= sm[j].x; } }
    } else { const int n = c1 - 1 - cidx, q = (n + 3) >> 2; hi = c1 - 1 - fq * q; lo = hi - q > cidx ? hi - q : cidx;
      for (int c = hi; c > lo; c -= 4) { float2 sm[4];
#pragma unroll
        for (int j = 0; j < 4; ++j) sm[j] = (c - j > lo) ? SUM[((size_t)(c - j) * 2 + 1) * 512 + cg_] : make_float2(1.f, 0.f);
#pragma unroll
        for (int j = 0; j < 4; ++j) { cH = sm[j].x * cH + sm[j].y; cP *= sm[j].x; } }
    }
  }
  __syncthreads();
#pragma unroll
  for (int i = 0; i < 5; ++i) { int e = tid + i * 512; if (e < 67 * 32) { int r = e >> 5, c2 = (e & 31) * 2;
    xrL[r * 64 + c2] = bf2f((bf16_t)(xv[i] & 0xffff)); xrL[r * 64 + c2 + 1] = bf2f((bf16_t)(xv[i] >> 16)); } }
  __syncthreads();
#pragma unroll
  for (int i = 0; i < 8; ++i) { int t = (tid >> 6) + 8 * i;
    float v = bb + w0 * xrL[t * 64 + chc] + w1 * xrL[(t + 1) * 64 + chc] + w2 * xrL[(t + 2) * 64 + chc] + w3 * xrL[(t + 3) * 64 + chc];
    xc[t * 64 + chc] = v; xcb[t * 72 + chc] = f2bf(v); }
  __syncthreads();
  float av[4][4], uv[4][4], Pt[4], Ht[4], Pe[4], He[4];
#pragma unroll
  for (int mt = 0; mt < 4; ++mt) {
    const bf16x8 a0 = *(const bf16x8*)(xcb + (mt * 16 + fr) * 72 + fq * 8), a1 = *(const bf16x8*)(xcb + (mt * 16 + fr) * 72 + 32 + fq * 8);
    f32x4 ga = {0.f, 0.f, 0.f, 0.f}, gi = {0.f, 0.f, 0.f, 0.f};
    ga = __builtin_amdgcn_mfma_f32_16x16x32_bf16(a0, wa[0], ga, 0, 0, 0); ga = __builtin_amdgcn_mfma_f32_16x16x32_bf16(a1, wa[1], ga, 0, 0, 0);
    gi = __builtin_amdgcn_mfma_f32_16x16x32_bf16(a0, wi[0], gi, 0, 0, 0); gi = __builtin_amdgcn_mfma_f32_16x16x32_bf16(a1, wi[1], gi, 0, 0, 0);
#pragma unroll
    for (int j = 0; j < 4; ++j) {
      const float ea = 1.f + __expf(fminf(-(ga[j] + ba), 40.f)), ei = 1.f + __expf(fminf(-(gi[j] + bi), 40.f));
      const float rc = __builtin_amdgcn_rcpf(ea * ei);
      const float r = rc * ei, ii = rc * ea;
      const float la = r * l8;
      const float a = __expf(la);
      const float x2 = 2.f * la;
      const float om = x2 > -0.25f ? -x2 * (1.f + x2 * 0.5f * (1.f + x2 * (1.f / 3.f) * (1.f + x2 * 0.25f * (1.f + x2 * 0.2f * (1.f + x2 * (1.f / 6.f)))))) : 1.f - a * a;
      av[mt][j] = a; uv[mt][j] = __builtin_amdgcn_sqrtf(fmaxf(om, 0.f)) * ii * xc[(mt * 16 + fq * 4 + j) * 64 + ch];
    }
    float P = 1.f, Hh = 0.f;
    if (dir == 0) {
#pragma unroll
      for (int j = 0; j < 4; ++j) { Hh = av[mt][j] * Hh + uv[mt][j]; P *= av[mt][j]; }
    } else {
#pragma unroll
      for (int j = 3; j >= 0; --j) { Hh = av[mt][j] * Hh + uv[mt][j]; P *= av[mt][j]; }
    }
    scan4(P, Hh, lane, stepl, oq);
    const float Pp = bperm(lane - stepl, P), Hp = bperm(lane - stepl, Hh);
    Pe[mt] = oq >= 1 ? Pp : 1.f; He[mt] = oq >= 1 ? Hp : 0.f;
    Pt[mt] = bperm(lastl, P); Ht[mt] = bperm(lastl, Hh);
  }
  if (mode == 0) {
    float P = 1.f, Hh = 0.f;
    if (dir == 0) {
#pragma unroll
      for (int mt = 0; mt < 4; ++mt) { Hh = Pt[mt] * Hh + Ht[mt]; P *= Pt[mt]; }
    } else {
#pragma unroll
      for (int mt = 3; mt >= 0; --mt) { Hh = Pt[mt] * Hh + Ht[mt]; P *= Pt[mt]; }
    }
    if (fq == 0) SUM[((size_t)cidx * 2 + dir) * 512 + cg_] = make_float2(P, Hh);
    return;
  }
  scan4(cP, cH, lane, 16, fq);
  const float tP = bperm(fr + 48, cP), tH = bperm(fr + 48, cH);
  float c = bsamp >= 0 ? p->in[2][(bsamp * 2 + dir) * 512 + cg_] : 0.f;
  c = tP * c + tH;
  float* hp = Hs + dir * 4096 + ch;
  if (dir == 0) {
#pragma unroll
    for (int mt = 0; mt < 4; ++mt) { float s = Pe[mt] * c + He[mt];
#pragma unroll
      for (int j = 0; j < 4; ++j) { s = av[mt][j] * s + uv[mt][j]; hp[(mt * 16 + fq * 4 + j) * 64] = s; }
      c = Pt[mt] * c + Ht[mt]; }
    if (bsamp < 0 && cidx == c1 - 1 && fq == 0) p->out[O_LRU + (size_t)((t0 / SEQ) * 2 + 0) * 512 + cg_] = c;
  } else {
#pragma unroll
    for (int mt = 3; mt >= 0; --mt) { float s = Pe[mt] * c + He[mt];
#pragma unroll
      for (int j = 3; j >= 0; --j) { s = av[mt][j] * s + uv[mt][j]; hp[(mt * 16 + fq * 4 + j) * 64] = s; }
      c = Pt[mt] * c + Ht[mt]; }
    if (bsamp < 0 && cidx == c0 && fq == 0) p->out[O_LRU + (size_t)((t0 / SEQ) * 2 + 1) * 512 + cg_] = c;
  }
  __syncthreads();
#pragma unroll
  for (int i = 0; i < 4; ++i) { int e = tid + i * 512; int t = e >> 5, c2 = (e & 31) * 2;
    float g0 = bf2f((bf16_t)(gz[i] & 0xffff)), g1 = bf2f((bf16_t)(gz[i] >> 16));
    float y0 = (Hs[t * 64 + c2] + Hs[4096 + t * 64 + c2]) * fast_gelu(g0);
    float y1 = (Hs[t * 64 + c2 + 1] + Hs[4096 + t * 64 + c2 + 1]) * fast_gelu(g1);
    *(unsigned*)(H + (size_t)(t0 + t) * DM + nb * 64 + c2) = cvtpk(y0, y1); }
}

__device__ void pool_item(KP p, int cidx, int gi) {
  const bf16_t* Z0 = (const bf16_t*)(p->ws + WS_Z0); bf16_t* H = (bf16_t*)(p->ws + WS_H);
  const bf16_t* Wp = (const bf16_t*)(p->ws + WS_WB) + W0_P + (size_t)gi * 16384;
  float* xp = (float*)dyn_shm;
  bf16_t* dL = (bf16_t*)(xp + 80 * 128);
  const int tid = tid_(), wid = tid >> 6, lane = tid & 63, fr = lane & 15, fq = lane >> 4;
  const int t0 = cidx * 64;
  int s0, s1;
  if (t0 < MP) { s0 = (t0 / SEQ) * SEQ; s1 = s0 + SEQ; } else { int b = (t0 - MP) / DSEQ; s0 = MP + b * DSEQ; s1 = s0 + DSEQ; }
  __syncthreads();
  for (int e = tid; e < 80 * 64; e += 512) { int r = e >> 6, c2 = (e & 63) * 2, t = t0 - 8 + r;
    float a = 0.f, b = 0.f;
    if (t >= s0 && t < s1) { unsigned v = *(const unsigned*)(Z0 + (size_t)t * 1536 + 1024 + gi * 128 + c2); a = bf2f((bf16_t)(v & 0xffff)); b = bf2f((bf16_t)(v >> 16)); }
    xp[r * 128 + c2] = a; xp[r * 128 + c2 + 1] = b; }
  __syncthreads();
  const int w = 2 << gi, left = w >> 1, right = w - 1 - left;
  {
    const int c = tid & 127, tq = tid >> 7, tb = tq * 16;
    float S = 0.f;
    for (int k = tb - left; k <= tb + right; ++k) S += xp[(k + 8) * 128 + c];
#pragma unroll
    for (int i = 0; i < 16; ++i) { const int t = tb + i, tg = t0 + t;
      const int lo = tg - left < s0 ? s0 : tg - left, hi = tg + right > s1 - 1 ? s1 - 1 : tg + right;
      const float d = S * __builtin_amdgcn_rcpf((float)(hi - lo + 1)) - xp[(t + 8) * 128 + c];
      dL[t * 136 + c] = f2bf(d);
      S += xp[(t + 1 + right + 8) * 128 + c] - xp[(t - left + 8) * 128 + c]; }
  }
  __syncthreads();
  {
    bf16x8 wf[4];
#pragma unroll
    for (int ks = 0; ks < 4; ++ks) wf[ks] = *(const bf16x8*)(Wp + (size_t)(wid * 16 + fr) * 128 + ks * 32 + fq * 8);
    const f32x4 sc = *(const f32x4*)(p->in[20] + gi * 128 + wid * 16 + fq * 4);
#pragma unroll
    for (int mt = 0; mt < 4; ++mt) {
      f32x4 acc = {0.f, 0.f, 0.f, 0.f};
#pragma unroll
      for (int ks = 0; ks < 4; ++ks) {
        bf16x8 df = *(const bf16x8*)(dL + (mt * 16 + fr) * 136 + ks * 32 + fq * 8);
        acc = __builtin_amdgcn_mfma_f32_16x16x32_bf16(wf[ks], df, acc, 0, 0, 0);
      }
      acc = acc * sc;
      u32x2 o; o.x = cvtpk(acc[0], acc[1]); o.y = cvtpk(acc[2], acc[3]);
      *(u32x2*)(H + (size_t)(t0 + mt * 16 + fr) * DM + 512 + gi * 128 + wid * 16 + fq * 4) = o;
    }
  }
}

__global__ void __launch_bounds__(512, 2) fwd_megakernel(Params kparams) {
  cg::grid_group grid = cg::this_grid();
  KP p = (KP)__builtin_amdgcn_kernarg_segment_ptr();
  unsigned char* ws = p->ws;
  bf16_t* WB = (bf16_t*)(ws + WS_WB);
  bf16_t* H = (bf16_t*)(ws + WS_H);
  float* X = p->out;
  const float* MOD = (const float*)(ws + WS_MOD);
  volatile LAS unsigned* xst = (volatile LAS unsigned*)(dyn_shm + LDS_MAIN);
  if (threadIdx.x == 0) { xst[0] = 0u; xst[1] = 0u; }
  __syncthreads();
  (void)xcd_barrier_post((unsigned*)(ws + WS_BAR), xst);
  int rep = 0;
  const int p_lo = p->p_lo, p_hi = p->p_hi, probe = p->pad, coop = p->coop;
  for (int ph = p_lo; ph < p_hi; ++ph) {
    asm volatile("" : "+s"(p));
    const int G = gdim_(), bid = bid_();
    unsigned char* ws = p->ws; bf16_t* WB = (bf16_t*)(ws + WS_WB); bf16_t* H = (bf16_t*)(ws + WS_H); float* X = p->out; const float* MOD = (const float*)(ws + WS_MOD);
#if PROBE_PH >= 0
    const int dry = (ph == probe && rep == 0) ? 1 : 0;
#else
    const int dry = 0;
#endif
    if (PROBE_PH == 99 && probe == 99 && ph == 1) { XcdBarrier xb; xb.bar = (unsigned*)(ws + WS_BAR); xb.st = (volatile LAS unsigned*)(dyn_shm + LDS_MAIN); for (int q = 0; q < 10; ++q) xcd_barrier(xb); }
    GemmDesc g1{nullptr, nullptr, 0, 0, 0, 0, 0, 0, nullptr, 0, nullptr, nullptr, nullptr, 0, 0};
    bool isg = false;
    const float* MODL = MOD + (ph >= 11 ? 5 * 6144 : 0);
    const bf16_t* U = (const bf16_t*)(ws + WS_U);
    switch (ph) {
      case 0: {
        for (int it = bid; it < 192; it += G) mod_gemv_item(p, it);
        if (bid == G - 1) { int t = tid_(); int pos = t >> 3, j = t & 7;
          float inv = exp2f(-(float)j * 0.125f * 13.287712379549449f);
          float s, c; my_sincos((float)pos * inv, s, c);
          float* rt = (float*)(ws + WS_ROPE); rt[t * 2] = c; rt[t * 2 + 1] = s; }
        if (bid == G - 2) { int t = tid_(); float* l8 = (float*)(ws + WS_LS8);
          for (int e = t; e < 1024; e += 512) l8[e] = -8.f * log1pf(__expf(-p->in[18][e])); }
      } break;
      case 2: g1 = GemmDesc{H, WB + W0_IN, 1024, 1024, M, 1536, 1024, 0, ws + WS_Z0, 1536, nullptr, nullptr, nullptr, 0, 0}; isg = true; break;
      case 5: g1 = GemmDesc{H, WB + W0_OUT, 1024, 1024, M, 1024, 1024, 2, X, 1024, p->in[0], p->in[1], MOD + 2 * 1024, 0, 0}; isg = true; break;
      case 7: case 9: case 19: case 21: { int ro = (ph == 7 || ph == 19) ? 0 : MH;
        g1 = GemmDesc{H + (size_t)ro * DM, WB + (ph < 11 ? W0_W1 : W1_W1), 1024, 1024, MH, 4096, 1024, 1, ws + WS_U, 4096, nullptr, nullptr, nullptr, 0, 0}; isg = true; } break;
      case 8: case 10: case 20: case 22: { int ro = (ph == 8 || ph == 20) ? 0 : MH;
        g1 = GemmDesc{U, WB + (ph < 11 ? W0_W2 : W1_W2), 4096, 4096, MH, 1024, 4096, 2, X, 1024, X, X + (size_t)MP * DM, MODL + 5 * 1024, ro, 0}; isg = true; } break;
      case 12: g1 = GemmDesc{H, WB + W1_IN, 1024, 1024, M, 768, 1024, 3, ws + WS_Z1, 768, nullptr, nullptr, nullptr, 0, 0}; isg = true; break;
      case 13: l1_rows_phase(p); break;
      case 14: g1 = GemmDesc{(const bf16_t*)(ws + WS_CQN), WB + W1_QB, 384, 384, M, 1536, 384, 0, ws + WS_Q, 1536, nullptr, nullptr, nullptr, 0, 0}; isg = true; break;
      case 15: g1 = GemmDesc{(const bf16_t*)(ws + WS_CKVN), WB + W1_KVB, 256, 256, KROWS, 2048, 256, 0, ws + WS_KV, 2048, nullptr, nullptr, nullptr, 0, 0}; isg = true; break;
#ifndef NO_ATTN
      case 16: attn_phase(p, dry); break;
#endif
      case 17: g1 = GemmDesc{(const bf16_t*)(ws + WS_Q), WB + W1_OUT, 1536, 1024, M, 1024, 1024, 2, X, 1024, X, X + (size_t)MP * DM, MODL + 2 * 1024, 0, 0}; isg = true; break;
      case 23: final_norm_phase(p, dry); break;
      default: break;
    }
    if (ph == 1 || ph == 6 || ph == 11 || ph == 18) {
      const bool first = ph == 1;
      modulate_phase(p, first ? p->in[0] : X, first ? p->in[1] : X + (size_t)MP * DM, p->in[ph == 1 ? 9 : ph == 6 ? 10 : ph == 11 ? 26 : 27], MODL, (ph == 1 || ph == 11) ? 0 : 3);
    }
    if (ph == 0 || ph == 11) cvt_weights(p, ph == 0 ? 0 : 1, ph == 0 ? (bid + G - 192 % G) % G : bid, G);
#ifndef NO_LRU
    if (ph == 3 || ph == 4) {
      const int nit = ph == 3 ? 3072 + 1536 : 3072;
      for (int it = bid; it < nit; it += G) { if (it < 3072) lru_item(p, it >> 3, it & 7, ph - 3); else pool_item(p, (it - 3072) >> 2, (it - 3072) & 3); }
    }
#endif
#ifndef NO_GEMM
    g1.dry = (dry && g1.mode == 2 && ph != 5) ? 1 : 0;
    if (isg) gemm_phase(g1);
#endif
    if (coop && ph + 1 < p_hi && ph != 14) {
      if (ph == 0 && !dry) grid.sync(); else { XcdBarrier xb; xb.bar = (unsigned*)(ws + WS_BAR); xb.st = (volatile LAS unsigned*)(dyn_shm + LDS_MAIN); xcd_barrier(xb); } }
#if PROBE_PH >= 0
    if (dry) { rep = 1; --ph; }
#endif
  }
}

#ifndef MK_SPLIT
#define MK_SPLIT 0
#endif
extern "C" void kernel_launch(void* const* d_in, const int* in_sizes, int n_in, void* d_out, int out_size, void* d_ws, size_t ws_size, hipStream_t stream) {
  static int grid = 0;
  if (grid == 0) {
    if (n_in != 37 || ws_size < WS_END) { fprintf(stderr, "kernel_launch: bad n_in %d or ws %zu < %zu\n", n_in, ws_size, (size_t)WS_END); grid = -1; return; }
    int dev = 0, cus = 0, per_cu = 0;
    hipGetDevice(&dev); hipDeviceGetAttribute(&cus, hipDeviceAttributeMultiprocessorCount, dev);
    if (hipFuncSetAttribute((const void*)fwd_megakernel, hipFuncAttributeMaxDynamicSharedMemorySize, LDS_BYTES) != hipSuccess) { fprintf(stderr, "kernel_launch: hipFuncSetAttribute failed\n"); grid = -1; return; }
    if (hipOccupancyMaxActiveBlocksPerMultiprocessor(&per_cu, (const void*)fwd_megakernel, 512, LDS_BYTES) != hipSuccess || per_cu < 1) { fprintf(stderr, "kernel_launch: occupancy query gave %d\n", per_cu); grid = -1; return; }
    grid = cus;
  }
  if (grid < 0) return;
  if (hipMemsetAsync((char*)d_ws + WS_BAR, 0, XCD_BAR_WORDS * 4, stream) != hipSuccess) { fprintf(stderr, "kernel_launch: memset failed\n"); return; }
  Params p{};
  for (int i = 0; i < 37; ++i) p.in[i] = (const float*)d_in[i];
  p.out = (float*)d_out; p.ws = (unsigned char*)d_ws; p.pad = PROBE_PH;
#if MK_SPLIT
  for (int ph = 0; ph < NPH; ++ph) {
    p.p_lo = ph; p.p_hi = ph + 1; p.coop = 0;
    hipLaunchKernelGGL(fwd_megakernel, dim3(grid), dim3(512), LDS_BYTES, stream, p);
  }
#else
  p.p_lo = 0; p.p_hi = NPH; p.coop = 1;
  void* args[] = {&p};
  hipError_t e = hipLaunchCooperativeKernel((const void*)fwd_megakernel, dim3(grid), dim3(512), args, LDS_BYTES, stream);
  if (e != hipSuccess) fprintf(stderr, "cooperative launch failed: %s (grid %d)\n", hipGetErrorString(e), grid);
#endif
}
```

```cpp
#include <hip/hip_runtime.h>
#include <hip/hip_cooperative_groups.h>
#include <cstdio>
#include <cstdint>
namespace cg = cooperative_groups;
#ifndef PROBE_PH
#define PROBE_PH -1
#endif

typedef unsigned short bf16_t;
typedef short bf16x8 __attribute__((ext_vector_type(8)));
typedef short s16x4 __attribute__((ext_vector_type(4)));
typedef float f32x4 __attribute__((ext_vector_type(4)));
typedef float f32x16 __attribute__((ext_vector_type(16)));
typedef unsigned u32x4 __attribute__((ext_vector_type(4)));
typedef unsigned u32x2 __attribute__((ext_vector_type(2)));

constexpr int DM = 1024, MP = 8192, MS = 16384, M = MP + MS, DFF = 4096;
constexpr int SEQ = 256, DSEQ = 4096, PAST = 512, NB_S = 4;
constexpr int KROWS = MP + NB_S * (DSEQ + PAST);
constexpr int SKEYS = DSEQ + PAST;
constexpr int MH = M / 2;
constexpr float EPS = 1e-6f;
constexpr int NPH = 24;

constexpr size_t MiB = 1u << 20;
constexpr size_t WS_MOD = 0;
constexpr size_t WS_ROPE = 256 * 1024;
constexpr size_t WS_LS8 = 260 * 1024;
constexpr size_t WS_SUM = 512 * 1024;
constexpr size_t WS_BAR = 3840 * 1024;
constexpr size_t WS_WB = 4 * MiB;
constexpr size_t WS_R1 = 26 * MiB;
constexpr size_t WS_H = WS_R1;
constexpr size_t WS_Z0 = WS_R1 + 48 * MiB;
constexpr size_t WS_U = WS_R1 + 48 * MiB;
constexpr size_t WS_KV = WS_R1;
constexpr size_t WS_Q = WS_R1 + 104 * MiB;
constexpr size_t WS_Z1 = WS_R1 + 104 * MiB;
constexpr size_t WS_CQN = WS_R1 + 176 * MiB;
constexpr size_t WS_CKVN = WS_R1 + 194 * MiB;
constexpr size_t WS_KPE = WS_R1 + 207 * MiB;
constexpr size_t WS_END = WS_R1 + 209 * MiB;
constexpr size_t W0_IN = 0, W0_OUT = 1572864, W0_W1 = 2621440, W0_W2 = 6815744, W0_G = 11010048, W0_P = 11141120;
constexpr size_t W1_IN = 0, W1_QB = 786432, W1_KVB = 1376256, W1_OUT = 1900544, W1_W1 = 2949120, W1_W2 = 7143424;
constexpr size_t O_Y = 0, O_LRU = 25165824, O_CKV = 25198592, O_KPE = 27295744;

struct Params {
  const float* in[37];
  float* out;
  unsigned char* ws;
  int p_lo, p_hi, coop, pad;
};

typedef const __attribute__((address_space(4))) Params* KP;
extern __shared__ __attribute__((aligned(16))) unsigned char dyn_shm[];
constexpr int LDS_MAIN = 139264;
constexpr int LDS_BYTES = LDS_MAIN + 16;

__device__ __forceinline__ unsigned cvtpk(float lo, float hi) {
  unsigned r; asm volatile("v_cvt_pk_bf16_f32 %0, %1, %2" : "=v"(r) : "v"(lo), "v"(hi)); return r;
}
__device__ __forceinline__ float bf2f(bf16_t b) { return __uint_as_float(((unsigned)b) << 16); }
__device__ __forceinline__ bf16_t f2bf(float f) { return (bf16_t)(cvtpk(f, f) & 0xffffu); }
__device__ __forceinline__ float sigmoidf_(float x) { return 1.f / (1.f + __expf(-x)); }
__device__ __forceinline__ float gelu_tanh(float x) {
  float u = 0.7978845608028654f * (x + 0.044715f * x * x * x);
  float e = __expf(2.f * u);
  float th = 1.f - 2.f / (e + 1.f);
  return 0.5f * x * (1.f + th);
}
__device__ __forceinline__ float lane_xor(float v, int lane, int o) { return __int_as_float(__builtin_amdgcn_ds_bpermute((lane ^ o) << 2, __float_as_int(v))); }
__device__ __forceinline__ float wave_sum(float v, int lane) {
#pragma unroll
  for (int o = 32; o > 0; o >>= 1) v += lane_xor(v, lane, o);
  return v;
}
__device__ __forceinline__ void my_sincos(float a, float& s, float& c) {
  float k = rintf(a * 0.63661977236758134f);
  float r = fmaf(k, -1.5707962513e+00f, a);
  r = fmaf(k, -7.5497894159e-08f, r);
  r = fmaf(k, -5.3903029534e-15f, r);
  float r2 = r * r;
  float sp = r + r * r2 * (-1.6666667163e-01f + r2 * (8.3333337680e-03f + r2 * (-1.9841270114e-04f + r2 * 2.7557314297e-06f)));
  float cp = 1.f + r2 * (-0.5f + r2 * (4.1666667908e-02f + r2 * (-1.3888889225e-03f + r2 * 2.4801587642e-05f)));
  int q = ((int)k) & 3;
  float ss = (q & 1) ? cp : sp, cc = (q & 1) ? sp : cp;
  s = (q & 2) ? -ss : ss;
  c = ((q + 1) & 2) ? -cc : cc;
}
__device__ __forceinline__ int bid_() { int b = blockIdx.x; asm volatile("" : "+s"(b)); return b; }
__device__ __forceinline__ int gdim_() { int g = gridDim.x; asm volatile("" : "+s"(g)); return g; }
__device__ __forceinline__ int tid_() { int t = threadIdx.x; asm volatile("" : "+v"(t)); return t; }
__device__ __forceinline__ int cond_of_row(int row) { return row < MP ? 0 : 1 + ((row - MP) >> 12); }


#define XB_TMO      128
#define XB_XCNT(j)  (256  + 64 * (j))
#define XB_XSUB(j)  (1280 + 64 * (j))
#define XB_XGEN(j)  (2304 + 64 * (j))
#define XB_TOP      3328
#define XB_TOPGEN   3392
#define XCD_BAR_WORDS 3456
#define XB_SPIN_CAP (1u << 20)
#define LAS __attribute__((address_space(3)))
__device__ __forceinline__ unsigned xb_ld(unsigned* p)              { return __hip_atomic_load(p, __ATOMIC_RELAXED, __HIP_MEMORY_SCOPE_AGENT); }
__device__ __forceinline__ unsigned xb_add(unsigned* p, unsigned v) { return __hip_atomic_fetch_add(p, v, __ATOMIC_RELAXED, __HIP_MEMORY_SCOPE_AGENT); }
__device__ __forceinline__ unsigned xb_xcc_id() { return (unsigned)__builtin_amdgcn_s_getreg((3 << 11) | 20) & 0xFu; }
#define XB_SPIN(cond, bar) do { unsigned _sp = 0; while (cond) { __builtin_amdgcn_s_sleep(1); \
    if ((++_sp & 255u) == 0u) { if (xb_ld(&(bar)[XB_TMO])) break; if (_sp > XB_SPIN_CAP) { atomicAdd(&(bar)[XB_TMO], 1u); break; } } } } while (0)
struct XcdBarrier { unsigned* bar; volatile LAS unsigned* st; };
__device__ __forceinline__ XcdBarrier xcd_barrier_post(unsigned* bar, volatile LAS unsigned* st) {
  XcdBarrier b; b.bar = bar; b.st = st;
  if (threadIdx.x == 0) (void)xb_add(&bar[XB_XCNT(xb_xcc_id())], 1u);
  return b;
}
__device__ __forceinline__ void xcd_barrier_complete(unsigned* bar, unsigned x, unsigned& nloc, unsigned& nx) {
  const unsigned G = (unsigned)gdim_();
  unsigned sum, cnt, mine, sp = 0u;
  for (;;) {
    sum = 0u; cnt = 0u; mine = 0u;
#pragma unroll
    for (unsigned j = 0; j < 16; ++j) { const unsigned c = xb_ld(&bar[XB_XCNT(j)]); sum += c; cnt += (c > 0u) ? 1u : 0u; mine = (j == x) ? c : mine; }
    if (sum == G) break;
    __builtin_amdgcn_s_sleep(1);
    if ((++sp & 255u) == 0u) { if (xb_ld(&bar[XB_TMO])) break; if (sp > XB_SPIN_CAP) { atomicAdd(&bar[XB_TMO], 1u); break; } }
  }
  nloc = mine > 0u ? mine : 1u; nx = cnt > 0u ? cnt : 1u;
}
__device__ __forceinline__ void xcd_barrier(const XcdBarrier& b) {
  asm volatile("s_waitcnt vmcnt(0)" ::: "memory");
  __syncthreads();
  if (threadIdx.x == 0) {
    unsigned* bar = b.bar; unsigned bx = xb_xcc_id(); asm volatile("" : "+s"(bx));
    __builtin_amdgcn_s_waitcnt(0);
    unsigned nloc = b.st[0], nx = b.st[1];
    if (nloc == 0u) { xcd_barrier_complete(bar, bx, nloc, nx); b.st[0] = nloc; b.st[1] = nx; }
    const unsigned old = xb_add(&bar[XB_XSUB(bx)], 1u);
    const unsigned gen = old / nloc;
    if (old + 1u == (gen + 1u) * nloc) {
      __builtin_amdgcn_fence(__ATOMIC_RELEASE, "agent");
      asm volatile("s_waitcnt vmcnt(0)" ::: "memory");
      const unsigned og = xb_add(&bar[XB_TOP], 1u);
      const unsigned tg = og / nx;
      if (og + 1u == (tg + 1u) * nx) xb_add(&bar[XB_TOPGEN], 1u);
      else XB_SPIN(xb_ld(&bar[XB_TOPGEN]) == tg, bar);
      __builtin_amdgcn_fence(__ATOMIC_ACQUIRE, "agent");
      xb_add(&bar[XB_XGEN(bx)], 1u);
      asm volatile("s_waitcnt vmcnt(0)" ::: "memory");
    } else {
      XB_SPIN(xb_ld(&bar[XB_XGEN(bx)]) == gen, bar);
      __builtin_amdgcn_fence(__ATOMIC_ACQUIRE, "agent");
      asm volatile("s_waitcnt vmcnt(0)" ::: "memory");
    }
  }
  __syncthreads();
}

constexpr int BM = 256, BK = 64, HALF = 128, HT = HALF * BK, NXCD = 8, WGM = 8;
__device__ __forceinline__ int lds_byte(int r, int c) {
  int st = (r >> 4) * 2 + (c >> 5), rr = r & 15, cc = c & 31, ob = rr * 64 + cc * 2;
  return st * 1024 + (ob ^ (((ob >> 9) & 1) << 5));
}
__device__ __forceinline__ void stage_rc(int b, int& R, int& C) {
  int st = b / 1024, sb = b % 1024, swz = sb ^ (((sb >> 9) & 1) << 5);
  R = (st >> 1) * 16 + swz / 64; C = (st & 1) * 32 + (swz % 64) / 2;
}

struct GemmDesc {
  const bf16_t* A; const bf16_t* Bt; int lda, ldb, Mrows, N, K;
  int mode;
  void* out; int ldc;
  const float* src0; const float* src1; const float* gate; int row_off; int dry;
};

__device__ __forceinline__ void gemm_epi(const GemmDesc& g, int row, int col, f32x4 v) {
#if PROBE_PH >= 0
  if (g.dry) return;
#endif
  if (g.mode == 0) {
    u32x2 w; w.x = cvtpk(v[0], v[1]); w.y = cvtpk(v[2], v[3]);
    *(u32x2*)((bf16_t*)g.out + (size_t)row * g.ldc + col) = w;
  } else if (g.mode == 1) {
    float a = fmaxf(v[0], 0.f), b = fmaxf(v[1], 0.f), c = fmaxf(v[2], 0.f), d = fmaxf(v[3], 0.f);
    u32x2 w; w.x = cvtpk(a * a, b * b); w.y = cvtpk(c * c, d * d);
    *(u32x2*)((bf16_t*)g.out + (size_t)row * g.ldc + col) = w;
  } else if (g.mode == 2) {
    int rg = row + g.row_off;
    const float* sp = rg < MP ? g.src0 + (size_t)rg * DM + col : g.src1 + (size_t)(rg - MP) * DM + col;
    f32x4 x = *(const f32x4*)sp;
    f32x4 gt = *(const f32x4*)(g.gate + cond_of_row(rg) * 6144 + col);
    *(f32x4*)((float*)g.out + (size_t)rg * DM + col) = x + gt * v;
  } else {
    *(f32x4*)((float*)g.out + (size_t)row * g.ldc + col) = v;
  }
}

template <int MF>
__device__ __forceinline__ void gemm_tile(const GemmDesc& g, int brow, int bcol) {
  constexpr int AH = MF * 32;
  bf16_t* shm = (bf16_t*)dyn_shm;
  const bf16_t* A = g.A; const bf16_t* Bt = g.Bt; const int lda = g.lda, ldb = g.ldb, K = g.K;
#define SA(b,h) (shm+((b)*2+(h))*HT)
#define SB(b,h) (shm+(4+(b)*2+(h))*HT)
#define STAGE(P,BASE,LD,VO,br,kt) do{const unsigned char* _ub=(const unsigned char*)(BASE)+((size_t)(br)*(LD)+(size_t)(kt)*BK)*2; \
    unsigned _vo=VO; asm volatile("":"+v"(_vo)); \
    __builtin_amdgcn_global_load_lds((const unsigned*)(_ub+_vo), (__attribute__((address_space(3))) unsigned*)((unsigned char*)(P)+tid*16),16,0,0); \
    __builtin_amdgcn_global_load_lds((const unsigned*)(_ub+(size_t)(LD)*128+_vo), (__attribute__((address_space(3))) unsigned*)((unsigned char*)(P)+tid*16+8192),16,0,0);}while(0)
#define LDA(dst,b,h) for(int m=0;m<MF;++m)for(int k=0;k<2;++k) \
    dst[m][k]=*reinterpret_cast<const bf16x8*>((char*)SA(b,h)+lds_byte(wr*(MF*16)+m*16+fr,k*32+fq*8))
#define LDB(dst,b,h) for(int n=0;n<2;++n)for(int k=0;k<2;++k) \
    dst[n][k]=*reinterpret_cast<const bf16x8*>((char*)SB(b,h)+lds_byte(wc*32+n*16+fr,k*32+fq*8))
#define MMA(ai,bj,At,Bt_) do{__builtin_amdgcn_s_setprio(1); \
    for(int m=0;m<MF;++m)for(int n=0;n<2;++n)for(int k=0;k<2;++k) \
      acc[ai][bj][m][n]=__builtin_amdgcn_mfma_f32_16x16x32_bf16(Bt_[n][k],At[m][k],acc[ai][bj][m][n],0,0,0); \
    __builtin_amdgcn_s_setprio(0);}while(0)
#define WAIT_V(n) asm volatile("s_waitcnt vmcnt(" #n ")":::"memory")
#define WAIT_L(n) asm volatile("s_waitcnt lgkmcnt(" #n ")":::"memory")
#define BAR __builtin_amdgcn_s_barrier()
#define SCHED __builtin_amdgcn_sched_barrier(0)
  const int tid = tid_();
  const int wid = __builtin_amdgcn_readfirstlane(tid >> 6), lane = tid & 63, wr = wid >> 2, wc = wid & 3, fr = lane & 15, fq = lane >> 4;
  unsigned voA, voB;
  { int r_, c_; stage_rc(tid * 16, r_, c_); voA = (unsigned)(r_ * lda + c_) * 2u; voB = (unsigned)(r_ * ldb + c_) * 2u; }
  f32x4 acc[2][2][MF][2] = {};
  bf16x8 At[MF][2], B0[2][2], B1[2][2];
  const int nt = K / BK;
  __syncthreads();
  STAGE(SB(0,0),Bt,ldb,voB,bcol,0); STAGE(SA(0,0),A,lda,voA,brow,0);
  STAGE(SB(0,1),Bt,ldb,voB,bcol+HALF,0); STAGE(SA(0,1),A,lda,voA,brow+AH,0);
  if(wr==1)BAR;
  WAIT_V(4); BAR;
  STAGE(SB(1,0),Bt,ldb,voB,bcol,1); STAGE(SA(1,0),A,lda,voA,brow,1); STAGE(SB(1,1),Bt,ldb,voB,bcol+HALF,1);
  WAIT_V(6); BAR;
  for(int t=0;t<nt-2;t+=2){
    LDB(B0,0,0); SCHED; LDA(At,0,0); STAGE(SA(1,1),A,lda,voA,brow+AH,t+1);
    if (MF == 4) WAIT_L(8); else WAIT_L(6); BAR; WAIT_L(0); MMA(0,0,At,B0); BAR; SCHED;
    LDB(B1,0,1); STAGE(SB(0,0),Bt,ldb,voB,bcol,t+2);
    BAR; WAIT_L(0); MMA(0,1,At,B1); BAR;
    LDA(At,0,1); STAGE(SA(0,0),A,lda,voA,brow,t+2);
    BAR; WAIT_L(0); MMA(1,0,At,B0); BAR; SCHED;
    STAGE(SB(0,1),Bt,ldb,voB,bcol+HALF,t+2);
    WAIT_V(6); BAR; MMA(1,1,At,B1); BAR;
    LDB(B0,1,0); SCHED; LDA(At,1,0); STAGE(SA(0,1),A,lda,voA,brow+AH,t+2);
    if (MF == 4) WAIT_L(8); else WAIT_L(6); BAR; WAIT_L(0); MMA(0,0,At,B0); BAR; SCHED;
    LDB(B1,1,1); STAGE(SB(1,0),Bt,ldb,voB,bcol,t+3);
    BAR; WAIT_L(0); MMA(0,1,At,B1); BAR;
    LDA(At,1,1); STAGE(SA(1,0),A,lda,voA,brow,t+3);
    BAR; WAIT_L(0); MMA(1,0,At,B0); BAR; SCHED;
    STAGE(SB(1,1),Bt,ldb,voB,bcol+HALF,t+3);
    WAIT_V(6); BAR; MMA(1,1,At,B1); BAR;
  }
  { LDB(B0,0,0); LDA(At,0,0); STAGE(SA(1,1),A,lda,voA,brow+AH,nt-1);
    BAR; WAIT_L(0); MMA(0,0,At,B0); BAR;
    LDB(B1,0,1); BAR; WAIT_L(0); MMA(0,1,At,B1); BAR;
    LDA(At,0,1); WAIT_V(4); BAR; WAIT_L(0); MMA(1,0,At,B0); MMA(1,1,At,B1); BAR; }
  { LDB(B0,1,0); LDA(At,1,0); WAIT_V(2); BAR; WAIT_L(0); MMA(0,0,At,B0); BAR;
    LDB(B1,1,1); WAIT_V(0); BAR; WAIT_L(0); MMA(0,1,At,B1); BAR;
    LDA(At,1,1); BAR; WAIT_L(0); MMA(1,0,At,B0); MMA(1,1,At,B1); BAR; }
  if(wr==0)BAR;
  const int tid2 = tid_(); const int wid2 = tid2 >> 6, lane2 = tid2 & 63;
  if (g.mode <= 1) {
    unsigned char* st = dyn_shm;
    const int lrow = (wid2 >> 2) * (MF * 16) + (lane2 & 15), lcol = (wid2 & 3) * 32 + (lane2 >> 4) * 4;
    const bool sq = g.mode == 1;
#pragma unroll
    for(int ai=0;ai<2;++ai)
#pragma unroll
      for(int m=0;m<MF;++m)
#pragma unroll
        for(int bj=0;bj<2;++bj)
#pragma unroll
          for(int n=0;n<2;++n) {
            f32x4 v = acc[ai][bj][m][n];
            if (sq) { v[0] = fmaxf(v[0], 0.f); v[1] = fmaxf(v[1], 0.f); v[2] = fmaxf(v[2], 0.f); v[3] = fmaxf(v[3], 0.f); v = v * v; }
            u32x2 w; w.x = cvtpk(v[0], v[1]); w.y = cvtpk(v[2], v[3]);
            *(u32x2*)(st + (lrow + ai * AH + m * 16) * 544 + (lcol + bj * HALF + n * 16) * 2) = w;
          }
    __syncthreads();
#if PROBE_PH >= 0
    if (!g.dry)
#endif
    {
      bf16_t* ob = (bf16_t*)g.out + (size_t)brow * g.ldc + bcol;
      const int r0 = wid2 * (MF * 8) + (lane2 >> 5), c16 = (lane2 & 31);
#pragma unroll 4
      for (int i = 0; i < MF * 4; ++i) {
        const int r = r0 + 2 * i;
        u32x4 w = *(const u32x4*)(st + r * 544 + c16 * 16);
        *(u32x4*)(ob + (size_t)r * g.ldc + c16 * 8) = w;
      }
    }
  } else {
  const int erow = brow + (wid2 >> 2) * (MF * 16) + (lane2 & 15), ecol = bcol + (wid2 & 3) * 32 + (lane2 >> 4) * 4;
#pragma unroll
  for(int ai=0;ai<2;++ai)
#pragma unroll
    for(int m=0;m<MF;++m)
#pragma unroll
      for(int bj=0;bj<2;++bj)
#pragma unroll
        for(int n=0;n<2;++n)
          gemm_epi(g, erow+ai*AH+m*16, ecol+bj*HALF+n*16, acc[ai][bj][m][n]);
  }
#undef SA
#undef SB
#undef STAGE
#undef LDA
#undef LDB
#undef MMA
}

__device__ __forceinline__ void tile_of(int L, int nM, int nN, int nwg, int th, int& brow, int& bcol) {
  int wgid = L;
  { const int q = nwg / NXCD, r = nwg % NXCD, xcd = wgid % NXCD, off = wgid / NXCD; wgid = (xcd < r ? xcd * (q + 1) : r * (q + 1) + (xcd - r) * q) + off; }
  const int nig = WGM * nN, gid = wgid / nig, fm = gid * WGM, gsz = (nM - fm) < WGM ? (nM - fm) : WGM;
  brow = (fm + ((wgid % nig) % gsz)) * th; bcol = ((wgid % nig) / gsz) * BM;
}
__device__ __forceinline__ void gemm_phase(const GemmDesc& g) {
  const int G = gdim_();
  const bool m3 = (g.Mrows % 192) == 0 && g.N <= 1536;
  const int th = m3 ? 192 : 256;
  const int nM = g.Mrows / th, nN = g.N / BM, nwg = nM * nN;
  for (int L = bid_(); L < nwg; L += G) {
    int brow, bcol; tile_of(L, nM, nN, nwg, th, brow, bcol);
    if (m3) gemm_tile<3>(g, brow, bcol); else gemm_tile<4>(g, brow, bcol);
  }
}

constexpr float ATT_SCALE = 0.10206207261596577f;
constexpr float ATT_THR = 8.f;
constexpr int SHM_V = 64 * 64 * 2, SHM_K = 64 * 128 * 2;
#define KSWZ(row, colB) ((row) * 256 + ((colB) ^ (((row) & 7) << 4)))
#define SBAR() __builtin_amdgcn_sched_barrier(0)
__device__ __forceinline__ int crow(int r, int hi) { return (r & 3) + 8 * (r >> 2) + 4 * hi; }

__device__ __forceinline__ void partialSM(f32x16& p0, f32x16& p1, float& m_reg, float& alpha, bool first) {
  constexpr float THRL = ATT_THR * 1.4426950408889634f;
  float pmax = p0[0];
#pragma unroll
  for (int r = 1; r < 16; ++r) pmax = fmaxf(pmax, p0[r]);
#pragma unroll
  for (int r = 0; r < 16; ++r) pmax = fmaxf(pmax, p1[r]);
  { auto rr = __builtin_amdgcn_permlane32_swap(__float_as_uint(pmax), __float_as_uint(pmax), false, false);
    pmax = fmaxf(__uint_as_float(rr[0]), __uint_as_float(rr[1])); }
  if (first) {
    alpha = 0.f; m_reg = pmax;
#pragma unroll
    for (int r = 0; r < 16; ++r) p0[r] -= pmax;
#pragma unroll
    for (int r = 0; r < 16; ++r) p1[r] -= pmax;
  } else if (__builtin_expect(__all(pmax <= THRL), 1)) { alpha = 1.f; }
  else { const float d = fmaxf(pmax, 0.f); alpha = __builtin_amdgcn_exp2f(-d); m_reg += d;
#pragma unroll
    for (int r = 0; r < 16; ++r) p0[r] -= d;
#pragma unroll
    for (int r = 0; r < 16; ++r) p1[r] -= d;
  }
#pragma unroll
  for (int r = 0; r < 16; ++r) p0[r] = __builtin_amdgcn_exp2f(p0[r]);
}
__device__ __forceinline__ void finishSM(f32x16& p0, f32x16& p1, float alpha, float& l_reg, bf16x8& pa0, bf16x8& pa1, bf16x8& pa2, bf16x8& pa3) {
#pragma unroll
  for (int r = 0; r < 16; ++r) p1[r] = __builtin_amdgcn_exp2f(p1[r]);
  float ps = 0;
#pragma unroll
  for (int r = 0; r < 16; ++r) ps += p0[r];
#pragma unroll
  for (int r = 0; r < 16; ++r) ps += p1[r];
  { auto rr = __builtin_amdgcn_permlane32_swap(__float_as_uint(ps), __float_as_uint(ps), false, false);
    ps = __uint_as_float(rr[0]) + __uint_as_float(rr[1]); }
  l_reg = l_reg * alpha + ps;
#define PK4(P, BASE, OUT) do { unsigned a0 = cvtpk(P[BASE + 0], P[BASE + 1]), a1 = cvtpk(P[BASE + 2], P[BASE + 3]);   \
    unsigned b0 = cvtpk(P[BASE + 4], P[BASE + 5]), b1 = cvtpk(P[BASE + 6], P[BASE + 7]);                              \
    auto r0 = __builtin_amdgcn_permlane32_swap(a0, b0, false, false); auto r1 = __builtin_amdgcn_permlane32_swap(a1, b1, false, false); \
    u32x4 w = {r0[0], r1[0], r0[1], r1[1]}; OUT = *reinterpret_cast<bf16x8*>(&w); } while (0)
  PK4(p0, 0, pa0); PK4(p0, 8, pa1); PK4(p1, 0, pa2); PK4(p1, 8, pa3);
#undef PK4
}
__device__ __forceinline__ void qkt(f32x16& p0, f32x16& p1, const unsigned char* Ks, const bf16x8* qr, int r32, int hi, float init) {
#pragma unroll
  for (int r = 0; r < 16; ++r) { p0[r] = init; p1[r] = init; }
#pragma unroll
  for (int d0 = 0; d0 < 6; ++d0) { int cb = (d0 * 16 + hi * 8) * 2;
    bf16x8 b0 = *reinterpret_cast<const bf16x8*>(Ks + KSWZ(r32, cb));
    bf16x8 b1 = *reinterpret_cast<const bf16x8*>(Ks + KSWZ(32 + r32, cb));
    p0 = __builtin_amdgcn_mfma_f32_32x32x16_bf16(b0, qr[d0], p0, 0, 0, 0);
    p1 = __builtin_amdgcn_mfma_f32_32x32x16_bf16(b1, qr[d0], p1, 0, 0, 0); }
}
__device__ __forceinline__ int v_st(int k, int c) { const int kk = (k & ~0xC) | ((k & 4) << 1) | ((k & 8) >> 1); return ((kk >> 3) * 2 + (c >> 5)) * 512 + ((kk & 7) * 32 + (c & 31)) * 2; }
__device__ __forceinline__ int v_rd_base(int lane) { return ((lane & 3) << 3) | (((lane >> 2) & 3) << 6) | (((lane >> 4) & 1) << 5) | (((lane >> 5) & 1) << 8); }
constexpr int v_rd_off(int d0, int ks, int half) { return d0 * 512 + ks * 2048 + half * 1024; }
template <int OFF> __device__ __forceinline__ s16x4 tr_read(int vb) {
  s16x4 r; asm volatile("ds_read_b64_tr_b16 %0, %1 offset:%2" : "=&v"(r) : "v"(vb), "i"(OFF) : "memory"); return r;
}
__device__ __forceinline__ void pv_d0(f32x16* o, int vb, bf16x8 pa0, bf16x8 pa1, bf16x8 pa2, bf16x8 pa3) {
  const s16x4 l0 = tr_read<v_rd_off(0, 0, 0)>(vb), h0 = tr_read<v_rd_off(0, 0, 1)>(vb), l1 = tr_read<v_rd_off(0, 1, 0)>(vb), h1 = tr_read<v_rd_off(0, 1, 1)>(vb);
  const s16x4 l2 = tr_read<v_rd_off(0, 2, 0)>(vb), h2 = tr_read<v_rd_off(0, 2, 1)>(vb), l3 = tr_read<v_rd_off(0, 3, 0)>(vb), h3 = tr_read<v_rd_off(0, 3, 1)>(vb);
  const s16x4 m0 = tr_read<v_rd_off(1, 0, 0)>(vb), n0 = tr_read<v_rd_off(1, 0, 1)>(vb), m1 = tr_read<v_rd_off(1, 1, 0)>(vb), n1 = tr_read<v_rd_off(1, 1, 1)>(vb);
  const s16x4 m2 = tr_read<v_rd_off(1, 2, 0)>(vb), n2 = tr_read<v_rd_off(1, 2, 1)>(vb), m3 = tr_read<v_rd_off(1, 3, 0)>(vb), n3 = tr_read<v_rd_off(1, 3, 1)>(vb);
  asm volatile("s_waitcnt lgkmcnt(0)" ::: "memory"); SBAR();
#define PK(L, H) (bf16x8){L[0], L[1], L[2], L[3], H[0], H[1], H[2], H[3]}
  o[0] = __builtin_amdgcn_mfma_f32_32x32x16_bf16(pa0, PK(l0, h0), o[0], 0, 0, 0);
  o[1] = __builtin_amdgcn_mfma_f32_32x32x16_bf16(pa0, PK(m0, n0), o[1], 0, 0, 0);
  o[0] = __builtin_amdgcn_mfma_f32_32x32x16_bf16(pa1, PK(l1, h1), o[0], 0, 0, 0);
  o[1] = __builtin_amdgcn_mfma_f32_32x32x16_bf16(pa1, PK(m1, n1), o[1], 0, 0, 0);
  o[0] = __builtin_amdgcn_mfma_f32_32x32x16_bf16(pa2, PK(l2, h2), o[0], 0, 0, 0);
  o[1] = __builtin_amdgcn_mfma_f32_32x32x16_bf16(pa2, PK(m2, n2), o[1], 0, 0, 0);
  o[0] = __builtin_amdgcn_mfma_f32_32x32x16_bf16(pa3, PK(l3, h3), o[0], 0, 0, 0);
  o[1] = __builtin_amdgcn_mfma_f32_32x32x16_bf16(pa3, PK(m3, n3), o[1], 0, 0, 0);
#undef PK
}

__device__ __forceinline__ void attn_unit(bf16_t* Qrows, int h, const bf16_t* KVb, const bf16_t* KPb, int nkeys, bool rope, int s0, const float* ropetab, int dry) {
  unsigned char* lds = dyn_shm;
  const int tid = tid_(), wid = tid >> 6, lane = tid & 63, r32 = lane & 31, hi = lane >> 5;
  unsigned char* V_lds = lds; unsigned char* K_lds = lds + 3 * SHM_V;
  float* ws = (float*)(lds + 3 * SHM_V + 3 * SHM_K) + wid * 64; float* li_l = ws; float* al_l = ws + 32;
  float m_reg = -1e30f, l_reg = 0; f32x16 o[2] = {}; bf16x8 qr[6];
  __syncthreads();
  {
    const int row = wid * 32 + r32;
    const bf16_t* Qn = Qrows + (size_t)row * 1536 + h * 64 + hi * 8;
#pragma unroll
    for (int d0 = 0; d0 < 4; ++d0) qr[d0] = *reinterpret_cast<const bf16x8*>(Qn + d0 * 16);
    const bf16_t* Qp = Qrows + (size_t)row * 1536 + 1024 + h * 32;
    const int s = s0 + row;
#pragma unroll
    for (int blk = 0; blk < 2; ++blk) {
      bf16x8 x1 = *reinterpret_cast<const bf16x8*>(Qp + blk * 16), x2 = *reinterpret_cast<const bf16x8*>(Qp + blk * 16 + 8);
      if (rope) {
        const int pos = blk == 0 ? (s >> 6) : (s & 63);
        const float* tb = ropetab + pos * 16;
        float ov[8];
#pragma unroll
        for (int j = 0; j < 8; ++j) {
          float a = bf2f((bf16_t)x1[j]), b = bf2f((bf16_t)x2[j]), cs = tb[2 * j], sn = tb[2 * j + 1];
          ov[j] = hi == 0 ? a * cs - b * sn : b * cs + a * sn;
        }
        u32x4 w = {cvtpk(ov[0], ov[1]), cvtpk(ov[2], ov[3]), cvtpk(ov[4], ov[5]), cvtpk(ov[6], ov[7])};
        qr[4 + blk] = *reinterpret_cast<bf16x8*>(&w);
      } else {
        qr[4 + blk] = hi == 0 ? x1 : x2;
      }
    }
  }
  const int vrow = tid >> 3, vc = (tid & 7) * 8, vst = v_st(vrow, vc);
  const bf16_t* vsrc = KVb + (size_t)vrow * 2048 + h * 128 + 64 + vc;
  const bool kact = tid < 384;
  const int kr = kact ? tid / 12 : 0, kc = kact ? (tid % 12) * 8 : 0;
  const bf16_t* ksrc = kc < 64 ? KVb + (size_t)kr * 2048 + h * 128 + kc : KPb + (size_t)kr * 32 + (kc - 64);
  const long kstride = kc < 64 ? 2048 : 32;
  const int kst0 = KSWZ(kr, kc * 2), kst1 = KSWZ(32 + kr, kc * 2);
  const int vb0 = (int)(uintptr_t)V_lds + v_rd_base(lane);
  struct { bf16x8 vs, ks0, ks1; } sr_[2];
#define SLOAD(i, k0) do { sr_[i].vs = *reinterpret_cast<const bf16x8*>(vsrc + (size_t)(k0) * 2048); \
    if (kact) { sr_[i].ks0 = *reinterpret_cast<const bf16x8*>(ksrc + (long)(k0) * kstride); sr_[i].ks1 = *reinterpret_cast<const bf16x8*>(ksrc + (long)((k0) + 32) * kstride); } } while (0)
#define SWRITE(b, i) do { *(bf16x8*)(V_lds + (b) * SHM_V + vst) = sr_[i].vs; \
    if (kact) { *(bf16x8*)(K_lds + (b) * SHM_K + kst0) = sr_[i].ks0; *(bf16x8*)(K_lds + (b) * SHM_K + kst1) = sr_[i].ks1; } } while (0)
#define RESC(a) do { if (__any((a) < 1.f)) { if (hi == 0) al_l[r32] = (a); asm volatile("s_waitcnt lgkmcnt(0)" ::: "memory"); \
    for (int d = 0; d < 2; ++d) for (int r = 0; r < 16; ++r) o[d][r] *= al_l[crow(r, hi)]; } } while (0)
  f32x16 pA0, pA1, pB0, pB1; float alA, alB; bf16x8 pa0, pa1, pa2, pa3; const int NT = nkeys / 64;
  constexpr int SE = 0, SO = 1;
  SLOAD(SE, 0); SWRITE(0, SE); SLOAD(SO, 64); __syncthreads();
  qkt(pA0, pA1, K_lds, qr, r32, hi, 0.f); partialSM(pA0, pA1, m_reg, alA, true);
  SWRITE(1, SO); if (2 < NT) SLOAD(SE, 128);
  int bc = 1;
  for (int j = 1; j + 1 < NT; j += 2) {
    const int bp = bc == 0 ? 2 : bc - 1, bn = bc == 2 ? 0 : bc + 1;
    __syncthreads();
    SBAR(); qkt(pB0, pB1, K_lds + bc * SHM_K, qr, r32, hi, -m_reg);
    finishSM(pA0, pA1, alA, l_reg, pa0, pa1, pa2, pa3); SBAR();
    SLOAD(SO, (j + 2) * 64); SBAR();
    pv_d0(o, vb0 + bp * SHM_V, pa0, pa1, pa2, pa3); partialSM(pB0, pB1, m_reg, alB, false);
    SWRITE(bn, SE);
    RESC(alB);
    __syncthreads();
    SBAR(); qkt(pA0, pA1, K_lds + bn * SHM_K, qr, r32, hi, -m_reg);
    finishSM(pB0, pB1, alB, l_reg, pa0, pa1, pa2, pa3); SBAR();
    if (j + 3 < NT) SLOAD(SE, (j + 3) * 64); SBAR();
    pv_d0(o, vb0 + bc * SHM_V, pa0, pa1, pa2, pa3); partialSM(pA0, pA1, m_reg, alA, false);
    SWRITE(bp, SO);
    RESC(alA);
    bc = bp;
  }
  { const int bp = bc == 0 ? 2 : bc - 1;
    __syncthreads();
    SBAR(); qkt(pB0, pB1, K_lds + bc * SHM_K, qr, r32, hi, -m_reg);
    finishSM(pA0, pA1, alA, l_reg, pa0, pa1, pa2, pa3); SBAR();
    pv_d0(o, vb0 + bp * SHM_V, pa0, pa1, pa2, pa3); partialSM(pB0, pB1, m_reg, alB, false);
    RESC(alB);
    finishSM(pB0, pB1, alB, l_reg, pa0, pa1, pa2, pa3); SBAR();
    pv_d0(o, vb0 + bc * SHM_V, pa0, pa1, pa2, pa3); }
  if (hi == 0) li_l[r32] = l_reg; asm volatile("s_waitcnt lgkmcnt(0)" ::: "memory");
  float rli[16];
#pragma unroll
  for (int r = 0; r < 16; ++r) rli[r] = __builtin_amdgcn_rcpf(li_l[crow(r, hi)]);
  bf16_t* Ow = Qrows + (size_t)(wid * 32) * 1536 + h * 64;
  if (!dry)
#pragma unroll
  for (int r = 0; r < 16; ++r) { int orow = crow(r, hi);
#pragma unroll
    for (int d0 = 0; d0 < 2; ++d0) Ow[(size_t)orow * 1536 + d0 * 32 + r32] = f2bf(o[d0][r] * rli[r]); }
#undef SLOAD
#undef SWRITE
#undef RESC
}

__device__ __forceinline__ void attn_phase(KP p, int dry) {
  bf16_t* Q = (bf16_t*)(p->ws + WS_Q); const bf16_t* KV = (const bf16_t*)(p->ws + WS_KV); const bf16_t* KP = (const bf16_t*)(p->ws + WS_KPE);
  const float* ropetab = (const float*)(p->ws + WS_ROPE);
  const int xcd = bid_() & 7, slot = bid_() >> 3;
  const int G = gdim_();
  const int nit = G == 256 ? 6 : (1536 + G - 1) / G;
  for (int i = 0; i < nit; ++i) {
    int u;
    if (G == 256) u = i < 4 ? ((i * 16 + xcd * 2 + (slot >> 4)) << 4) + (slot & 15) : 1024 + (i - 4) * 256 + xcd * 32 + slot;
    else { u = bid_() + i * G; if (u >= 1536) break; }
    const bool samp = u < 1024;
    const int pair = samp ? u >> 4 : u - 1024, qb = samp ? u & 15 : 0, b = pair >> 4, h = pair & 15;
    const size_t qrow = samp ? (size_t)(MP + b * DSEQ + qb * 256) : (size_t)(b * SEQ);
    const size_t krow = samp ? (size_t)(MP + b * SKEYS) : (size_t)(b * SEQ);
    attn_unit(Q + qrow * 1536, h, KV + krow * 2048, KP + krow * 32, samp ? SKEYS : SEQ, samp, qb * 256, ropetab, dry);
  }
}

__device__ void mod_gemv_item(KP p, int it) {
  float* lds = (float*)dyn_shm;
  const int l = it / 96, n0 = (it % 96) * 64, tid = tid_();
  const float* wmod = p->in[l == 0 ? 7 : 24]; const float* bmod = p->in[l == 0 ? 8 : 25];
  __syncthreads();
  for (int e = tid; e < 5 * 1024; e += 512) { int c = e >> 10, k = e & 1023; float v = c == 0 ? p->in[6][k] : p->in[5][(c - 1) * 1024 + k]; lds[e] = v / (1.f + __expf(-v)); }
  __syncthreads();
  const int col = tid & 63, ks = tid >> 6;
  float a0 = 0, a1 = 0, a2 = 0, a3 = 0, a4 = 0;
  const float* wp = wmod + (size_t)(ks * 128) * 6144 + n0 + col;
#pragma unroll 8
  for (int k = 0; k < 128; ++k) { float w = wp[(size_t)k * 6144]; int kk = ks * 128 + k;
    a0 += lds[kk] * w; a1 += lds[1024 + kk] * w; a2 += lds[2048 + kk] * w; a3 += lds[3072 + kk] * w; a4 += lds[4096 + kk] * w; }
  float* red = lds + 5 * 1024;
  red[(ks * 5 + 0) * 64 + col] = a0; red[(ks * 5 + 1) * 64 + col] = a1; red[(ks * 5 + 2) * 64 + col] = a2; red[(ks * 5 + 3) * 64 + col] = a3; red[(ks * 5 + 4) * 64 + col] = a4;
  __syncthreads();
  if (tid < 320) { int c = tid >> 6, cc = tid & 63; float s = 0;
#pragma unroll
    for (int k8 = 0; k8 < 8; ++k8) s += red[(k8 * 5 + c) * 64 + cc];
    ((float*)(p->ws + WS_MOD))[(l * 5 + c) * 6144 + n0 + cc] = s + bmod[n0 + cc]; }
}

struct CvtMat { const float* src; int K, N, Npad; bf16_t* dst; int ldk, perm; };
__device__ __forceinline__ CvtMat get_mat(KP p, int layer, int i) {
  bf16_t* WB = (bf16_t*)(p->ws + WS_WB);
  if (layer == 0) {
    switch (i) {
      case 0: return CvtMat{p->in[11], 1024, 1536, 1536, WB + W0_IN, 1024, 0};
      case 1: return CvtMat{p->in[21], 1024, 1024, 1024, WB + W0_OUT, 1024, 0};
      case 2: return CvtMat{p->in[22], 1024, 4096, 4096, WB + W0_W1, 1024, 0};
      default: return CvtMat{p->in[23], 4096, 1024, 1024, WB + W0_W2, 4096, 0};
    }
  } else {
    switch (i) {
      case 0: return CvtMat{p->in[28], 1024, 672, 768, WB + W1_IN, 1024, 0};
      case 1: return CvtMat{p->in[30], 384, 1536, 1536, WB + W1_QB, 384, 1};
      case 2: return CvtMat{p->in[32], 256, 2048, 2048, WB + W1_KVB, 256, 0};
      case 3: return CvtMat{p->in[33], 1024, 1024, 1024, WB + W1_OUT, 1024, 0};
      case 4: return CvtMat{p->in[34], 1024, 4096, 4096, WB + W1_W1, 1024, 0};
      default: return CvtMat{p->in[35], 4096, 1024, 1024, WB + W1_W2, 4096, 0};
    }
  }
}
struct CvtTile { const float* src; int K, N; bf16_t* dst; int ldk, perm, k0, n0; };
__device__ __forceinline__ CvtTile cvt_desc(KP p, int layer, int t, int total) {
  bf16_t* WB = (bf16_t*)(p->ws + WS_WB);
  const int nm = layer == 0 ? 4 : 6;
  if (t < total) {
    int tt = t, i = 0;
    for (; i < nm - 1; ++i) { CvtMat m = get_mat(p, layer, i); int c = (m.K / 64) * (m.Npad / 64); if (tt < c) break; tt -= c; }
    const CvtMat m = get_mat(p, layer, i);
    const int nn = m.Npad / 64;
    return CvtTile{m.src, m.K, m.N, m.dst, m.ldk, m.perm, (tt / nn) * 64, (tt % nn) * 64};
  }
  const int e = t - total;
  if (e < 32) {
    const int dg = e >> 3, nb = e & 7, dir = dg >> 1, gate = dg & 1;
    return CvtTile{p->in[gate == 0 ? 14 : 16] + (size_t)(dir * 8 + nb) * 4096, 64, 64, WB + W0_G + (size_t)e * 4096, 64, 0, 0, 0};
  }
  const int e2 = e - 32, gi = e2 >> 2, q = e2 & 3;
  return CvtTile{p->in[19] + (size_t)gi * 16384, 128, 128, WB + W0_P + (size_t)gi * 16384, 128, 0, (q >> 1) * 64, (q & 1) * 64};
}
__device__ __forceinline__ void cvt_load(const CvtTile& d, int tid, f32x4& v0, f32x4& v1) {
  const int kk = tid >> 4, n4 = (tid & 15) * 4;
  const f32x4 zero = {0.f, 0.f, 0.f, 0.f};
  const bool ok = d.n0 + n4 < d.N;
  const float* sp = d.src + (size_t)(d.k0 + kk) * d.N + d.n0 + (ok ? n4 : 0);
  v0 = ok ? *(const f32x4*)sp : zero;
  v1 = ok ? *(const f32x4*)(sp + (size_t)32 * d.N) : zero;
}
__device__ void cvt_weights(KP p, int layer, int start, int stride) {
  float* tile = (float*)dyn_shm;
  const int total = layer == 0 ? 384 + 256 + 1024 + 1024 : 192 + 144 + 128 + 256 + 1024 + 1024;
  const int all = total + (layer == 0 ? 32 + 16 : 0);
  const int tid = tid_();
  int t = start;
  if (t >= all) return;
  CvtTile d = cvt_desc(p, layer, t, total);
  f32x4 v0, v1; cvt_load(d, tid, v0, v1);
  for (;;) {
    const int kk = tid >> 4, n4 = (tid & 15) * 4;
    __syncthreads();
    tile[kk * 65 + n4 + 0] = v0[0]; tile[kk * 65 + n4 + 1] = v0[1]; tile[kk * 65 + n4 + 2] = v0[2]; tile[kk * 65 + n4 + 3] = v0[3];
    tile[(kk + 32) * 65 + n4 + 0] = v1[0]; tile[(kk + 32) * 65 + n4 + 1] = v1[1]; tile[(kk + 32) * 65 + n4 + 2] = v1[2]; tile[(kk + 32) * 65 + n4 + 3] = v1[3];
    __syncthreads();
    const int tn = t + stride; const bool more = tn < all;
    CvtTile dn = d;
    if (more) { dn = cvt_desc(p, layer, tn, total); cvt_load(dn, tid, v0, v1); }
    {
      int n = tid >> 3, k8 = (tid & 7) * 8, ng = d.n0 + n;
      if (d.perm) { int hh = ng / 96, dd = ng % 96; ng = dd < 64 ? hh * 64 + dd : 1024 + hh * 32 + (dd - 64); }
      float v[8];
#pragma unroll
      for (int j = 0; j < 8; ++j) v[j] = tile[(k8 + j) * 65 + n];
      const float wsc = d.perm ? ATT_SCALE * 1.4426950408889634f : 1.f;
      u32x4 w = {cvtpk(v[0] * wsc, v[1] * wsc), cvtpk(v[2] * wsc, v[3] * wsc), cvtpk(v[4] * wsc, v[5] * wsc), cvtpk(v[6] * wsc, v[7] * wsc)};
      *(u32x4*)(d.dst + (size_t)ng * d.ldk + d.k0 + k8) = w;
    }
    if (!more) break;
    t = tn; d = dn;
  }
}

__device__ __forceinline__ void mod_row_store(bf16_t* H, int row, int lane, const f32x4 (&x)[4], const f32x4 (&gv)[4], float ss, const float* modl, int chunk_shift) {
  const float rstd = rsqrtf(ss * (1.f / DM) + EPS);
  const float* mc = modl + cond_of_row(row) * 6144 + chunk_shift * 1024;
#pragma unroll
  for (int i = 0; i < 4; ++i) {
    const int col = (i * 64 + lane) * 4;
    f32x4 sh = *(const f32x4*)(mc + col), sc = *(const f32x4*)(mc + 1024 + col);
    f32x4 y = x[i] * rstd * gv[i] * (sc + 1.f) + sh;
    u32x2 w; w.x = cvtpk(y[0], y[1]); w.y = cvtpk(y[2], y[3]);
    *(u32x2*)(H + (size_t)row * DM + col) = w;
  }
}
__device__ void modulate_phase(KP p, const float* src0, const float* src1, const float* g, const float* modl, int chunk_shift) {
  bf16_t* H = (bf16_t*)(p->ws + WS_H);
  const int tid = tid_(); const int wid = tid >> 6, lane = tid & 63;
  f32x4 gv[4];
#pragma unroll
  for (int i = 0; i < 4; ++i) gv[i] = *(const f32x4*)(g + (i * 64 + lane) * 4);
  const int stride = gdim_() * 8;
  for (int row = bid_() * 8 + wid; row < M; row += 2 * stride) {
    const int row2 = row + stride; const bool v2 = row2 < M; const int r2 = v2 ? row2 : row;
    const float* xp = row < MP ? src0 + (size_t)row * DM : src1 + (size_t)(row - MP) * DM;
    const float* xq = r2 < MP ? src0 + (size_t)r2 * DM : src1 + (size_t)(r2 - MP) * DM;
    f32x4 x[4], z[4]; float ss = 0, s2 = 0;
#pragma unroll
    for (int i = 0; i < 4; ++i) { x[i] = *(const f32x4*)(xp + (i * 64 + lane) * 4); z[i] = *(const f32x4*)(xq + (i * 64 + lane) * 4); }
#pragma unroll
    for (int i = 0; i < 4; ++i) { ss += x[i][0] * x[i][0] + x[i][1] * x[i][1] + x[i][2] * x[i][2] + x[i][3] * x[i][3]; s2 += z[i][0] * z[i][0] + z[i][1] * z[i][1] + z[i][2] * z[i][2] + z[i][3] * z[i][3]; }
    ss = wave_sum(ss, lane); s2 = wave_sum(s2, lane);
    mod_row_store(H, row, lane, x, gv, ss, modl, chunk_shift);
    if (v2) mod_row_store(H, row2, lane, z, gv, s2, modl, chunk_shift);
  }
}
__device__ void final_norm_phase(KP p, int dry) {
  float* X = p->out; const float* g = p->in[36];
  const int tid = tid_(); const int wid = tid >> 6, lane = tid & 63;
  f32x4 gv[4];
#pragma unroll
  for (int i = 0; i < 4; ++i) gv[i] = *(const f32x4*)(g + (i * 64 + lane) * 4);
  const int stride = gdim_() * 8;
  for (int row = bid_() * 8 + wid; row < M; row += 2 * stride) {
    const int row2 = row + stride; const bool v2 = row2 < M; const int r2 = v2 ? row2 : row;
    float* xp = X + (size_t)row * DM; float* xq = X + (size_t)r2 * DM;
    f32x4 x[4], z[4]; float ss = 0, s2 = 0;
#pragma unroll
    for (int i = 0; i < 4; ++i) { x[i] = *(const f32x4*)(xp + (i * 64 + lane) * 4); z[i] = *(const f32x4*)(xq + (i * 64 + lane) * 4); }
#pragma unroll
    for (int i = 0; i < 4; ++i) { ss += x[i][0] * x[i][0] + x[i][1] * x[i][1] + x[i][2] * x[i][2] + x[i][3] * x[i][3]; s2 += z[i][0] * z[i][0] + z[i][1] * z[i][1] + z[i][2] * z[i][2] + z[i][3] * z[i][3]; }
    ss = wave_sum(ss, lane); s2 = wave_sum(s2, lane);
    const float rstd = rsqrtf(ss * (1.f / DM) + EPS), rstd2 = rsqrtf(s2 * (1.f / DM) + EPS);
    if (!dry) {
#pragma unroll
      for (int i = 0; i < 4; ++i) *(f32x4*)(xp + (i * 64 + lane) * 4) = x[i] * rstd * gv[i];
      if (v2) {
#pragma unroll
        for (int i = 0; i < 4; ++i) *(f32x4*)(xq + (i * 64 + lane) * 4) = z[i] * rstd2 * gv[i];
      }
    }
  }
}
struct L1Row { f32x4 qa, qb, kv; float kp; };
__device__ __forceinline__ void l1_row_load(const float* Z1, int row, int lane, L1Row& r) {
  const float* z = Z1 + (size_t)row * 768;
  const f32x4 zero = {0.f, 0.f, 0.f, 0.f};
  r.qa = lane < 48 ? *(const f32x4*)(z + lane * 4) : zero;
  r.qb = lane < 48 ? *(const f32x4*)(z + 192 + lane * 4) : zero;
  r.kv = *(const f32x4*)(z + 384 + lane * 4);
  r.kp = lane < 32 ? z[640 + lane] : 0.f;
}
__device__ __forceinline__ void l1_row_finish(KP p, int row, int lane, const L1Row& r, const f32x4& gqa, const f32x4& gqb, const f32x4& gk) {
  bf16_t* CQN = (bf16_t*)(p->ws + WS_CQN); bf16_t* CKVN = (bf16_t*)(p->ws + WS_CKVN); bf16_t* KPE = (bf16_t*)(p->ws + WS_KPE);
  const float* ropetab = (const float*)(p->ws + WS_ROPE);
  float ss = r.qa[0] * r.qa[0] + r.qa[1] * r.qa[1] + r.qa[2] * r.qa[2] + r.qa[3] * r.qa[3] + r.qb[0] * r.qb[0] + r.qb[1] * r.qb[1] + r.qb[2] * r.qb[2] + r.qb[3] * r.qb[3];
  ss = wave_sum(ss, lane);
  const float rstd = rsqrtf(ss * (1.f / 384) + EPS);
  if (lane < 48) {
    const f32x4 ya = r.qa * rstd * gqa, yb = r.qb * rstd * gqb;
    u32x2 wa; wa.x = cvtpk(ya[0], ya[1]); wa.y = cvtpk(ya[2], ya[3]);
    u32x2 wb; wb.x = cvtpk(yb[0], yb[1]); wb.y = cvtpk(yb[2], yb[3]);
    *(u32x2*)(CQN + (size_t)row * 384 + lane * 4) = wa; *(u32x2*)(CQN + (size_t)row * 384 + 192 + lane * 4) = wb;
  }
  const float s2 = wave_sum(r.kv[0] * r.kv[0] + r.kv[1] * r.kv[1] + r.kv[2] * r.kv[2] + r.kv[3] * r.kv[3], lane);
  const float r2 = rsqrtf(s2 * (1.f / 256) + EPS);
  const f32x4 y = r.kv * r2 * gk;
  int krow; bool rope; int s = 0;
  if (row < MP) { krow = row; rope = false; *(f32x4*)(p->out + O_CKV + (size_t)row * 256 + lane * 4) = y; }
  else { int b = (row - MP) >> 12; s = (row - MP) & 4095; krow = MP + b * SKEYS + s; rope = true; }
  u32x2 w; w.x = cvtpk(y[0], y[1]); w.y = cvtpk(y[2], y[3]);
  *(u32x2*)(CKVN + (size_t)krow * 256 + lane * 4) = w;
  const float kp = r.kp;
  const float partner = lane_xor(kp, lane, 8);
  if (!rope) { if (lane < 32) { p->out[O_KPE + (size_t)row * 32 + lane] = kp; KPE[(size_t)krow * 32 + lane] = f2bf(kp); } }
  else if (lane < 32) {
    int pos = lane < 16 ? (s >> 6) : (s & 63); int j = lane & 7;
    float cs = ropetab[pos * 16 + 2 * j], sn = ropetab[pos * 16 + 2 * j + 1];
    float ov = (lane & 8) == 0 ? kp * cs - partner * sn : kp * cs + partner * sn;
    KPE[(size_t)krow * 32 + lane] = f2bf(ov);
  }
}
__device__ void l1_rows_phase(KP p) {
  const float* Z1 = (const float*)(p->ws + WS_Z1);
  bf16_t* CKVN = (bf16_t*)(p->ws + WS_CKVN); bf16_t* KPE = (bf16_t*)(p->ws + WS_KPE);
  const int tid = tid_(); const int wid = tid >> 6, lane = tid & 63;
  const int l48 = lane < 48 ? lane : 0;
  const f32x4 gqa = *(const f32x4*)(p->in[29] + l48 * 4), gqb = *(const f32x4*)(p->in[29] + 192 + l48 * 4), gk = *(const f32x4*)(p->in[31] + lane * 4);
  const int stride = gdim_() * 8;
  for (int row = bid_() * 8 + wid; row < M; row += 2 * stride) {
    const int row2 = row + stride; const bool v2 = row2 < M;
    L1Row ra, rb;
    l1_row_load(Z1, row, lane, ra); l1_row_load(Z1, v2 ? row2 : row, lane, rb);
    l1_row_finish(p, row, lane, ra, gqa, gqb, gk);
    if (v2) l1_row_finish(p, row2, lane, rb, gqa, gqb, gk);
  }
  for (int idx = bid_() * 8 + wid; idx < NB_S * PAST; idx += stride) {
    const int b = idx >> 9, j = idx & 511, krow = MP + b * SKEYS + DSEQ + j;
    f32x4 kv = *(const f32x4*)(p->in[3] + ((size_t)(b * PAST + j)) * 256 + lane * 4);
    u32x2 w; w.x = cvtpk(kv[0], kv[1]); w.y = cvtpk(kv[2], kv[3]);
    *(u32x2*)(CKVN + (size_t)krow * 256 + lane * 4) = w;
    if (lane < 32) KPE[(size_t)krow * 32 + lane] = f2bf(p->in[4][((size_t)(b * PAST + j)) * 32 + lane]);
  }
}

__device__ __forceinline__ float fast_sigmoid(float x) { return __builtin_amdgcn_rcpf(1.f + __expf(-x)); }
__device__ __forceinline__ float fast_gelu(float x) {
  float u = 0.7978845608028654f * (x + 0.044715f * x * x * x);
  float e = __expf(2.f * u);
  float th = 1.f - 2.f * __builtin_amdgcn_rcpf(e + 1.f);
  return 0.5f * x * (1.f + th);
}
__device__ __forceinline__ float bperm(int srclane, float v) { return __int_as_float(__builtin_amdgcn_ds_bpermute(srclane << 2, __float_as_int(v))); }
__device__ __forceinline__ void scan4(float& P, float& H, int lane, int stepl, int oq) {
  { const float Pp = bperm(lane - stepl, P), Hp = bperm(lane - stepl, H); if (oq >= 1) { H = P * Hp + H; P = Pp * P; } }
  { const float Pp = bperm(lane - 2 * stepl, P), Hp = bperm(lane - 2 * stepl, H); if (oq >= 2) { H = P * Hp + H; P = Pp * P; } }
}
__device__ void lru_item(KP p, int cidx, int nb, int mode) {
  const bf16_t* Z0 = (const bf16_t*)(p->ws + WS_Z0); bf16_t* H = (bf16_t*)(p->ws + WS_H);
  const bf16_t* Wg = (const bf16_t*)(p->ws + WS_WB) + W0_G;
  const float* LS8 = (const float*)(p->ws + WS_LS8);
  float2* SUM = (float2*)(p->ws + WS_SUM);
  float* xrL = (float*)dyn_shm;
  float* xc = xrL + 67 * 64;
  bf16_t* xcb = (bf16_t*)(xc + 64 * 64);
  float* Hs = (float*)(xcb + 64 * 72);
  const int tid = tid_(), lane = tid & 63, fr = lane & 15, fq = lane >> 4;
  const int wid = __builtin_amdgcn_readfirstlane(tid >> 6), dir = wid >> 2, wq = wid & 3;
  const int t0 = cidx * 64;
  int s0, s1, bsamp = -1;
  if (t0 < MP) { s0 = (t0 / SEQ) * SEQ; s1 = s0 + SEQ; } else { bsamp = (t0 - MP) / DSEQ; s0 = MP + bsamp * DSEQ; s1 = s0 + DSEQ; }
  const int c0 = s0 / 64, c1 = s1 / 64;
  const int chc = tid & 63, cgc = nb * 64 + chc;
  const int ch = wq * 16 + fr, cg_ = nb * 64 + ch;
  const int oq = dir ? 3 - fq : fq, stepl = dir ? -16 : 16, lastl = fr + (dir ? 0 : 48);
  unsigned xv[5];
#pragma unroll
  for (int i = 0; i < 5; ++i) { int e = tid + i * 512; int r = e >> 5, c2 = (e & 31) * 2, t = t0 - 2 + r;
    xv[i] = (e < 67 * 32 && t >= s0 && t < s1) ? *(const unsigned*)(Z0 + (size_t)t * 1536 + nb * 64 + c2) : 0u; }
  const float* cw = p->in[12];
  const float w0 = cw[cgc], w1 = cw[512 + cgc], w2 = cw[1024 + cgc], w3 = cw[1536 + cgc], bb = p->in[13][cgc];
  const float ba = p->in[15][dir * 512 + cg_], bi = p->in[17][dir * 512 + cg_], l8 = LS8[dir * 512 + cg_];
  bf16x8 wa[2], wi[2];
  { const bf16_t* pa = Wg + (size_t)((dir * 2 + 0) * 8 + nb) * 4096 + (size_t)ch * 64 + fq * 8; const bf16_t* pi = pa + 8 * 4096;
    wa[0] = *(const bf16x8*)pa; wa[1] = *(const bf16x8*)(pa + 32); wi[0] = *(const bf16x8*)pi; wi[1] = *(const bf16x8*)(pi + 32); }
  unsigned gz[4] = {0u, 0u, 0u, 0u};
  if (mode == 1) {
#pragma unroll
    for (int i = 0; i < 4; ++i) { int e = tid + i * 512; int t = e >> 5, c2 = (e & 31) * 2; gz[i] = *(const unsigned*)(Z0 + (size_t)(t0 + t) * 1536 + 512 + nb * 64 + c2); }
  }
  float cP = 1.f, cH = 0.f;
  if (mode == 1) {
    int lo, hi;
    if (dir == 0) { const int n = cidx - c0, q = (n + 3) >> 2; lo = c0 + fq * q; hi = lo + q < cidx ? lo + q : cidx;
      for (int c = lo; c < hi; c += 4) { float2 sm[4];
#pragma unroll
        for (int j = 0; j < 4; ++j) sm[j] = (c + j < hi) ? SUM[((size_t)(c + j) * 2) * 512 + cg_] : make_float2(1.f, 0.f);
#pragma unroll
        for (int j = 0; j < 4; ++j) { cH = sm[j].x * cH + sm[j].y; cP *= sm[j].x; } }
    } else { const int n = c1 - 1 - cidx, q = (n + 3) >> 2; hi = c1 - 1 - fq * q; lo = hi - q > cidx ? hi - q : cidx;
      for (int c = hi; c > lo; c -= 4) { float2 sm[4];
#pragma unroll
        for (int j = 0; j < 4; ++j) sm[j] = (c - j > lo) ? SUM[((size_t)(c - j) * 2 + 1) * 512 + cg_] : make_float2(1.f, 0.f);
#pragma unroll
        for (int j = 0; j < 4; ++j) { cH = sm[j].x * cH + sm[j].y; cP *= sm[j].x; } }
    }
  }
  __syncthreads();
#pragma unroll
  for (int i = 0; i < 5; ++i) { int e = tid + i * 512; if (e < 67 * 32) { int r = e >> 5, c2 = (e & 31) * 2;
    xrL[r * 64 + c2] = bf2f((bf16_t)(xv[i] & 0xffff)); xrL[r * 64 + c2 + 1] = bf2f((bf16_t)(xv[i] >> 16)); } }
  __syncthreads();
#pragma unroll
  for (int i = 0; i < 8; ++i) { int t = (tid >> 6) + 8 * i;
    float v = bb + w0 * xrL[t * 64 + chc] + w1 * xrL[(t + 1) * 64 + chc] + w2 * xrL[(t + 2) * 64 + chc] + w3 * xrL[(t + 3) * 64 + chc];
    xc[t * 64 + chc] = v; xcb[t * 72 + chc] = f2bf(v); }
  __syncthreads();
  float av[4][4], uv[4][4], Pt[4], Ht[4], Pe[4], He[4];
#pragma unroll
  for (int mt = 0; mt < 4; ++mt) {
    const bf16x8 a0 = *(const bf16x8*)(xcb + (mt * 16 + fr) * 72 + fq * 8), a1 = *(const bf16x8*)(xcb + (mt * 16 + fr) * 72 + 32 + fq * 8);
    f32x4 ga = {0.f, 0.f, 0.f, 0.f}, gi = {0.f, 0.f, 0.f, 0.f};
    ga = __builtin_amdgcn_mfma_f32_16x16x32_bf16(a0, wa[0], ga, 0, 0, 0); ga = __builtin_amdgcn_mfma_f32_16x16x32_bf16(a1, wa[1], ga, 0, 0, 0);
    gi = __builtin_amdgcn_mfma_f32_16x16x32_bf16(a0, wi[0], gi, 0, 0, 0); gi = __builtin_amdgcn_mfma_f32_16x16x32_bf16(a1, wi[1], gi, 0, 0, 0);
#pragma unroll
    for (int j = 0; j < 4; ++j) {
      const float ea = 1.f + __expf(fminf(-(ga[j] + ba), 40.f)), ei = 1.f + __expf(fminf(-(gi[j] + bi), 40.f));
      const float rc = __builtin_amdgcn_rcpf(ea * ei);
      const float r = rc * ei, ii = rc * ea;
      const float la = r * l8;
      const float a = __expf(la);
      const float x2 = 2.f * la;
      const float om = x2 > -0.25f ? -x2 * (1.f + x2 * 0.5f * (1.f + x2 * (1.f / 3.f) * (1.f + x2 * 0.25f * (1.f + x2 * 0.2f * (1.f + x2 * (1.f / 6.f)))))) : 1.f - a * a;
      av[mt][j] = a; uv[mt][j] = __builtin_amdgcn_sqrtf(fmaxf(om, 0.f)) * ii * xc[(mt * 16 + fq * 4 + j) * 64 + ch];
    }
    float P = 1.f, Hh = 0.f;
    if (dir == 0) {
#pragma unroll
      for (int j = 0; j < 4; ++j) { Hh = av[mt][j] * Hh + uv[mt][j]; P *= av[mt][j]; }
    } else {
#pragma unroll
      for (int j = 3; j >= 0; --j) { Hh = av[mt][j] * Hh + uv[mt][j]; P *= av[mt][j]; }
    }
    scan4(P, Hh, lane, stepl, oq);
    const float Pp = bperm(lane - stepl, P), Hp = bperm(lane - stepl, Hh);
    Pe[mt] = oq >= 1 ? Pp : 1.f; He[mt] = oq >= 1 ? Hp : 0.f;
    Pt[mt] = bperm(lastl, P); Ht[mt] = bperm(lastl, Hh);
  }
  if (mode == 0) {
    float P = 1.f, Hh = 0.f;
    if (dir == 0) {
#pragma unroll
      for (int mt = 0; mt < 4; ++mt) { Hh = Pt[mt] * Hh + Ht[mt]; P *= Pt[mt]; }
    } else {
#pragma unroll
      for (int mt = 3; mt >= 0; --mt) { Hh = Pt[mt] * Hh + Ht[mt]; P *= Pt[mt]; }
    }
    if (fq == 0) SUM[((size_t)cidx * 2 + dir) * 512 + cg_] = make_float2(P, Hh);
    return;
  }
  scan4(cP, cH, lane, 16, fq);
  const float tP = bperm(fr + 48, cP), tH = bperm(fr + 48, cH);
  float c = bsamp >= 0 ? p->in[2][(bsamp * 2 + dir) * 512 + cg_] : 0.f;
  c = tP * c + tH;
  float* hp = Hs + dir * 4096 + ch;
  if (dir == 0) {
#pragma unroll
    for (int mt = 0; mt < 4; ++mt) { float s = Pe[mt] * c + He[mt];
#pragma unroll
      for (int j = 0; j < 4; ++j) { s = av[mt][j] * s + uv[mt][j]; hp[(mt * 16 + fq * 4 + j) * 64] = s; }
      c = Pt[mt] * c + Ht[mt]; }
    if (bsamp < 0 && cidx == c1 - 1 && fq == 0) p->out[O_LRU + (size_t)((t0 / SEQ) * 2 + 0) * 512 + cg_] = c;
  } else {
#pragma unroll
    for (int mt = 3; mt >= 0; --mt) { float s = Pe[mt] * c + He[mt];
#pragma unroll
      for (int j = 3; j >= 0; --j) { s = av[mt][j] * s + uv[mt][j]; hp[(mt * 16 + fq * 4 + j) * 64] = s; }
      c = Pt[mt] * c + Ht[mt]; }
    if (bsamp < 0 && cidx == c0 && fq == 0) p->out[O_LRU + (size_t)((t0 / SEQ) * 2 + 1) * 512 + cg_] = c;
  }
  __syncthreads();
#pragma unroll
  for (int i = 0; i < 4; ++i) { int e = tid + i * 512; int t = e >> 5, c2 = (e & 31) * 2;
    float g0 = bf2f((bf16_t)(gz[i] & 0xffff)), g1 = bf2f((bf16_t)(gz[i] >> 16));
    float y0 = (Hs[t * 64 + c2] + Hs[4096 + t * 64 + c2]) * fast_gelu(g0);
    float y1 = (Hs[t * 64 + c2 + 1] + Hs[4096 + t * 64 + c2 + 1]) * fast_gelu(g1);
    *(unsigned*)(H + (size_t)(t0 + t) * DM + nb * 64 + c2) = cvtpk(y0, y1); }
}

__device__ void pool_item(KP p, int cidx, int gi) {
  const bf16_t* Z0 = (const bf16_t*)(p->ws + WS_Z0); bf16_t* H = (bf16_t*)(p->ws + WS_H);
  const bf16_t* Wp = (const bf16_t*)(p->ws + WS_WB) + W0_P + (size_t)gi * 16384;
  float* xp = (float*)dyn_shm;
  bf16_t* dL = (bf16_t*)(xp + 80 * 128);
  const int tid = tid_(), wid = tid >> 6, lane = tid & 63, fr = lane & 15, fq = lane >> 4;
  const int t0 = cidx * 64;
  int s0, s1;
  if (t0 < MP) { s0 = (t0 / SEQ) * SEQ; s1 = s0 + SEQ; } else { int b = (t0 - MP) / DSEQ; s0 = MP + b * DSEQ; s1 = s0 + DSEQ; }
  __syncthreads();
  for (int e = tid; e < 80 * 64; e += 512) { int r = e >> 6, c2 = (e & 63) * 2, t = t0 - 8 + r;
    float a = 0.f, b = 0.f;
    if (t >= s0 && t < s1) { unsigned v = *(const unsigned*)(Z0 + (size_t)t * 1536 + 1024 + gi * 128 + c2); a = bf2f((bf16_t)(v & 0xffff)); b = bf2f((bf16_t)(v >> 16)); }
    xp[r * 128 + c2] = a; xp[r * 128 + c2 + 1] = b; }
  __syncthreads();
  const int w = 2 << gi, left = w >> 1, right = w - 1 - left;
  {
    const int c = tid & 127, tq = tid >> 7, tb = tq * 16;
    float S = 0.f;
    for (int k = tb - left; k <= tb + right; ++k) S += xp[(k + 8) * 128 + c];
#pragma unroll
    for (int i = 0; i < 16; ++i) { const int t = tb + i, tg = t0 + t;
      const int lo = tg - left < s0 ? s0 : tg - left, hi = tg + right > s1 - 1 ? s1 - 1 : tg + right;
      const float d = S * __builtin_amdgcn_rcpf((float)(hi - lo + 1)) - xp[(t + 8) * 128 + c];
      dL[t * 136 + c] = f2bf(d);
      S += xp[(t + 1 + right + 8) * 128 + c] - xp[(t - left + 8) * 128 + c]; }
  }
  __syncthreads();
  {
    bf16x8 wf[4];
#pragma unroll
    for (int ks = 0; ks < 4; ++ks) wf[ks] = *(const bf16x8*)(Wp + (size_t)(wid * 16 + fr) * 128 + ks * 32 + fq * 8);
    const f32x4 sc = *(const f32x4*)(p->in[20] + gi * 128 + wid * 16 + fq * 4);
#pragma unroll
    for (int mt = 0; mt < 4; ++mt) {
      f32x4 acc = {0.f, 0.f, 0.f, 0.f};
#pragma unroll
      for (int ks = 0; ks < 4; ++ks) {
        bf16x8 df = *(const bf16x8*)(dL + (mt * 16 + fr) * 136 + ks * 32 + fq * 8);
        acc = __builtin_amdgcn_mfma_f32_16x16x32_bf16(wf[ks], df, acc, 0, 0, 0);
      }
      acc = acc * sc;
      u32x2 o; o.x = cvtpk(acc[0], acc[1]); o.y = cvtpk(acc[2], acc[3]);
      *(u32x2*)(H + (size_t)(t0 + mt * 16 + fr) * DM + 512 + gi * 128 + wid * 16 + fq * 4) = o;
    }
  }
}

__global__ void __launch_bounds__(512, 2) fwd_megakernel(Params kparams) {
  cg::grid_group grid = cg::this_grid();
  KP p = (KP)__builtin_amdgcn_kernarg_segment_ptr();
  unsigned char* ws = p->ws;
  bf16_t* WB = (bf16_t*)(ws + WS_WB);
  bf16_t* H = (bf16_t*)(ws + WS_H);
  float* X = p->out;
  const float* MOD = (const float*)(ws + WS_MOD);
  volatile LAS unsigned* xst = (volatile LAS unsigned*)(dyn_shm + LDS_MAIN);
  if (threadIdx.x == 0) { xst[0] = 0u; xst[1] = 0u; }
  __syncthreads();
  (void)xcd_barrier_post((unsigned*)(ws + WS_BAR), xst);
  int rep = 0;
  const int p_lo = p->p_lo, p_hi = p->p_hi, probe = p->pad, coop = p->coop;
  for (int ph = p_lo; ph < p_hi; ++ph) {
    asm volatile("" : "+s"(p));
    const int G = gdim_(), bid = bid_();
    unsigned char* ws = p->ws; bf16_t* WB = (bf16_t*)(ws + WS_WB); bf16_t* H = (bf16_t*)(ws + WS_H); float* X = p->out; const float* MOD = (const float*)(ws + WS_MOD);
#if PROBE_PH >= 0
    const int dry = (ph == probe && rep == 0) ? 1 : 0;
#else
    const int dry = 0;
#endif
    if (PROBE_PH == 99 && probe == 99 && ph == 1) { XcdBarrier xb; xb.bar = (unsigned*)(ws + WS_BAR); xb.st = (volatile LAS unsigned*)(dyn_shm + LDS_MAIN); for (int q = 0; q < 10; ++q) xcd_barrier(xb); }
    GemmDesc g1{nullptr, nullptr, 0, 0, 0, 0, 0, 0, nullptr, 0, nullptr, nullptr, nullptr, 0, 0};
    bool isg = false;
    const float* MODL = MOD + (ph >= 11 ? 5 * 6144 : 0);
    const bf16_t* U = (const bf16_t*)(ws + WS_U);
    switch (ph) {
      case 0: {
        for (int it = bid; it < 192; it += G) mod_gemv_item(p, it);
        if (bid == G - 1) { int t = tid_(); int pos = t >> 3, j = t & 7;
          float inv = exp2f(-(float)j * 0.125f * 13.287712379549449f);
          float s, c; my_sincos((float)pos * inv, s, c);
          float* rt = (float*)(ws + WS_ROPE); rt[t * 2] = c; rt[t * 2 + 1] = s; }
        if (bid == G - 2) { int t = tid_(); float* l8 = (float*)(ws + WS_LS8);
          for (int e = t; e < 1024; e += 512) l8[e] = -8.f * log1pf(__expf(-p->in[18][e])); }
      } break;
      case 2: g1 = GemmDesc{H, WB + W0_IN, 1024, 1024, M, 1536, 1024, 0, ws + WS_Z0, 1536, nullptr, nullptr, nullptr, 0, 0}; isg = true; break;
      case 5: g1 = GemmDesc{H, WB + W0_OUT, 1024, 1024, M, 1024, 1024, 2, X, 1024, p->in[0], p->in[1], MOD + 2 * 1024, 0, 0}; isg = true; break;
      case 7: case 9: case 19: case 21: { int ro = (ph == 7 || ph == 19) ? 0 : MH;
        g1 = GemmDesc{H + (size_t)ro * DM, WB + (ph < 11 ? W0_W1 : W1_W1), 1024, 1024, MH, 4096, 1024, 1, ws + WS_U, 4096, nullptr, nullptr, nullptr, 0, 0}; isg = true; } break;
      case 8: case 10: case 20: case 22: { int ro = (ph == 8 || ph == 20) ? 0 : MH;
        g1 = GemmDesc{U, WB + (ph < 11 ? W0_W2 : W1_W2), 4096, 4096, MH, 1024, 4096, 2, X, 1024, X, X + (size_t)MP * DM, MODL + 5 * 1024, ro, 0}; isg = true; } break;
      case 12: g1 = GemmDesc{H, WB + W1_IN, 1024, 1024, M, 768, 1024, 3, ws + WS_Z1, 768, nullptr, nullptr, nullptr, 0, 0}; isg = true; break;
      case 13: l1_rows_phase(p); break;
      case 14: g1 = GemmDesc{(const bf16_t*)(ws + WS_CQN), WB + W1_QB, 384, 384, M, 1536, 384, 0, ws + WS_Q, 1536, nullptr, nullptr, nullptr, 0, 0}; isg = true; break;
      case 15: g1 = GemmDesc{(const bf16_t*)(ws + WS_CKVN), WB + W1_KVB, 256, 256, KROWS, 2048, 256, 0, ws + WS_KV, 2048, nullptr, nullptr, nullptr, 0, 0}; isg = true; break;
#ifndef NO_ATTN
      case 16: attn_phase(p, dry); break;
#endif
      case 17: g1 = GemmDesc{(const bf16_t*)(ws + WS_Q), WB + W1_OUT, 1536, 1024, M, 1024, 1024, 2, X, 1024, X, X + (size_t)MP * DM, MODL + 2 * 1024, 0, 0}; isg = true; break;
      case 23: final_norm_phase(p, dry); break;
      default: break;
    }
    if (ph == 1 || ph == 6 || ph == 11 || ph == 18) {
      const bool first = ph == 1;
      modulate_phase(p, first ? p->in[0] : X, first ? p->in[1] : X + (size_t)MP * DM, p->in[ph == 1 ? 9 : ph == 6 ? 10 : ph == 11 ? 26 : 27], MODL, (ph == 1 || ph == 11) ? 0 : 3);
    }
    if (ph == 0 || ph == 11) cvt_weights(p, ph == 0 ? 0 : 1, ph == 0 ? (bid + G - 192 % G) % G : bid, G);
#ifndef NO_LRU
    if (ph == 3 || ph == 4) {
      const int nit = ph == 3 ? 3072 + 1536 : 3072;
      for (int it = bid; it < nit; it += G) { if (it < 3072) lru_item(p, it >> 3, it & 7, ph - 3); else pool_item(p, (it - 3072) >> 2, (it - 3072) & 3); }
    }
#endif
#ifndef NO_GEMM
    g1.dry = (dry && g1.mode == 2 && ph != 5) ? 1 : 0;
    if (isg) gemm_phase(g1);
#endif
    if (coop && ph + 1 < p_hi && ph != 14) {
      if (ph == 0 && !dry) grid.sync(); else { XcdBarrier xb; xb.bar = (unsigned*)(ws + WS_BAR); xb.st = (volatile LAS unsigned*)(dyn_shm + LDS_MAIN); xcd_barrier(xb); } }
#if PROBE_PH >= 0
    if (dry) { rep = 1; --ph; }
#endif
  }
}

#ifndef MK_SPLIT
#define MK_SPLIT 0
#endif
extern "C" void kernel_launch(void* const* d_in, const int* in_sizes, int n_in, void* d_out, int out_size, void* d_ws, size_t ws_size, hipStream_t stream) {
  static int grid = 0;
  if (grid == 0) {
    if (n_in != 37 || ws_size < WS_END) { fprintf(stderr, "kernel_launch: bad n_in %d or ws %zu < %zu\n", n_in, ws_size, (size_t)WS_END); grid = -1; return; }
    int dev = 0, cus = 0, per_cu = 0;
    hipGetDevice(&dev); hipDeviceGetAttribute(&cus, hipDeviceAttributeMultiprocessorCount, dev);
    if (hipFuncSetAttribute((const void*)fwd_megakernel, hipFuncAttributeMaxDynamicSharedMemorySize, LDS_BYTES) != hipSuccess) { fprintf(stderr, "kernel_launch: hipFuncSetAttribute failed\n"); grid = -1; return; }
    if (hipOccupancyMaxActiveBlocksPerMultiprocessor(&per_cu, (const void*)fwd_megakernel, 512, LDS_BYTES) != hipSuccess || per_cu < 1) { fprintf(stderr, "kernel_launch: occupancy query gave %d\n", per_cu); grid = -1; return; }
    grid = cus;
  }
  if (grid < 0) return;
  if (hipMemsetAsync((char*)d_ws + WS_BAR, 0, XCD_BAR_WORDS * 4, stream) != hipSuccess) { fprintf(stderr, "kernel_launch: memset failed\n"); return; }
  Params p{};
  for (int i = 0; i < 37; ++i) p.in[i] = (const float*)d_in[i];
  p.out = (float*)d_out; p.ws = (unsigned char*)d_ws; p.pad = PROBE_PH;
#if MK_SPLIT
  for (int ph = 0; ph < NPH; ++ph) {
    p.p_lo = ph; p.p_hi = ph + 1; p.coop = 0;
    hipLaunchKernelGGL(fwd_megakernel, dim3(grid), dim3(512), LDS_BYTES, stream, p);
  }
#else
  p.p_lo = 0; p.p_hi = NPH; p.coop = 1;
  void* args[] = {&p};
  hipError_t e = hipLaunchCooperativeKernel((const void*)fwd_megakernel, dim3(grid), dim3(512), args, LDS_BYTES, stream);
  if (e != hipSuccess) fprintf(stderr, "cooperative launch failed: %s (grid %d)\n", hipGetErrorString(e), grid);
#endif
}
```

```cpp
#include <hip/hip_runtime.h>
#include <hip/hip_cooperative_groups.h>
#include <cstdio>
#include <cstdint>
namespace cg = cooperative_groups;
#ifndef PROBE_PH
#define PROBE_PH -1
#endif

typedef unsigned short bf16_t;
typedef short bf16x8 __attribute__((ext_vector_type(8)));
typedef short s16x4 __attribute__((ext_vector_type(4)));
typedef float f32x4 __attribute__((ext_vector_type(4)));
typedef float f32x16 __attribute__((ext_vector_type(16)));
typedef unsigned u32x4 __attribute__((ext_vector_type(4)));
typedef unsigned u32x2 __attribute__((ext_vector_type(2)));

constexpr int DM = 1024, MP = 8192, MS = 16384, M = MP + MS, DFF = 4096;
constexpr int SEQ = 256, DSEQ = 4096, PAST = 512, NB_S = 4;
constexpr int KROWS = MP + NB_S * (DSEQ + PAST);
constexpr int SKEYS = DSEQ + PAST;
constexpr int MH = M / 2;
constexpr float EPS = 1e-6f;
constexpr int NPH = 24;

constexpr size_t MiB = 1u << 20;
constexpr size_t WS_MOD = 0;
constexpr size_t WS_ROPE = 256 * 1024;
constexpr size_t WS_LS8 = 260 * 1024;
constexpr size_t WS_SUM = 512 * 1024;
constexpr size_t WS_BAR = 3840 * 1024;
constexpr size_t WS_WB = 4 * MiB;
constexpr size_t WS_R1 = 26 * MiB;
constexpr size_t WS_H = WS_R1;
constexpr size_t WS_Z0 = WS_R1 + 48 * MiB;
constexpr size_t WS_U = WS_R1 + 48 * MiB;
constexpr size_t WS_KV = WS_R1;
constexpr size_t WS_Q = WS_R1 + 104 * MiB;
constexpr size_t WS_Z1 = WS_R1 + 104 * MiB;
constexpr size_t WS_CQN = WS_R1 + 176 * MiB;
constexpr size_t WS_CKVN = WS_R1 + 194 * MiB;
constexpr size_t WS_KPE = WS_R1 + 207 * MiB;
constexpr size_t WS_END = WS_R1 + 209 * MiB;
constexpr size_t W0_IN = 0, W0_OUT = 1572864, W0_W1 = 2621440, W0_W2 = 6815744, W0_G = 11010048, W0_P = 11141120;
constexpr size_t W1_IN = 0, W1_QB = 786432, W1_KVB = 1376256, W1_OUT = 1900544, W1_W1 = 2949120, W1_W2 = 7143424;
constexpr size_t O_Y = 0, O_LRU = 25165824, O_CKV = 25198592, O_KPE = 27295744;

struct Params {
  const float* in[37];
  float* out;
  unsigned char* ws;
  int p_lo, p_hi, coop, pad;
};

typedef const __attribute__((address_space(4))) Params* KP;
extern __shared__ __attribute__((aligned(16))) unsigned char dyn_shm[];
constexpr int LDS_MAIN = 139264;
constexpr int LDS_BYTES = LDS_MAIN + 16;

__device__ __forceinline__ unsigned cvtpk(float lo, float hi) {
  unsigned r; asm volatile("v_cvt_pk_bf16_f32 %0, %1, %2" : "=v"(r) : "v"(lo), "v"(hi)); return r;
}
__device__ __forceinline__ float bf2f(bf16_t b) { return __uint_as_float(((unsigned)b) << 16); }
__device__ __forceinline__ bf16_t f2bf(float f) { return (bf16_t)(cvtpk(f, f) & 0xffffu); }
__device__ __forceinline__ float sigmoidf_(float x) { return 1.f / (1.f + __expf(-x)); }
__device__ __forceinline__ float gelu_tanh(float x) {
  float u = 0.7978845608028654f * (x + 0.044715f * x * x * x);
  float e = __expf(2.f * u);
  float th = 1.f - 2.f / (e + 1.f);
  return 0.5f * x * (1.f + th);
}
__device__ __forceinline__ float lane_xor(float v, int lane, int o) { return __int_as_float(__builtin_amdgcn_ds_bpermute((lane ^ o) << 2, __float_as_int(v))); }
__device__ __forceinline__ float wave_sum(float v, int lane) {
#pragma unroll
  for (int o = 32; o > 0; o >>= 1) v += lane_xor(v, lane, o);
  return v;
}
__device__ __forceinline__ void my_sincos(float a, float& s, float& c) {
  float k = rintf(a * 0.63661977236758134f);
  float r = fmaf(k, -1.5707962513e+00f, a);
  r = fmaf(k, -7.5497894159e-08f, r);
  r = fmaf(k, -5.3903029534e-15f, r);
  float r2 = r * r;
  float sp = r + r * r2 * (-1.6666667163e-01f + r2 * (8.3333337680e-03f + r2 * (-1.9841270114e-04f + r2 * 2.7557314297e-06f)));
  float cp = 1.f + r2 * (-0.5f + r2 * (4.1666667908e-02f + r2 * (-1.3888889225e-03f + r2 * 2.4801587642e-05f)));
  int q = ((int)k) & 3;
  float ss = (q & 1) ? cp : sp, cc = (q & 1) ? sp : cp;
  s = (q & 2) ? -ss : ss;
  c = ((q + 1) & 2) ? -cc : cc;
}
__device__ __forceinline__ int bid_() { int b = blockIdx.x; asm volatile("" : "+s"(b)); return b; }
__device__ __forceinline__ int gdim_() { int g = gridDim.x; asm volatile("" : "+s"(g)); return g; }
__device__ __forceinline__ int tid_() { int t = threadIdx.x; asm volatile("" : "+v"(t)); return t; }
__device__ __forceinline__ int cond_of_row(int row) { return row < MP ? 0 : 1 + ((row - MP) >> 12); }


#define XB_TMO      128
#define XB_XCNT(j)  (256  + 64 * (j))
#define XB_XSUB(j)  (1280 + 64 * (j))
#define XB_XGEN(j)  (2304 + 64 * (j))
#define XB_TOP      3328
#define XB_TOPGEN   3392
#define XCD_BAR_WORDS 3456
#define XB_SPIN_CAP (1u << 20)
#define LAS __attribute__((address_space(3)))
__device__ __forceinline__ unsigned xb_ld(unsigned* p)              { return __hip_atomic_load(p, __ATOMIC_RELAXED, __HIP_MEMORY_SCOPE_AGENT); }
__device__ __forceinline__ unsigned xb_add(unsigned* p, unsigned v) { return __hip_atomic_fetch_add(p, v, __ATOMIC_RELAXED, __HIP_MEMORY_SCOPE_AGENT); }
__device__ __forceinline__ unsigned xb_xcc_id() { return (unsigned)__builtin_amdgcn_s_getreg((3 << 11) | 20) & 0xFu; }
#define XB_SPIN(cond, bar) do { unsigned _sp = 0; while (cond) { __builtin_amdgcn_s_sleep(1); \
    if ((++_sp & 255u) == 0u) { if (xb_ld(&(bar)[XB_TMO])) break; if (_sp > XB_SPIN_CAP) { atomicAdd(&(bar)[XB_TMO], 1u); break; } } } } while (0)
struct XcdBarrier { unsigned* bar; volatile LAS unsigned* st; };
__device__ __forceinline__ XcdBarrier xcd_barrier_post(unsigned* bar, volatile LAS unsigned* st) {
  XcdBarrier b; b.bar = bar; b.st = st;
  if (threadIdx.x == 0) (void)xb_add(&bar[XB_XCNT(xb_xcc_id())], 1u);
  return b;
}
__device__ __forceinline__ void xcd_barrier_complete(unsigned* bar, unsigned x, unsigned& nloc, unsigned& nx) {
  const unsigned G = (unsigned)gdim_();
  unsigned sum, cnt, mine, sp = 0u;
  for (;;) {
    sum = 0u; cnt = 0u; mine = 0u;
#pragma unroll
    for (unsigned j = 0; j < 16; ++j) { const unsigned c = xb_ld(&bar[XB_XCNT(j)]); sum += c; cnt += (c > 0u) ? 1u : 0u; mine = (j == x) ? c : mine; }
    if (sum == G) break;
    __builtin_amdgcn_s_sleep(1);
    if ((++sp & 255u) == 0u) { if (xb_ld(&bar[XB_TMO])) break; if (sp > XB_SPIN_CAP) { atomicAdd(&bar[XB_TMO], 1u); break; } }
  }
  nloc = mine > 0u ? mine : 1u; nx = cnt > 0u ? cnt : 1u;
}
__device__ __forceinline__ void xcd_barrier(const XcdBarrier& b) {
  asm volatile("s_waitcnt vmcnt(0)" ::: "memory");
  __syncthreads();
  if (threadIdx.x == 0) {
    unsigned* bar = b.bar; unsigned bx = xb_xcc_id(); asm volatile("" : "+s"(bx));
    __builtin_amdgcn_s_waitcnt(0);
    unsigned nloc = b.st[0], nx = b.st[1];
    if (nloc == 0u) { xcd_barrier_complete(bar, bx, nloc, nx); b.st[0] = nloc; b.st[1] = nx; }
    const unsigned old = xb_add(&bar[XB_XSUB(bx)], 1u);
    const unsigned gen = old / nloc;
    if (old + 1u == (gen + 1u) * nloc) {
      __builtin_amdgcn_fence(__ATOMIC_RELEASE, "agent");
      asm volatile("s_waitcnt vmcnt(0)" ::: "memory");
      const unsigned og = xb_add(&bar[XB_TOP], 1u);
      const unsigned tg = og / nx;
      if (og + 1u == (tg + 1u) * nx) xb_add(&bar[XB_TOPGEN], 1u);
      else XB_SPIN(xb_ld(&bar[XB_TOPGEN]) == tg, bar);
      __builtin_amdgcn_fence(__ATOMIC_ACQUIRE, "agent");
      xb_add(&bar[XB_XGEN(bx)], 1u);
      asm volatile("s_waitcnt vmcnt(0)" ::: "memory");
    } else {
      XB_SPIN(xb_ld(&bar[XB_XGEN(bx)]) == gen, bar);
      __builtin_amdgcn_fence(__ATOMIC_ACQUIRE, "agent");
      asm volatile("s_waitcnt vmcnt(0)" ::: "memory");
    }
  }
  __syncthreads();
}

constexpr int BM = 256, BK = 64, HALF = 128, HT = HALF * BK, NXCD = 8, WGM = 8;
__device__ __forceinline__ int lds_byte(int r, int c) {
  int st = (r >> 4) * 2 + (c >> 5), rr = r & 15, cc = c & 31, ob = rr * 64 + cc * 2;
  return st * 1024 + (ob ^ (((ob >> 9) & 1) << 5));
}
__device__ __forceinline__ void stage_rc(int b, int& R, int& C) {
  int st = b / 1024, sb = b % 1024, swz = sb ^ (((sb >> 9) & 1) << 5);
  R = (st >> 1) * 16 + swz / 64; C = (st & 1) * 32 + (swz % 64) / 2;
}

struct GemmDesc {
  const bf16_t* A; const bf16_t* Bt; int lda, ldb, Mrows, N, K;
  int mode;
  void* out; int ldc;
  const float* src0; const float* src1; const float* gate; int row_off; int dry;
};

__device__ __forceinline__ void gemm_epi(const GemmDesc& g, int row, int col, f32x4 v) {
#if PROBE_PH >= 0
  if (g.dry) return;
#endif
  if (g.mode == 0) {
    u32x2 w; w.x = cvtpk(v[0], v[1]); w.y = cvtpk(v[2], v[3]);
    *(u32x2*)((bf16_t*)g.out + (size_t)row * g.ldc + col) = w;
  } else if (g.mode == 1) {
    float a = fmaxf(v[0], 0.f), b = fmaxf(v[1], 0.f), c = fmaxf(v[2], 0.f), d = fmaxf(v[3], 0.f);
    u32x2 w; w.x = cvtpk(a * a, b * b); w.y = cvtpk(c * c, d * d);
    *(u32x2*)((bf16_t*)g.out + (size_t)row * g.ldc + col) = w;
  } else if (g.mode == 2) {
    int rg = row + g.row_off;
    const float* sp = rg < MP ? g.src0 + (size_t)rg * DM + col : g.src1 + (size_t)(rg - MP) * DM + col;
    f32x4 x = *(const f32x4*)sp;
    f32x4 gt = *(const f32x4*)(g.gate + cond_of_row(rg) * 6144 + col);
    *(f32x4*)((float*)g.out + (size_t)rg * DM + col) = x + gt * v;
  } else {
    *(f32x4*)((float*)g.out + (size_t)row * g.ldc + col) = v;
  }
}

template <int MF>
__device__ __forceinline__ void gemm_tile(const GemmDesc& g, int brow, int bcol) {
  constexpr int AH = MF * 32;
  bf16_t* shm = (bf16_t*)dyn_shm;
  const bf16_t* A = g.A; const bf16_t* Bt = g.Bt; const int lda = g.lda, ldb = g.ldb, K = g.K;
#define SA(b,h) (shm+((b)*2+(h))*HT)
#define SB(b,h) (shm+(4+(b)*2+(h))*HT)
#define STAGE(P,BASE,LD,VO,br,kt) do{const unsigned char* _ub=(const unsigned char*)(BASE)+((size_t)(br)*(LD)+(size_t)(kt)*BK)*2; \
    unsigned _vo=VO; asm volatile("":"+v"(_vo)); \
    __builtin_amdgcn_global_load_lds((const unsigned*)(_ub+_vo), (__attribute__((address_space(3))) unsigned*)((unsigned char*)(P)+tid*16),16,0,0); \
    __builtin_amdgcn_global_load_lds((const unsigned*)(_ub+(size_t)(LD)*128+_vo), (__attribute__((address_space(3))) unsigned*)((unsigned char*)(P)+tid*16+8192),16,0,0);}while(0)
#define LDA(dst,b,h) for(int m=0;m<MF;++m)for(int k=0;k<2;++k) \
    dst[m][k]=*reinterpret_cast<const bf16x8*>((char*)SA(b,h)+lds_byte(wr*(MF*16)+m*16+fr,k*32+fq*8))
#define LDB(dst,b,h) for(int n=0;n<2;++n)for(int k=0;k<2;++k) \
    dst[n][k]=*reinterpret_cast<const bf16x8*>((char*)SB(b,h)+lds_byte(wc*32+n*16+fr,k*32+fq*8))
#define MMA(ai,bj,At,Bt_) do{__builtin_amdgcn_s_setprio(1); \
    for(int m=0;m<MF;++m)for(int n=0;n<2;++n)for(int k=0;k<2;++k) \
      acc[ai][bj][m][n]=__builtin_amdgcn_mfma_f32_16x16x32_bf16(Bt_[n][k],At[m][k],acc[ai][bj][m][n],0,0,0); \
    __builtin_amdgcn_s_setprio(0);}while(0)
#define WAIT_V(n) asm volatile("s_waitcnt vmcnt(" #n ")":::"memory")
#define WAIT_L(n) asm volatile("s_waitcnt lgkmcnt(" #n ")":::"memory")
#define BAR __builtin_amdgcn_s_barrier()
#define SCHED __builtin_amdgcn_sched_barrier(0)
  const int tid = tid_();
  const int wid = __builtin_amdgcn_readfirstlane(tid >> 6), lane = tid & 63, wr = wid >> 2, wc = wid & 3, fr = lane & 15, fq = lane >> 4;
  unsigned voA, voB;
  { int r_, c_; stage_rc(tid * 16, r_, c_); voA = (unsigned)(r_ * lda + c_) * 2u; voB = (unsigned)(r_ * ldb + c_) * 2u; }
  f32x4 acc[2][2][MF][2] = {};
  bf16x8 At[MF][2], B0[2][2], B1[2][2];
  const int nt = K / BK;
  __syncthreads();
  STAGE(SB(0,0),Bt,ldb,voB,bcol,0); STAGE(SA(0,0),A,lda,voA,brow,0);
  STAGE(SB(0,1),Bt,ldb,voB,bcol+HALF,0); STAGE(SA(0,1),A,lda,voA,brow+AH,0);
  if(wr==1)BAR;
  WAIT_V(4); BAR;
  STAGE(SB(1,0),Bt,ldb,voB,bcol,1); STAGE(SA(1,0),A,lda,voA,brow,1); STAGE(SB(1,1),Bt,ldb,voB,bcol+HALF,1);
  WAIT_V(6); BAR;
  for(int t=0;t<nt-2;t+=2){
    LDB(B0,0,0); SCHED; LDA(At,0,0); STAGE(SA(1,1),A,lda,voA,brow+AH,t+1);
    if (MF == 4) WAIT_L(8); else WAIT_L(6); BAR; WAIT_L(0); MMA(0,0,At,B0); BAR; SCHED;
    LDB(B1,0,1); STAGE(SB(0,0),Bt,ldb,voB,bcol,t+2);
    BAR; WAIT_L(0); MMA(0,1,At,B1); BAR;
    LDA(At,0,1); STAGE(SA(0,0),A,lda,voA,brow,t+2);
    BAR; WAIT_L(0); MMA(1,0,At,B0); BAR; SCHED;
    STAGE(SB(0,1),Bt,ldb,voB,bcol+HALF,t+2);
    WAIT_V(6); BAR; MMA(1,1,At,B1); BAR;
    LDB(B0,1,0); SCHED; LDA(At,1,0); STAGE(SA(0,1),A,lda,voA,brow+AH,t+2);
    if (MF == 4) WAIT_L(8); else WAIT_L(6); BAR; WAIT_L(0); MMA(0,0,At,B0); BAR; SCHED;
    LDB(B1,1,1); STAGE(SB(1,0),Bt,ldb,voB,bcol,t+3);
    BAR; WAIT_L(0); MMA(0,1,At,B1); BAR;
    LDA(At,1,1); STAGE(SA(1,0),A,lda,voA,brow,t+3);
    BAR; WAIT_L(0); MMA(1,0,At,B0); BAR; SCHED;
    STAGE(SB(1,1),Bt,ldb,voB,bcol+HALF,t+3);
    WAIT_V(6); BAR; MMA(1,1,At,B1); BAR;
  }
  { LDB(B0,0,0); LDA(At,0,0); STAGE(SA(1,1),A,lda,voA,brow+AH,nt-1);
    BAR; WAIT_L(0); MMA(0,0,At,B0); BAR;
    LDB(B1,0,1); BAR; WAIT_L(0); MMA(0,1,At,B1); BAR;
    LDA(At,0,1); WAIT_V(4); BAR; WAIT_L(0); MMA(1,0,At,B0); MMA(1,1,At,B1); BAR; }
  { LDB(B0,1,0); LDA(At,1,0); WAIT_V(2); BAR; WAIT_L(0); MMA(0,0,At,B0); BAR;
    LDB(B1,1,1); WAIT_V(0); BAR; WAIT_L(0); MMA(0,1,At,B1); BAR;
    LDA(At,1,1); BAR; WAIT_L(0); MMA(1,0,At,B0); MMA(1,1,At,B1); BAR; }
  if(wr==0)BAR;
  const int tid2 = tid_(); const int wid2 = tid2 >> 6, lane2 = tid2 & 63;
  if (g.mode <= 1) {
    unsigned char* st = dyn_shm;
    const int lrow = (wid2 >> 2) * (MF * 16) + (lane2 & 15), lcol = (wid2 & 3) * 32 + (lane2 >> 4) * 4;
    const bool sq = g.mode == 1;
#pragma unroll
    for(int ai=0;ai<2;++ai)
#pragma unroll
      for(int m=0;m<MF;++m)
#pragma unroll
        for(int bj=0;bj<2;++bj)
#pragma unroll
          for(int n=0;n<2;++n) {
            f32x4 v = acc[ai][bj][m][n];
            if (sq) { v[0] = fmaxf(v[0], 0.f); v[1] = fmaxf(v[1], 0.f); v[2] = fmaxf(v[2], 0.f); v[3] = fmaxf(v[3], 0.f); v = v * v; }
            u32x2 w; w.x = cvtpk(v[0], v[1]); w.y = cvtpk(v[2], v[3]);
            *(u32x2*)(st + (lrow + ai * AH + m * 16) * 544 + (lcol + bj * HALF + n * 16) * 2) = w;
          }
    __syncthreads();
#if PROBE_PH >= 0
    if (!g.dry)
#endif
    {
      bf16_t* ob = (bf16_t*)g.out + (size_t)brow * g.ldc + bcol;
      const int r0 = wid2 * (MF * 8) + (lane2 >> 5), c16 = (lane2 & 31);
#pragma unroll 4
      for (int i = 0; i < MF * 4; ++i) {
        const int r = r0 + 2 * i;
        u32x4 w = *(const u32x4*)(st + r * 544 + c16 * 16);
        *(u32x4*)(ob + (size_t)r * g.ldc + c16 * 8) = w;
      }
    }
  } else {
  const int erow = brow + (wid2 >> 2) * (MF * 16) + (lane2 & 15), ecol = bcol + (wid2 & 3) * 32 + (lane2 >> 4) * 4;
#pragma unroll
  for(int ai=0;ai<2;++ai)
#pragma unroll
    for(int m=0;m<MF;++m)
#pragma unroll
      for(int bj=0;bj<2;++bj)
#pragma unroll
        for(int n=0;n<2;++n)
          gemm_epi(g, erow+ai*AH+m*16, ecol+bj*HALF+n*16, acc[ai][bj][m][n]);
  }
#undef SA
#undef SB
#undef STAGE
#undef LDA
#undef LDB
#undef MMA
}

__device__ __forceinline__ void tile_of(int L, int nM, int nN, int nwg, int th, int& brow, int& bcol) {
  int wgid = L;
  { const int q = nwg / NXCD, r = nwg % NXCD, xcd = wgid % NXCD, off = wgid / NXCD; wgid = (xcd < r ? xcd * (q + 1) : r * (q + 1) + (xcd - r) * q) + off; }
  const int nig = WGM * nN, gid = wgid / nig, fm = gid * WGM, gsz = (nM - fm) < WGM ? (nM - fm) : WGM;
  brow = (fm + ((wgid % nig) % gsz)) * th; bcol = ((wgid % nig) / gsz) * BM;
}
__device__ __forceinline__ void gemm_phase(const GemmDesc& g) {
  const int G = gdim_();
  const bool m3 = (g.Mrows % 192) == 0 && g.N <= 1536;
  const int th = m3 ? 192 : 256;
  const int nM = g.Mrows / th, nN = g.N / BM, nwg = nM * nN;
  for (int L = bid_(); L < nwg; L += G) {
    int brow, bcol; tile_of(L, nM, nN, nwg, th, brow, bcol);
    if (m3) gemm_tile<3>(g, brow, bcol); else gemm_tile<4>(g, brow, bcol);
  }
}

constexpr float ATT_SCALE = 0.10206207261596577f;
constexpr float ATT_THR = 8.f;
constexpr int SHM_V = 64 * 64 * 2, SHM_K = 64 * 128 * 2;
#define KSWZ(row, colB) ((row) * 256 + ((colB) ^ (((row) & 7) << 4)))
#define SBAR() __builtin_amdgcn_sched_barrier(0)
__device__ __forceinline__ int crow(int r, int hi) { return (r & 3) + 8 * (r >> 2) + 4 * hi; }

__device__ __forceinline__ void partialSM(f32x16& p0, f32x16& p1, float& m_reg, float& alpha, bool first) {
  constexpr float THRL = ATT_THR * 1.4426950408889634f;
  float pmax = p0[0];
#pragma unroll
  for (int r = 1; r < 16; ++r) pmax = fmaxf(pmax, p0[r]);
#pragma unroll
  for (int r = 0; r < 16; ++r) pmax = fmaxf(pmax, p1[r]);
  { auto rr = __builtin_amdgcn_permlane32_swap(__float_as_uint(pmax), __float_as_uint(pmax), false, false);
    pmax = fmaxf(__uint_as_float(rr[0]), __uint_as_float(rr[1])); }
  if (first) {
    alpha = 0.f; m_reg = pmax;
#pragma unroll
    for (int r = 0; r < 16; ++r) p0[r] -= pmax;
#pragma unroll
    for (int r = 0; r < 16; ++r) p1[r] -= pmax;
  } else if (__builtin_expect(__all(pmax <= THRL), 1)) { alpha = 1.f; }
  else { const float d = fmaxf(pmax, 0.f); alpha = __builtin_amdgcn_exp2f(-d); m_reg += d;
#pragma unroll
    for (int r = 0; r < 16; ++r) p0[r] -= d;
#pragma unroll
    for (int r = 0; r < 16; ++r) p1[r] -= d;
  }
#pragma unroll
  for (int r = 0; r < 16; ++r) p0[r] = __builtin_amdgcn_exp2f(p0[r]);
}
__device__ __forceinline__ void finishSM(f32x16& p0, f32x16& p1, float alpha, float& l_reg, bf16x8& pa0, bf16x8& pa1, bf16x8& pa2, bf16x8& pa3) {
#pragma unroll
  for (int r = 0; r < 16; ++r) p1[r] = __builtin_amdgcn_exp2f(p1[r]);
  float ps = 0;
#pragma unroll
  for (int r = 0; r < 16; ++r) ps += p0[r];
#pragma unroll
  for (int r = 0; r < 16; ++r) ps += p1[r];
  { auto rr = __builtin_amdgcn_permlane32_swap(__float_as_uint(ps), __float_as_uint(ps), false, false);
    ps = __uint_as_float(rr[0]) + __uint_as_float(rr[1]); }
  l_reg = l_reg * alpha + ps;
#define PK4(P, BASE, OUT) do { unsigned a0 = cvtpk(P[BASE + 0], P[BASE + 1]), a1 = cvtpk(P[BASE + 2], P[BASE + 3]);   \
    unsigned b0 = cvtpk(P[BASE + 4], P[BASE + 5]), b1 = cvtpk(P[BASE + 6], P[BASE + 7]);                              \
    auto r0 = __builtin_amdgcn_permlane32_swap(a0, b0, false, false); auto r1 = __builtin_amdgcn_permlane32_swap(a1, b1, false, false); \
    u32x4 w = {r0[0], r1[0], r0[1], r1[1]}; OUT = *reinterpret_cast<bf16x8*>(&w); } while (0)
  PK4(p0, 0, pa0); PK4(p0, 8, pa1); PK4(p1, 0, pa2); PK4(p1, 8, pa3);
#undef PK4
}
__device__ __forceinline__ void qkt(f32x16& p0, f32x16& p1, const unsigned char* Ks, const bf16x8* qr, int r32, int hi, float init) {
#pragma unroll
  for (int r = 0; r < 16; ++r) { p0[r] = init; p1[r] = init; }
#pragma unroll
  for (int d0 = 0; d0 < 6; ++d0) { int cb = (d0 * 16 + hi * 8) * 2;
    bf16x8 b0 = *reinterpret_cast<const bf16x8*>(Ks + KSWZ(r32, cb));
    bf16x8 b1 = *reinterpret_cast<const bf16x8*>(Ks + KSWZ(32 + r32, cb));
    p0 = __builtin_amdgcn_mfma_f32_32x32x16_bf16(b0, qr[d0], p0, 0, 0, 0);
    p1 = __builtin_amdgcn_mfma_f32_32x32x16_bf16(b1, qr[d0], p1, 0, 0, 0); }
}
__device__ __forceinline__ int v_st(int k, int c) { const int kk = (k & ~0xC) | ((k & 4) << 1) | ((k & 8) >> 1); return ((kk >> 3) * 2 + (c >> 5)) * 512 + ((kk & 7) * 32 + (c & 31)) * 2; }
__device__ __forceinline__ int v_rd_base(int lane) { return ((lane & 3) << 3) | (((lane >> 2) & 3) << 6) | (((lane >> 4) & 1) << 5) | (((lane >> 5) & 1) << 8); }
constexpr int v_rd_off(int d0, int ks, int half) { return d0 * 512 + ks * 2048 + half * 1024; }
template <int OFF> __device__ __forceinline__ s16x4 tr_read(int vb) {
  s16x4 r; asm volatile("ds_read_b64_tr_b16 %0, %1 offset:%2" : "=&v"(r) : "v"(vb), "i"(OFF) : "memory"); return r;
}
__device__ __forceinline__ void pv_d0(f32x16* o, int vb, bf16x8 pa0, bf16x8 pa1, bf16x8 pa2, bf16x8 pa3) {
  const s16x4 l0 = tr_read<v_rd_off(0, 0, 0)>(vb), h0 = tr_read<v_rd_off(0, 0, 1)>(vb), l1 = tr_read<v_rd_off(0, 1, 0)>(vb), h1 = tr_read<v_rd_off(0, 1, 1)>(vb);
  const s16x4 l2 = tr_read<v_rd_off(0, 2, 0)>(vb), h2 = tr_read<v_rd_off(0, 2, 1)>(vb), l3 = tr_read<v_rd_off(0, 3, 0)>(vb), h3 = tr_read<v_rd_off(0, 3, 1)>(vb);
  const s16x4 m0 = tr_read<v_rd_off(1, 0, 0)>(vb), n0 = tr_read<v_rd_off(1, 0, 1)>(vb), m1 = tr_read<v_rd_off(1, 1, 0)>(vb), n1 = tr_read<v_rd_off(1, 1, 1)>(vb);
  const s16x4 m2 = tr_read<v_rd_off(1, 2, 0)>(vb), n2 = tr_read<v_rd_off(1, 2, 1)>(vb), m3 = tr_read<v_rd_off(1, 3, 0)>(vb), n3 = tr_read<v_rd_off(1, 3, 1)>(vb);
  asm volatile("s_waitcnt lgkmcnt(0)" ::: "memory"); SBAR();
#define PK(L, H) (bf16x8){L[0], L[1], L[2], L[3], H[0], H[1], H[2], H[3]}
  o[0] = __builtin_amdgcn_mfma_f32_32x32x16_bf16(pa0, PK(l0, h0), o[0], 0, 0, 0);
  o[1] = __builtin_amdgcn_mfma_f32_32x32x16_bf16(pa0, PK(m0, n0), o[1], 0, 0, 0);
  o[0] = __builtin_amdgcn_mfma_f32_32x32x16_bf16(pa1, PK(l1, h1), o[0], 0, 0, 0);
  o[1] = __builtin_amdgcn_mfma_f32_32x32x16_bf16(pa1, PK(m1, n1), o[1], 0, 0, 0);
  o[0] = __builtin_amdgcn_mfma_f32_32x32x16_bf16(pa2, PK(l2, h2), o[0], 0, 0, 0);
  o[1] = __builtin_amdgcn_mfma_f32_32x32x16_bf16(pa2, PK(m2, n2), o[1], 0, 0, 0);
  o[0] = __builtin_amdgcn_mfma_f32_32x32x16_bf16(pa3, PK(l3, h3), o[0], 0, 0, 0);
  o[1] = __builtin_amdgcn_mfma_f32_32x32x16_bf16(pa3, PK(m3, n3), o[1], 0, 0, 0);
#undef PK
}

__device__ __forceinline__ void attn_unit(bf16_t* Qrows, int h, const bf16_t* KVb, const bf16_t* KPb, int nkeys, bool rope, int s0, const float* ropetab, int dry) {
  unsigned char* lds = dyn_shm;
  const int tid = tid_(), wid = tid >> 6, lane = tid & 63, r32 = lane & 31, hi = lane >> 5;
  unsigned char* V_lds = lds; unsigned char* K_lds = lds + 3 * SHM_V;
  float* ws = (float*)(lds + 3 * SHM_V + 3 * SHM_K) + wid * 64; float* li_l = ws; float* al_l = ws + 32;
  float m_reg = -1e30f, l_reg = 0; f32x16 o[2] = {}; bf16x8 qr[6];
  __syncthreads();
  {
    const int row = wid * 32 + r32;
    const bf16_t* Qn = Qrows + (size_t)row * 1536 + h * 64 + hi * 8;
#pragma unroll
    for (int d0 = 0; d0 < 4; ++d0) qr[d0] = *reinterpret_cast<const bf16x8*>(Qn + d0 * 16);
    const bf16_t* Qp = Qrows + (size_t)row * 1536 + 1024 + h * 32;
    const int s = s0 + row;
#pragma unroll
    for (int blk = 0; blk < 2; ++blk) {
      bf16x8 x1 = *reinterpret_cast<const bf16x8*>(Qp + blk * 16), x2 = *reinterpret_cast<const bf16x8*>(Qp + blk * 16 + 8);
      if (rope) {
        const int pos = blk == 0 ? (s >> 6) : (s & 63);
        const float* tb = ropetab + pos * 16;
        float ov[8];
#pragma unroll
        for (int j = 0; j < 8; ++j) {
          float a = bf2f((bf16_t)x1[j]), b = bf2f((bf16_t)x2[j]), cs = tb[2 * j], sn = tb[2 * j + 1];
          ov[j] = hi == 0 ? a * cs - b * sn : b * cs + a * sn;
        }
        u32x4 w = {cvtpk(ov[0], ov[1]), cvtpk(ov[2], ov[3]), cvtpk(ov[4], ov[5]), cvtpk(ov[6], ov[7])};
        qr[4 + blk] = *reinterpret_cast<bf16x8*>(&w);
      } else {
        qr[4 + blk] = hi == 0 ? x1 : x2;
      }
    }
  }
  const int vrow = tid >> 3, vc = (tid & 7) * 8, vst = v_st(vrow, vc);
  const bf16_t* vsrc = KVb + (size_t)vrow * 2048 + h * 128 + 64 + vc;
  const bool kact = tid < 384;
  const int kr = kact ? tid / 12 : 0, kc = kact ? (tid % 12) * 8 : 0;
  const bf16_t* ksrc = kc < 64 ? KVb + (size_t)kr * 2048 + h * 128 + kc : KPb + (size_t)kr * 32 + (kc - 64);
  const long kstride = kc < 64 ? 2048 : 32;
  const int kst0 = KSWZ(kr, kc * 2), kst1 = KSWZ(32 + kr, kc * 2);
  const int vb0 = (int)(uintptr_t)V_lds + v_rd_base(lane);
  struct { bf16x8 vs, ks0, ks1; } sr_[2];
#define SLOAD(i, k0) do { sr_[i].vs = *reinterpret_cast<const bf16x8*>(vsrc + (size_t)(k0) * 2048); \
    if (kact) { sr_[i].ks0 = *reinterpret_cast<const bf16x8*>(ksrc + (long)(k0) * kstride); sr_[i].ks1 = *reinterpret_cast<const bf16x8*>(ksrc + (long)((k0) + 32) * kstride); } } while (0)
#define SWRITE(b, i) do { *(bf16x8*)(V_lds + (b) * SHM_V + vst) = sr_[i].vs; \
    if (kact) { *(bf16x8*)(K_lds + (b) * SHM_K + kst0) = sr_[i].ks0; *(bf16x8*)(K_lds + (b) * SHM_K + kst1) = sr_[i].ks1; } } while (0)
#define RESC(a) do { if (__any((a) < 1.f)) { if (hi == 0) al_l[r32] = (a); asm volatile("s_waitcnt lgkmcnt(0)" ::: "memory"); \
    for (int d = 0; d < 2; ++d) for (int r = 0; r < 16; ++r) o[d][r] *= al_l[crow(r, hi)]; } } while (0)
  f32x16 pA0, pA1, pB0, pB1; float alA, alB; bf16x8 pa0, pa1, pa2, pa3; const int NT = nkeys / 64;
  constexpr int SE = 0, SO = 1;
  SLOAD(SE, 0); SWRITE(0, SE); SLOAD(SO, 64); __syncthreads();
  qkt(pA0, pA1, K_lds, qr, r32, hi, 0.f); partialSM(pA0, pA1, m_reg, alA, true);
  SWRITE(1, SO); if (2 < NT) SLOAD(SE, 128);
  int bc = 1;
  for (int j = 1; j + 1 < NT; j += 2) {
    const int bp = bc == 0 ? 2 : bc - 1, bn = bc == 2 ? 0 : bc + 1;
    __syncthreads();
    SBAR(); qkt(pB0, pB1, K_lds + bc * SHM_K, qr, r32, hi, -m_reg);
    finishSM(pA0, pA1, alA, l_reg, pa0, pa1, pa2, pa3); SBAR();
    SLOAD(SO, (j + 2) * 64); SBAR();
    pv_d0(o, vb0 + bp * SHM_V, pa0, pa1, pa2, pa3); partialSM(pB0, pB1, m_reg, alB, false);
    SWRITE(bn, SE);
    RESC(alB);
    __syncthreads();
    SBAR(); qkt(pA0, pA1, K_lds + bn * SHM_K, qr, r32, hi, -m_reg);
    finishSM(pB0, pB1, alB, l_reg, pa0, pa1, pa2, pa3); SBAR();
    if (j + 3 < NT) SLOAD(SE, (j + 3) * 64); SBAR();
    pv_d0(o, vb0 + bc * SHM_V, pa0, pa1, pa2, pa3); partialSM(pA0, pA1, m_reg, alA, false);
    SWRITE(bp, SO);
    RESC(alA);
    bc = bp;
  }
  { const int bp = bc == 0 ? 2 : bc - 1;
    __syncthreads();
    SBAR(); qkt(pB0, pB1, K_lds + bc * SHM_K, qr, r32, hi, -m_reg);
    finishSM(pA0, pA1, alA, l_reg, pa0, pa1, pa2, pa3); SBAR();
    pv_d0(o, vb0 + bp * SHM_V, pa0, pa1, pa2, pa3); partialSM(pB0, pB1, m_reg, alB, false);
    RESC(alB);
    finishSM(pB0, pB1, alB, l_reg, pa0, pa1, pa2, pa3); SBAR();
    pv_d0(o, vb0 + bc * SHM_V, pa0, pa1, pa2, pa3); }
  if (hi == 0) li_l[r32] = l_reg; asm volatile("s_waitcnt lgkmcnt(0)" ::: "memory");
  float rli[16];
#pragma unroll
  for (int r = 0; r < 16; ++r) rli[r] = __builtin_amdgcn_rcpf(li_l[crow(r, hi)]);
  bf16_t* Ow = Qrows + (size_t)(wid * 32) * 1536 + h * 64;
  if (!dry)
#pragma unroll
  for (int r = 0; r < 16; ++r) { int orow = crow(r, hi);
#pragma unroll
    for (int d0 = 0; d0 < 2; ++d0) Ow[(size_t)orow * 1536 + d0 * 32 + r32] = f2bf(o[d0][r] * rli[r]); }
#undef SLOAD
#undef SWRITE
#undef RESC
}

__device__ __forceinline__ void attn_phase(KP p, int dry) {
  bf16_t* Q = (bf16_t*)(p->ws + WS_Q); const bf16_t* KV = (const bf16_t*)(p->ws + WS_KV); const bf16_t* KP = (const bf16_t*)(p->ws + WS_KPE);
  const float* ropetab = (const float*)(p->ws + WS_ROPE);
  const int xcd = bid_() & 7, slot = bid_() >> 3;
  const int G = gdim_();
  const int nit = G == 256 ? 6 : (1536 + G - 1) / G;
  for (int i = 0; i < nit; ++i) {
    int u;
    if (G == 256) u = i < 4 ? ((i * 16 + xcd * 2 + (slot >> 4)) << 4) + (slot & 15) : 1024 + (i - 4) * 256 + xcd * 32 + slot;
    else { u = bid_() + i * G; if (u >= 1536) break; }
    const bool samp = u < 1024;
    const int pair = samp ? u >> 4 : u - 1024, qb = samp ? u & 15 : 0, b = pair >> 4, h = pair & 15;
    const size_t qrow = samp ? (size_t)(MP + b * DSEQ + qb * 256) : (size_t)(b * SEQ);
    const size_t krow = samp ? (size_t)(MP + b * SKEYS) : (size_t)(b * SEQ);
    attn_unit(Q + qrow * 1536, h, KV + krow * 2048, KP + krow * 32, samp ? SKEYS : SEQ, samp, qb * 256, ropetab, dry);
  }
}

__device__ void mod_gemv_item(KP p, int it) {
  float* lds = (float*)dyn_shm;
  const int l = it / 96, n0 = (it % 96) * 64, tid = tid_();
  const float* wmod = p->in[l == 0 ? 7 : 24]; const float* bmod = p->in[l == 0 ? 8 : 25];
  __syncthreads();
  for (int e = tid; e < 5 * 1024; e += 512) { int c = e >> 10, k = e & 1023; float v = c == 0 ? p->in[6][k] : p->in[5][(c - 1) * 1024 + k]; lds[e] = v / (1.f + __expf(-v)); }
  __syncthreads();
  const int col = tid & 63, ks = tid >> 6;
  float a0 = 0, a1 = 0, a2 = 0, a3 = 0, a4 = 0;
  const float* wp = wmod + (size_t)(ks * 128) * 6144 + n0 + col;
#pragma unroll 8
  for (int k = 0; k < 128; ++k) { float w = wp[(size_t)k * 6144]; int kk = ks * 128 + k;
    a0 += lds[kk] * w; a1 += lds[1024 + kk] * w; a2 += lds[2048 + kk] * w; a3 += lds[3072 + kk] * w; a4 += lds[4096 + kk] * w; }
  float* red = lds + 5 * 1024;
  red[(ks * 5 + 0) * 64 + col] = a0; red[(ks * 5 + 1) * 64 + col] = a1; red[(ks * 5 + 2) * 64 + col] = a2; red[(ks * 5 + 3) * 64 + col] = a3; red[(ks * 5 + 4) * 64 + col] = a4;
  __syncthreads();
  if (tid < 320) { int c = tid >> 6, cc = tid & 63; float s = 0;
#pragma unroll
    for (int k8 = 0; k8 < 8; ++k8) s += red[(k8 * 5 + c) * 64 + cc];
    ((float*)(p->ws + WS_MOD))[(l * 5 + c) * 6144 + n0 + cc] = s + bmod[n0 + cc]; }
}

struct CvtMat { const float* src; int K, N, Npad; bf16_t* dst; int ldk, perm; };
__device__ __forceinline__ CvtMat get_mat(KP p, int layer, int i) {
  bf16_t* WB = (bf16_t*)(p->ws + WS_WB);
  if (layer == 0) {
    switch (i) {
      case 0: return CvtMat{p->in[11], 1024, 1536, 1536, WB + W0_IN, 1024, 0};
      case 1: return CvtMat{p->in[21], 1024, 1024, 1024, WB + W0_OUT, 1024, 0};
      case 2: return CvtMat{p->in[22], 1024, 4096, 4096, WB + W0_W1, 1024, 0};
      default: return CvtMat{p->in[23], 4096, 1024, 1024, WB + W0_W2, 4096, 0};
    }
  } else {
    switch (i) {
      case 0: return CvtMat{p->in[28], 1024, 672, 768, WB + W1_IN, 1024, 0};
      case 1: return CvtMat{p->in[30], 384, 1536, 1536, WB + W1_QB, 384, 1};
      case 2: return CvtMat{p->in[32], 256, 2048, 2048, WB + W1_KVB, 256, 0};
      case 3: return CvtMat{p->in[33], 1024, 1024, 1024, WB + W1_OUT, 1024, 0};
      case 4: return CvtMat{p->in[34], 1024, 4096, 4096, WB + W1_W1, 1024, 0};
      default: return CvtMat{p->in[35], 4096, 1024, 1024, WB + W1_W2, 4096, 0};
    }
  }
}
struct CvtTile { const float* src; int K, N; bf16_t* dst; int ldk, perm, k0, n0; float wsc; };
__device__ __forceinline__ CvtTile cvt_desc(KP p, int layer, int t, int total) {
  bf16_t* WB = (bf16_t*)(p->ws + WS_WB);
  const int nm = layer == 0 ? 4 : 6;
  if (t < total) {
    int tt = t, i = 0;
    for (; i < nm - 1; ++i) { CvtMat m = get_mat(p, layer, i); int c = (m.K / 64) * (m.Npad / 64); if (tt < c) break; tt -= c; }
    const CvtMat m = get_mat(p, layer, i);
    const int nn = m.Npad / 64;
    return CvtTile{m.src, m.K, m.N, m.dst, m.ldk, m.perm, (tt / nn) * 64, (tt % nn) * 64, m.perm ? ATT_SCALE * 1.4426950408889634f : 1.f};
  }
  const int e = t - total;
  if (e < 32) {
    const int dg = e >> 3, nb = e & 7, dir = dg >> 1, gate = dg & 1;
    return CvtTile{p->in[gate == 0 ? 14 : 16] + (size_t)(dir * 8 + nb) * 4096, 64, 64, WB + W0_G + (size_t)e * 4096, 64, 0, 0, 0, -1.4426950408889634f};
  }
  const int e2 = e - 32, gi = e2 >> 2, q = e2 & 3;
  return CvtTile{p->in[19] + (size_t)gi * 16384, 128, 128, WB + W0_P + (size_t)gi * 16384, 128, 0, (q >> 1) * 64, (q & 1) * 64, 1.f};
}
__device__ __forceinline__ void cvt_load(const CvtTile& d, int tid, f32x4& v0, f32x4& v1) {
  const int kk = tid >> 4, n4 = (tid & 15) * 4;
  const f32x4 zero = {0.f, 0.f, 0.f, 0.f};
  const bool ok = d.n0 + n4 < d.N;
  const float* sp = d.src + (size_t)(d.k0 + kk) * d.N + d.n0 + (ok ? n4 : 0);
  v0 = ok ? *(const f32x4*)sp : zero;
  v1 = ok ? *(const f32x4*)(sp + (size_t)32 * d.N) : zero;
}
__device__ void cvt_weights(KP p, int layer, int start, int stride) {
  float* tile = (float*)dyn_shm;
  const int total = layer == 0 ? 384 + 256 + 1024 + 1024 : 192 + 144 + 128 + 256 + 1024 + 1024;
  const int all = total + (layer == 0 ? 32 + 16 : 0);
  const int tid = tid_();
  int t = start;
  if (t >= all) return;
  CvtTile d = cvt_desc(p, layer, t, total);
  f32x4 v0, v1; cvt_load(d, tid, v0, v1);
  for (;;) {
    const int kk = tid >> 4, n4 = (tid & 15) * 4;
    __syncthreads();
    tile[kk * 65 + n4 + 0] = v0[0]; tile[kk * 65 + n4 + 1] = v0[1]; tile[kk * 65 + n4 + 2] = v0[2]; tile[kk * 65 + n4 + 3] = v0[3];
    tile[(kk + 32) * 65 + n4 + 0] = v1[0]; tile[(kk + 32) * 65 + n4 + 1] = v1[1]; tile[(kk + 32) * 65 + n4 + 2] = v1[2]; tile[(kk + 32) * 65 + n4 + 3] = v1[3];
    __syncthreads();
    const int tn = t + stride; const bool more = tn < all;
    CvtTile dn = d;
    if (more) { dn = cvt_desc(p, layer, tn, total); cvt_load(dn, tid, v0, v1); }
    {
      int n = tid >> 3, k8 = (tid & 7) * 8, ng = d.n0 + n;
      if (d.perm) { int hh = ng / 96, dd = ng % 96; ng = dd < 64 ? hh * 64 + dd : 1024 + hh * 32 + (dd - 64); }
      float v[8];
#pragma unroll
      for (int j = 0; j < 8; ++j) v[j] = tile[(k8 + j) * 65 + n];
      const float wsc = d.wsc;
      u32x4 w = {cvtpk(v[0] * wsc, v[1] * wsc), cvtpk(v[2] * wsc, v[3] * wsc), cvtpk(v[4] * wsc, v[5] * wsc), cvtpk(v[6] * wsc, v[7] * wsc)};
      *(u32x4*)(d.dst + (size_t)ng * d.ldk + d.k0 + k8) = w;
    }
    if (!more) break;
    t = tn; d = dn;
  }
}

__device__ __forceinline__ void mod_row_store(bf16_t* H, int row, int lane, const f32x4 (&x)[4], const f32x4 (&gv)[4], float ss, const float* modl, int chunk_shift) {
  const float rstd = rsqrtf(ss * (1.f / DM) + EPS);
  const float* mc = modl + cond_of_row(row) * 6144 + chunk_shift * 1024;
#pragma unroll
  for (int i = 0; i < 4; ++i) {
    const int col = (i * 64 + lane) * 4;
    f32x4 sh = *(const f32x4*)(mc + col), sc = *(const f32x4*)(mc + 1024 + col);
    f32x4 y = x[i] * rstd * gv[i] * (sc + 1.f) + sh;
    u32x2 w; w.x = cvtpk(y[0], y[1]); w.y = cvtpk(y[2], y[3]);
    *(u32x2*)(H + (size_t)row * DM + col) = w;
  }
}
__device__ void modulate_phase(KP p, const float* src0, const float* src1, const float* g, const float* modl, int chunk_shift) {
  bf16_t* H = (bf16_t*)(p->ws + WS_H);
  const int tid = tid_(); const int wid = tid >> 6, lane = tid & 63;
  f32x4 gv[4];
#pragma unroll
  for (int i = 0; i < 4; ++i) gv[i] = *(const f32x4*)(g + (i * 64 + lane) * 4);
  const int stride = gdim_() * 8;
  for (int row = bid_() * 8 + wid; row < M; row += 2 * stride) {
    const int row2 = row + stride; const bool v2 = row2 < M; const int r2 = v2 ? row2 : row;
    const float* xp = row < MP ? src0 + (size_t)row * DM : src1 + (size_t)(row - MP) * DM;
    const float* xq = r2 < MP ? src0 + (size_t)r2 * DM : src1 + (size_t)(r2 - MP) * DM;
    f32x4 x[4], z[4]; float ss = 0, s2 = 0;
#pragma unroll
    for (int i = 0; i < 4; ++i) { x[i] = *(const f32x4*)(xp + (i * 64 + lane) * 4); z[i] = *(const f32x4*)(xq + (i * 64 + lane) * 4); }
#pragma unroll
    for (int i = 0; i < 4; ++i) { ss += x[i][0] * x[i][0] + x[i][1] * x[i][1] + x[i][2] * x[i][2] + x[i][3] * x[i][3]; s2 += z[i][0] * z[i][0] + z[i][1] * z[i][1] + z[i][2] * z[i][2] + z[i][3] * z[i][3]; }
    ss = wave_sum(ss, lane); s2 = wave_sum(s2, lane);
    mod_row_store(H, row, lane, x, gv, ss, modl, chunk_shift);
    if (v2) mod_row_store(H, row2, lane, z, gv, s2, modl, chunk_shift);
  }
}
__device__ void final_norm_phase(KP p, int dry) {
  float* X = p->out; const float* g = p->in[36];
  const int tid = tid_(); const int wid = tid >> 6, lane = tid & 63;
  f32x4 gv[4];
#pragma unroll
  for (int i = 0; i < 4; ++i) gv[i] = *(const f32x4*)(g + (i * 64 + lane) * 4);
  const int stride = gdim_() * 8;
  for (int row = bid_() * 8 + wid; row < M; row += 2 * stride) {
    const int row2 = row + stride; const bool v2 = row2 < M; const int r2 = v2 ? row2 : row;
    float* xp = X + (size_t)row * DM; float* xq = X + (size_t)r2 * DM;
    f32x4 x[4], z[4]; float ss = 0, s2 = 0;
#pragma unroll
    for (int i = 0; i < 4; ++i) { x[i] = *(const f32x4*)(xp + (i * 64 + lane) * 4); z[i] = *(const f32x4*)(xq + (i * 64 + lane) * 4); }
#pragma unroll
    for (int i = 0; i < 4; ++i) { ss += x[i][0] * x[i][0] + x[i][1] * x[i][1] + x[i][2] * x[i][2] + x[i][3] * x[i][3]; s2 += z[i][0] * z[i][0] + z[i][1] * z[i][1] + z[i][2] * z[i][2] + z[i][3] * z[i][3]; }
    ss = wave_sum(ss, lane); s2 = wave_sum(s2, lane);
    const float rstd = rsqrtf(ss * (1.f / DM) + EPS), rstd2 = rsqrtf(s2 * (1.f / DM) + EPS);
    if (!dry) {
#pragma unroll
      for (int i = 0; i < 4; ++i) *(f32x4*)(xp + (i * 64 + lane) * 4) = x[i] * rstd * gv[i];
      if (v2) {
#pragma unroll
        for (int i = 0; i < 4; ++i) *(f32x4*)(xq + (i * 64 + lane) * 4) = z[i] * rstd2 * gv[i];
      }
    }
  }
}
struct L1Row { f32x4 qa, qb, kv; float kp; };
__device__ __forceinline__ void l1_row_load(const float* Z1, int row, int lane, L1Row& r) {
  const float* z = Z1 + (size_t)row * 768;
  const f32x4 zero = {0.f, 0.f, 0.f, 0.f};
  r.qa = lane < 48 ? *(const f32x4*)(z + lane * 4) : zero;
  r.qb = lane < 48 ? *(const f32x4*)(z + 192 + lane * 4) : zero;
  r.kv = *(const f32x4*)(z + 384 + lane * 4);
  r.kp = lane < 32 ? z[640 + lane] : 0.f;
}
__device__ __forceinline__ void l1_row_finish(KP p, int row, int lane, const L1Row& r, const f32x4& gqa, const f32x4& gqb, const f32x4& gk) {
  bf16_t* CQN = (bf16_t*)(p->ws + WS_CQN); bf16_t* CKVN = (bf16_t*)(p->ws + WS_CKVN); bf16_t* KPE = (bf16_t*)(p->ws + WS_KPE);
  const float* ropetab = (const float*)(p->ws + WS_ROPE);
  float ss = r.qa[0] * r.qa[0] + r.qa[1] * r.qa[1] + r.qa[2] * r.qa[2] + r.qa[3] * r.qa[3] + r.qb[0] * r.qb[0] + r.qb[1] * r.qb[1] + r.qb[2] * r.qb[2] + r.qb[3] * r.qb[3];
  ss = wave_sum(ss, lane);
  const float rstd = rsqrtf(ss * (1.f / 384) + EPS);
  if (lane < 48) {
    const f32x4 ya = r.qa * rstd * gqa, yb = r.qb * rstd * gqb;
    u32x2 wa; wa.x = cvtpk(ya[0], ya[1]); wa.y = cvtpk(ya[2], ya[3]);
    u32x2 wb; wb.x = cvtpk(yb[0], yb[1]); wb.y = cvtpk(yb[2], yb[3]);
    *(u32x2*)(CQN + (size_t)row * 384 + lane * 4) = wa; *(u32x2*)(CQN + (size_t)row * 384 + 192 + lane * 4) = wb;
  }
  const float s2 = wave_sum(r.kv[0] * r.kv[0] + r.kv[1] * r.kv[1] + r.kv[2] * r.kv[2] + r.kv[3] * r.kv[3], lane);
  const float r2 = rsqrtf(s2 * (1.f / 256) + EPS);
  const f32x4 y = r.kv * r2 * gk;
  int krow; bool rope; int s = 0;
  if (row < MP) { krow = row; rope = false; *(f32x4*)(p->out + O_CKV + (size_t)row * 256 + lane * 4) = y; }
  else { int b = (row - MP) >> 12; s = (row - MP) & 4095; krow = MP + b * SKEYS + s; rope = true; }
  u32x2 w; w.x = cvtpk(y[0], y[1]); w.y = cvtpk(y[2], y[3]);
  *(u32x2*)(CKVN + (size_t)krow * 256 + lane * 4) = w;
  const float kp = r.kp;
  const float partner = lane_xor(kp, lane, 8);
  if (!rope) { if (lane < 32) { p->out[O_KPE + (size_t)row * 32 + lane] = kp; KPE[(size_t)krow * 32 + lane] = f2bf(kp); } }
  else if (lane < 32) {
    int pos = lane < 16 ? (s >> 6) : (s & 63); int j = lane & 7;
    float cs = ropetab[pos * 16 + 2 * j], sn = ropetab[pos * 16 + 2 * j + 1];
    float ov = (lane & 8) == 0 ? kp * cs - partner * sn : kp * cs + partner * sn;
    KPE[(size_t)krow * 32 + lane] = f2bf(ov);
  }
}
__device__ void l1_rows_phase(KP p) {
  const float* Z1 = (const float*)(p->ws + WS_Z1);
  bf16_t* CKVN = (bf16_t*)(p->ws + WS_CKVN); bf16_t* KPE = (bf16_t*)(p->ws + WS_KPE);
  const int tid = tid_(); const int wid = tid >> 6, lane = tid & 63;
  const int l48 = lane < 48 ? lane : 0;
  const f32x4 gqa = *(const f32x4*)(p->in[29] + l48 * 4), gqb = *(const f32x4*)(p->in[29] + 192 + l48 * 4), gk = *(const f32x4*)(p->in[31] + lane * 4);
  const int stride = gdim_() * 8;
  for (int row = bid_() * 8 + wid; row < M; row += 2 * stride) {
    const int row2 = row + stride; const bool v2 = row2 < M;
    L1Row ra, rb;
    l1_row_load(Z1, row, lane, ra); l1_row_load(Z1, v2 ? row2 : row, lane, rb);
    l1_row_finish(p, row, lane, ra, gqa, gqb, gk);
    if (v2) l1_row_finish(p, row2, lane, rb, gqa, gqb, gk);
  }
  for (int idx = bid_() * 8 + wid; idx < NB_S * PAST; idx += stride) {
    const int b = idx >> 9, j = idx & 511, krow = MP + b * SKEYS + DSEQ + j;
    f32x4 kv = *(const f32x4*)(p->in[3] + ((size_t)(b * PAST + j)) * 256 + lane * 4);
    u32x2 w; w.x = cvtpk(kv[0], kv[1]); w.y = cvtpk(kv[2], kv[3]);
    *(u32x2*)(CKVN + (size_t)krow * 256 + lane * 4) = w;
    if (lane < 32) KPE[(size_t)krow * 32 + lane] = f2bf(p->in[4][((size_t)(b * PAST + j)) * 32 + lane]);
  }
}

__device__ __forceinline__ float fast_sigmoid(float x) { return __builtin_amdgcn_rcpf(1.f + __expf(-x)); }
__device__ __forceinline__ float fast_gelu(float x) {
  float u = 0.7978845608028654f * (x + 0.044715f * x * x * x);
  float e = __expf(2.f * u);
  float th = 1.f - 2.f * __builtin_amdgcn_rcpf(e + 1.f);
  return 0.5f * x * (1.f + th);
}
__device__ __forceinline__ float bperm(int srclane, float v) { return __int_as_float(__builtin_amdgcn_ds_bpermute(srclane << 2, __float_as_int(v))); }
__device__ __forceinline__ void scan4(float& P, float& H, int lane, int stepl, int oq) {
  { const float Pp = bperm(lane - stepl, P), Hp = bperm(lane - stepl, H); if (oq >= 1) { H = P * Hp + H; P = Pp * P; } }
  { const float Pp = bperm(lane - 2 * stepl, P), Hp = bperm(lane - 2 * stepl, H); if (oq >= 2) { H = P * Hp + H; P = Pp * P; } }
}
__device__ void lru_item(KP p, int cidx, int nb, int mode) {
  const bf16_t* Z0 = (const bf16_t*)(p->ws + WS_Z0); bf16_t* H = (bf16_t*)(p->ws + WS_H);
  const bf16_t* Wg = (const bf16_t*)(p->ws + WS_WB) + W0_G;
  const float* LS8 = (const float*)(p->ws + WS_LS8);
  float2* SUM = (float2*)(p->ws + WS_SUM);
  float* xrL = (float*)dyn_shm;
  float* xc = xrL + 67 * 64;
  bf16_t* xcb = (bf16_t*)(xc + 64 * 64);
  float* Hs = (float*)(xcb + 64 * 72);
  const int tid = tid_(), lane = tid & 63, fr = lane & 15, fq = lane >> 4;
  const int wid = __builtin_amdgcn_readfirstlane(tid >> 6), dir = wid >> 2, wq = wid & 3;
  const int t0 = cidx * 64;
  int s0, s1, bsamp = -1;
  if (t0 < MP) { s0 = (t0 / SEQ) * SEQ; s1 = s0 + SEQ; } else { bsamp = (t0 - MP) / DSEQ; s0 = MP + bsamp * DSEQ; s1 = s0 + DSEQ; }
  const int c0 = s0 / 64, c1 = s1 / 64;
  const int chc = tid & 63, cgc = nb * 64 + chc;
  const int ch = wq * 16 + fr, cg_ = nb * 64 + ch;
  const int oq = dir ? 3 - fq : fq, stepl = dir ? -16 : 16, lastl = fr + (dir ? 0 : 48);
  unsigned xv[5];
#pragma unroll
  for (int i = 0; i < 5; ++i) { int e = tid + i * 512; int r = e >> 5, c2 = (e & 31) * 2, t = t0 - 2 + r;
    xv[i] = (e < 67 * 32 && t >= s0 && t < s1) ? *(const unsigned*)(Z0 + (size_t)t * 1536 + nb * 64 + c2) : 0u; }
  const float* cw = p->in[12];
  const float w0 = cw[cgc], w1 = cw[512 + cgc], w2 = cw[1024 + cgc], w3 = cw[1536 + cgc], bb = p->in[13][cgc];
  const float ba = -1.4426950408889634f * p->in[15][dir * 512 + cg_], bi = -1.4426950408889634f * p->in[17][dir * 512 + cg_], l8 = LS8[dir * 512 + cg_];
  bf16x8 wa[2], wi[2];
  { const bf16_t* pa = Wg + (size_t)((dir * 2 + 0) * 8 + nb) * 4096 + (size_t)ch * 64 + fq * 8; const bf16_t* pi = pa + 8 * 4096;
    wa[0] = *(const bf16x8*)pa; wa[1] = *(const bf16x8*)(pa + 32); wi[0] = *(const bf16x8*)pi; wi[1] = *(const bf16x8*)(pi + 32); }
  unsigned gz[4] = {0u, 0u, 0u, 0u};
  if (mode == 1) {
#pragma unroll
    for (int i = 0; i < 4; ++i) { int e = tid + i * 512; int t = e >> 5, c2 = (e & 31) * 2; gz[i] = *(const unsigned*)(Z0 + (size_t)(t0 + t) * 1536 + 512 + nb * 64 + c2); }
  }
  float cP = 1.f, cH = 0.f;
  if (mode == 1) {
    int lo, hi;
    if (dir == 0) { const int n = cidx - c0, q = (n + 3) >> 2; lo = c0 + fq * q; hi = lo + q < cidx ? lo + q : cidx;
      for (int c = lo; c < hi; c += 4) { float2 sm[4];
#pragma unroll
        for (int j = 0; j < 4; ++j) sm[j] = (c + j < hi) ? SUM[((size_t)(c + j) * 2) * 512 + cg_] : make_float2(1.f, 0.f);
#pragma unroll
        for (int j = 0; j < 4; ++j) { cH = sm[j].x * cH + sm[j].y; cP *= sm[j].x; } }
    } else { const int n = c1 - 1 - cidx, q = (n + 3) >> 2; hi = c1 - 1 - fq * q; lo = hi - q > cidx ? hi - q : cidx;
      for (int c = hi; c > lo; c -= 4) { float2 sm[4];
#pragma unroll
        for (int j = 0; j < 4; ++j) sm[j] = (c - j > lo) ? SUM[((size_t)(c - j) * 2 + 1) * 512 + cg_] : make_float2(1.f, 0.f);
#pragma unroll
        for (int j = 0; j < 4; ++j) { cH = sm[j].x * cH + sm[j].y; cP *= sm[j].x; } }
    }
  }
  __syncthreads();
#pragma unroll
  for (int i = 0; i < 5; ++i) { int e = tid + i * 512; if (e < 67 * 32) { int r = e >> 5, c2 = (e & 31) * 2;
    xrL[r * 64 + c2] = bf2f((bf16_t)(xv[i] & 0xffff)); xrL[r * 64 + c2 + 1] = bf2f((bf16_t)(xv[i] >> 16)); } }
  __syncthreads();
#pragma unroll
  for (int i = 0; i < 8; ++i) { int t = (tid >> 6) + 8 * i;
    float v = bb + w0 * xrL[t * 64 + chc] + w1 * xrL[(t + 1) * 64 + chc] + w2 * xrL[(t + 2) * 64 + chc] + w3 * xrL[(t + 3) * 64 + chc];
    xc[t * 64 + chc] = v; xcb[t * 72 + chc] = f2bf(v); }
  __syncthreads();
  float av[4][4], uv[4][4], Pt[4], Ht[4], Pe[4], He[4];
#pragma unroll
  for (int mt = 0; mt < 4; ++mt) {
    const bf16x8 a0 = *(const bf16x8*)(xcb + (mt * 16 + fr) * 72 + fq * 8), a1 = *(const bf16x8*)(xcb + (mt * 16 + fr) * 72 + 32 + fq * 8);
    f32x4 ga = {0.f, 0.f, 0.f, 0.f}, gi = {0.f, 0.f, 0.f, 0.f};
    ga = __builtin_amdgcn_mfma_f32_16x16x32_bf16(a0, wa[0], ga, 0, 0, 0); ga = __builtin_amdgcn_mfma_f32_16x16x32_bf16(a1, wa[1], ga, 0, 0, 0);
    gi = __builtin_amdgcn_mfma_f32_16x16x32_bf16(a0, wi[0], gi, 0, 0, 0); gi = __builtin_amdgcn_mfma_f32_16x16x32_bf16(a1, wi[1], gi, 0, 0, 0);
#pragma unroll
    for (int j = 0; j < 4; ++j) {
      const float ea = 1.f + __builtin_amdgcn_exp2f(fminf(ga[j] + ba, 57.f)), ei = 1.f + __builtin_amdgcn_exp2f(fminf(gi[j] + bi, 57.f));
      const float rc = __builtin_amdgcn_rcpf(ea * ei);
      const float r = rc * ei, ii = rc * ea;
      const float l2 = r * l8;
      const float a = __builtin_amdgcn_exp2f(l2);
      const float x2 = l2 * (2.f * 0.6931471805599453f);
      const float ser = -x2 * fmaf(x2, fmaf(x2, fmaf(x2, fmaf(x2, fmaf(x2, 1.f / 720.f, 1.f / 120.f), 1.f / 24.f), 1.f / 6.f), 0.5f), 1.f);
      const float om = x2 > -0.25f ? ser : 1.f - a * a;
      av[mt][j] = a; uv[mt][j] = __builtin_amdgcn_sqrtf(om) * ii * xc[(mt * 16 + fq * 4 + j) * 64 + ch];
    }
    float P = 1.f, Hh = 0.f;
    if (dir == 0) {
#pragma unroll
      for (int j = 0; j < 4; ++j) { Hh = av[mt][j] * Hh + uv[mt][j]; P *= av[mt][j]; }
    } else {
#pragma unroll
      for (int j = 3; j >= 0; --j) { Hh = av[mt][j] * Hh + uv[mt][j]; P *= av[mt][j]; }
    }
    scan4(P, Hh, lane, stepl, oq);
    const float Pp = bperm(lane - stepl, P), Hp = bperm(lane - stepl, Hh);
    Pe[mt] = oq >= 1 ? Pp : 1.f; He[mt] = oq >= 1 ? Hp : 0.f;
    Pt[mt] = bperm(lastl, P); Ht[mt] = bperm(lastl, Hh);
  }
  if (mode == 0) {
    float P = 1.f, Hh = 0.f;
    if (dir == 0) {
#pragma unroll
      for (int mt = 0; mt < 4; ++mt) { Hh = Pt[mt] * Hh + Ht[mt]; P *= Pt[mt]; }
    } else {
#pragma unroll
      for (int mt = 3; mt >= 0; --mt) { Hh = Pt[mt] * Hh + Ht[mt]; P *= Pt[mt]; }
    }
    if (fq == 0) SUM[((size_t)cidx * 2 + dir) * 512 + cg_] = make_float2(P, Hh);
    return;
  }
  scan4(cP, cH, lane, 16, fq);
  const float tP = bperm(fr + 48, cP), tH = bperm(fr + 48, cH);
  float c = bsamp >= 0 ? p->in[2][(bsamp * 2 + dir) * 512 + cg_] : 0.f;
  c = tP * c + tH;
  float* hp = Hs + dir * 4096 + ch;
  if (dir == 0) {
#pragma unroll
    for (int mt = 0; mt < 4; ++mt) { float s = Pe[mt] * c + He[mt];
#pragma unroll
      for (int j = 0; j < 4; ++j) { s = av[mt][j] * s + uv[mt][j]; hp[(mt * 16 + fq * 4 + j) * 64] = s; }
      c = Pt[mt] * c + Ht[mt]; }
    if (bsamp < 0 && cidx == c1 - 1 && fq == 0) p->out[O_LRU + (size_t)((t0 / SEQ) * 2 + 0) * 512 + cg_] = c;
  } else {
#pragma unroll
    for (int mt = 3; mt >= 0; --mt) { float s = Pe[mt] * c + He[mt];
#pragma unroll
      for (int j = 3; j >= 0; --j) { s = av[mt][j] * s + uv[mt][j]; hp[(mt * 16 + fq * 4 + j) * 64] = s; }
      c = Pt[mt] * c + Ht[mt]; }
    if (bsamp < 0 && cidx == c0 && fq == 0) p->out[O_LRU + (size_t)((t0 / SEQ) * 2 + 1) * 512 + cg_] = c;
  }
  __syncthreads();
#pragma unroll
  for (int i = 0; i < 4; ++i) { int e = tid + i * 512; int t = e >> 5, c2 = (e & 31) * 2;
    float g0 = bf2f((bf16_t)(gz[i] & 0xffff)), g1 = bf2f((bf16_t)(gz[i] >> 16));
    float y0 = (Hs[t * 64 + c2] + Hs[4096 + t * 64 + c2]) * fast_gelu(g0);
    float y1 = (Hs[t * 64 + c2 + 1] + Hs[4096 + t * 64 + c2 + 1]) * fast_gelu(g1);
    *(unsigned*)(H + (size_t)(t0 + t) * DM + nb * 64 + c2) = cvtpk(y0, y1); }
}

__device__ void pool_item(KP p, int cidx, int gi) {
  const bf16_t* Z0 = (const bf16_t*)(p->ws + WS_Z0); bf16_t* H = (bf16_t*)(p->ws + WS_H);
  const bf16_t* Wp = (const bf16_t*)(p->ws + WS_WB) + W0_P + (size_t)gi * 16384;
  float* xp = (float*)dyn_shm;
  bf16_t* dL = (bf16_t*)(xp + 80 * 128);
  const int tid = tid_(), wid = tid >> 6, lane = tid & 63, fr = lane & 15, fq = lane >> 4;
  const int t0 = cidx * 64;
  int s0, s1;
  if (t0 < MP) { s0 = (t0 / SEQ) * SEQ; s1 = s0 + SEQ; } else { int b = (t0 - MP) / DSEQ; s0 = MP + b * DSEQ; s1 = s0 + DSEQ; }
  __syncthreads();
  for (int e = tid; e < 80 * 64; e += 512) { int r = e >> 6, c2 = (e & 63) * 2, t = t0 - 8 + r;
    float a = 0.f, b = 0.f;
    if (t >= s0 && t < s1) { unsigned v = *(const unsigned*)(Z0 + (size_t)t * 1536 + 1024 + gi * 128 + c2); a = bf2f((bf16_t)(v & 0xffff)); b = bf2f((bf16_t)(v >> 16)); }
    xp[r * 128 + c2] = a; xp[r * 128 + c2 + 1] = b; }
  __syncthreads();
  const int w = 2 << gi, left = w >> 1, right = w - 1 - left;
  {
    const int c = tid & 127, tq = tid >> 7, tb = tq * 16;
    float S = 0.f;
    for (int k = tb - left; k <= tb + right; ++k) S += xp[(k + 8) * 128 + c];
#pragma unroll
    for (int i = 0; i < 16; ++i) { const int t = tb + i, tg = t0 + t;
      const int lo = tg - left < s0 ? s0 : tg - left, hi = tg + right > s1 - 1 ? s1 - 1 : tg + right;
      const float d = S * __builtin_amdgcn_rcpf((float)(hi - lo + 1)) - xp[(t + 8) * 128 + c];
      dL[t * 136 + c] = f2bf(d);
      S += xp[(t + 1 + right + 8) * 128 + c] - xp[(t - left + 8) * 128 + c]; }
  }
  __syncthreads();
  {
    bf16x8 wf[4];
#pragma unroll
    for (int ks = 0; ks < 4; ++ks) wf[ks] = *(const bf16x8*)(Wp + (size_t)(wid * 16 + fr) * 128 + ks * 32 + fq * 8);
    const f32x4 sc = *(const f32x4*)(p->in[20] + gi * 128 + wid * 16 + fq * 4);
#pragma unroll
    for (int mt = 0; mt < 4; ++mt) {
      f32x4 acc = {0.f, 0.f, 0.f, 0.f};
#pragma unroll
      for (int ks = 0; ks < 4; ++ks) {
        bf16x8 df = *(const bf16x8*)(dL + (mt * 16 + fr) * 136 + ks * 32 + fq * 8);
        acc = __builtin_amdgcn_mfma_f32_16x16x32_bf16(wf[ks], df, acc, 0, 0, 0);
      }
      acc = acc * sc;
      u32x2 o; o.x = cvtpk(acc[0], acc[1]); o.y = cvtpk(acc[2], acc[3]);
      *(u32x2*)(H + (size_t)(t0 + mt * 16 + fr) * DM + 512 + gi * 128 + wid * 16 + fq * 4) = o;
    }
  }
}

__global__ void __launch_bounds__(512, 2) fwd_megakernel(Params kparams) {
  cg::grid_group grid = cg::this_grid();
  KP p = (KP)__builtin_amdgcn_kernarg_segment_ptr();
  unsigned char* ws = p->ws;
  bf16_t* WB = (bf16_t*)(ws + WS_WB);
  bf16_t* H = (bf16_t*)(ws + WS_H);
  float* X = p->out;
  const float* MOD = (const float*)(ws + WS_MOD);
  volatile LAS unsigned* xst = (volatile LAS unsigned*)(dyn_shm + LDS_MAIN);
  if (threadIdx.x == 0) { xst[0] = 0u; xst[1] = 0u; }
  __syncthreads();
  (void)xcd_barrier_post((unsigned*)(ws + WS_BAR), xst);
  int rep = 0;
  const int p_lo = p->p_lo, p_hi = p->p_hi, probe = p->pad, coop = p->coop;
  for (int ph = p_lo; ph < p_hi; ++ph) {
    asm volatile("" : "+s"(p));
    const int G = gdim_(), bid = bid_();
    unsigned char* ws = p->ws; bf16_t* WB = (bf16_t*)(ws + WS_WB); bf16_t* H = (bf16_t*)(ws + WS_H); float* X = p->out; const float* MOD = (const float*)(ws + WS_MOD);
#if PROBE_PH >= 0
    const int dry = (ph == probe && rep == 0) ? 1 : 0;
#else
    const int dry = 0;
#endif
    if (PROBE_PH == 99 && probe == 99 && ph == 1) { XcdBarrier xb; xb.bar = (unsigned*)(ws + WS_BAR); xb.st = (volatile LAS unsigned*)(dyn_shm + LDS_MAIN); for (int q = 0; q < 10; ++q) xcd_barrier(xb); }
    GemmDesc g1{nullptr, nullptr, 0, 0, 0, 0, 0, 0, nullptr, 0, nullptr, nullptr, nullptr, 0, 0};
    bool isg = false;
    const float* MODL = MOD + (ph >= 11 ? 5 * 6144 : 0);
    const bf16_t* U = (const bf16_t*)(ws + WS_U);
    switch (ph) {
      case 0: {
        for (int it = bid; it < 192; it += G) mod_gemv_item(p, it);
        if (bid == G - 1) { int t = tid_(); int pos = t >> 3, j = t & 7;
          float inv = exp2f(-(float)j * 0.125f * 13.287712379549449f);
          float s, c; my_sincos((float)pos * inv, s, c);
          float* rt = (float*)(ws + WS_ROPE); rt[t * 2] = c; rt[t * 2 + 1] = s; }
        if (bid == G - 2) { int t = tid_(); float* l8 = (float*)(ws + WS_LS8);
          for (int e = t; e < 1024; e += 512) l8[e] = -8.f * 1.4426950408889634f * log1pf(__expf(-p->in[18][e])); }
      } break;
      case 2: g1 = GemmDesc{H, WB + W0_IN, 1024, 1024, M, 1536, 1024, 0, ws + WS_Z0, 1536, nullptr, nullptr, nullptr, 0, 0}; isg = true; break;
      case 5: g1 = GemmDesc{H, WB + W0_OUT, 1024, 1024, M, 1024, 1024, 2, X, 1024, p->in[0], p->in[1], MOD + 2 * 1024, 0, 0}; isg = true; break;
      case 7: case 9: case 19: case 21: { int ro = (ph == 7 || ph == 19) ? 0 : MH;
        g1 = GemmDesc{H + (size_t)ro * DM, WB + (ph < 11 ? W0_W1 : W1_W1), 1024, 1024, MH, 4096, 1024, 1, ws + WS_U, 4096, nullptr, nullptr, nullptr, 0, 0}; isg = true; } break;
      case 8: case 10: case 20: case 22: { int ro = (ph == 8 || ph == 20) ? 0 : MH;
        g1 = GemmDesc{U, WB + (ph < 11 ? W0_W2 : W1_W2), 4096, 4096, MH, 1024, 4096, 2, X, 1024, X, X + (size_t)MP * DM, MODL + 5 * 1024, ro, 0}; isg = true; } break;
      case 12: g1 = GemmDesc{H, WB + W1_IN, 1024, 1024, M, 768, 1024, 3, ws + WS_Z1, 768, nullptr, nullptr, nullptr, 0, 0}; isg = true; break;
      case 13: l1_rows_phase(p); break;
      case 14: g1 = GemmDesc{(const bf16_t*)(ws + WS_CQN), WB + W1_QB, 384, 384, M, 1536, 384, 0, ws + WS_Q, 1536, nullptr, nullptr, nullptr, 0, 0}; isg = true; break;
      case 15: g1 = GemmDesc{(const bf16_t*)(ws + WS_CKVN), WB + W1_KVB, 256, 256, KROWS, 2048, 256, 0, ws + WS_KV, 2048, nullptr, nullptr, nullptr, 0, 0}; isg = true; break;
#ifndef NO_ATTN
      case 16: attn_phase(p, dry); break;
#endif
      case 17: g1 = GemmDesc{(const bf16_t*)(ws + WS_Q), WB + W1_OUT, 1536, 1024, M, 1024, 1024, 2, X, 1024, X, X + (size_t)MP * DM, MODL + 2 * 1024, 0, 0}; isg = true; break;
      case 23: final_norm_phase(p, dry); break;
      default: break;
    }
    if (ph == 1 || ph == 6 || ph == 11 || ph == 18) {
      const bool first = ph == 1;
      modulate_phase(p, first ? p->in[0] : X, first ? p->in[1] : X + (size_t)MP * DM, p->in[ph == 1 ? 9 : ph == 6 ? 10 : ph == 11 ? 26 : 27], MODL, (ph == 1 || ph == 11) ? 0 : 3);
    }
    if (ph == 0 || ph == 11) cvt_weights(p, ph == 0 ? 0 : 1, ph == 0 ? (bid + G - 192 % G) % G : bid, G);
#ifndef NO_LRU
    if (ph == 3 || ph == 4) {
      const int nit = ph == 3 ? 3072 + 1536 : 3072;
      for (int it = bid; it < nit; it += G) { if (it < 3072) lru_item(p, it >> 3, it & 7, ph - 3); else pool_item(p, (it - 3072) >> 2, (it - 3072) & 3); }
    }
#endif
#ifndef NO_GEMM
    g1.dry = (dry && g1.mode == 2 && ph != 5) ? 1 : 0;
    if (isg) gemm_phase(g1);
#endif
    if (coop && ph + 1 < p_hi && ph != 14) {
      if (ph == 0 && !dry) grid.sync(); else { XcdBarrier xb; xb.bar = (unsigned*)(ws + WS_BAR); xb.st = (volatile LAS unsigned*)(dyn_shm + LDS_MAIN); xcd_barrier(xb); } }
#if PROBE_PH >= 0
    if (dry) { rep = 1; --ph; }
#endif
  }
}

#ifndef MK_SPLIT
#define MK_SPLIT 0
#endif
extern "C" void kernel_launch(void* const* d_in, const int* in_sizes, int n_in, void* d_out, int out_size, void* d_ws, size_t ws_size, hipStream_t stream) {
  static int grid = 0;
  if (grid == 0) {
    if (n_in != 37 || ws_size < WS_END) { fprintf(stderr, "kernel_launch: bad n_in %d or ws %zu < %zu\n", n_in, ws_size, (size_t)WS_END); grid = -1; return; }
    int dev = 0, cus = 0, per_cu = 0;
    hipGetDevice(&dev); hipDeviceGetAttribute(&cus, hipDeviceAttributeMultiprocessorCount, dev);
    if (hipFuncSetAttribute((const void*)fwd_megakernel, hipFuncAttributeMaxDynamicSharedMemorySize, LDS_BYTES) != hipSuccess) { fprintf(stderr, "kernel_launch: hipFuncSetAttribute failed\n"); grid = -1; return; }
    if (hipOccupancyMaxActiveBlocksPerMultiprocessor(&per_cu, (const void*)fwd_megakernel, 512, LDS_BYTES) != hipSuccess || per_cu < 1) { fprintf(stderr, "kernel_launch: occupancy query gave %d\n", per_cu); grid = -1; return; }
    grid = cus;
  }
  if (grid < 0) return;
  if (hipMemsetAsync((char*)d_ws + WS_BAR, 0, XCD_BAR_WORDS * 4, stream) != hipSuccess) { fprintf(stderr, "kernel_launch: memset failed\n"); return; }
  Params p{};
  for (int i = 0; i < 37; ++i) p.in[i] = (const float*)d_in[i];
  p.out = (float*)d_out; p.ws = (unsigned char*)d_ws; p.pad = PROBE_PH;
#if MK_SPLIT
  for (int ph = 0; ph < NPH; ++ph) {
    p.p_lo = ph; p.p_hi = ph + 1; p.coop = 0;
    hipLaunchKernelGGL(fwd_megakernel, dim3(grid), dim3(512), LDS_BYTES, stream, p);
  }
#else
  p.p_lo = 0; p.p_hi = NPH; p.coop = 1;
  void* args[] = {&p};
  hipError_t e = hipLaunchCooperativeKernel((const void*)fwd_megakernel, dim3(grid), dim3(512), args, LDS_BYTES, stream);
  if (e != hipSuccess) fprintf(stderr, "cooperative launch failed: %s (grid %d)\n", hipGetErrorString(e), grid);
#endif
}
```

```cpp
#include <hip/hip_runtime.h>
#include <hip/hip_cooperative_groups.h>
#include <cstdio>
#include <cstdint>
namespace cg = cooperative_groups;
#ifndef PROBE_PH
#define PROBE_PH -1
#endif

typedef unsigned short bf16_t;
typedef short bf16x8 __attribute__((ext_vector_type(8)));
typedef short s16x4 __attribute__((ext_vector_type(4)));
typedef float f32x4 __attribute__((ext_vector_type(4)));
typedef float f32x16 __attribute__((ext_vector_type(16)));
typedef unsigned u32x4 __attribute__((ext_vector_type(4)));
typedef unsigned u32x2 __attribute__((ext_vector_type(2)));

constexpr int DM = 1024, MP = 8192, MS = 16384, M = MP + MS, DFF = 4096;
constexpr int SEQ = 256, DSEQ = 4096, PAST = 512, NB_S = 4;
constexpr int KROWS = MP + NB_S * (DSEQ + PAST);
constexpr int SKEYS = DSEQ + PAST;
constexpr int MH = M / 2;
constexpr float EPS = 1e-6f;
constexpr int NPH = 24;

constexpr size_t MiB = 1u << 20;
constexpr size_t WS_MOD = 0;
constexpr size_t WS_ROPE = 256 * 1024;
constexpr size_t WS_LS8 = 260 * 1024;
constexpr size_t WS_SUM = 512 * 1024;
constexpr size_t WS_BAR = 3840 * 1024;
constexpr size_t WS_WB = 4 * MiB;
constexpr size_t WS_R1 = 26 * MiB;
constexpr size_t WS_H = WS_R1;
constexpr size_t WS_Z0 = WS_R1 + 48 * MiB;
constexpr size_t WS_U = WS_R1 + 48 * MiB;
constexpr size_t WS_KV = WS_R1;
constexpr size_t WS_Q = WS_R1 + 104 * MiB;
constexpr size_t WS_Z1 = WS_R1 + 104 * MiB;
constexpr size_t WS_CQN = WS_R1 + 176 * MiB;
constexpr size_t WS_CKVN = WS_R1 + 194 * MiB;
constexpr size_t WS_KPE = WS_R1 + 207 * MiB;
constexpr size_t WS_END = WS_R1 + 209 * MiB;
constexpr size_t W0_IN = 0, W0_OUT = 1572864, W0_W1 = 2621440, W0_W2 = 6815744, W0_G = 11010048, W0_P = 11141120;
constexpr size_t W1_IN = 0, W1_QB = 786432, W1_KVB = 1376256, W1_OUT = 1900544, W1_W1 = 2949120, W1_W2 = 7143424;
constexpr size_t O_Y = 0, O_LRU = 25165824, O_CKV = 25198592, O_KPE = 27295744;

struct Params {
  const float* in[37];
  float* out;
  unsigned char* ws;
  int p_lo, p_hi, coop, pad;
};

typedef const __attribute__((address_space(4))) Params* KP;
extern __shared__ __attribute__((aligned(16))) unsigned char dyn_shm[];
constexpr int LDS_MAIN = 139264;
constexpr int LDS_BYTES = LDS_MAIN + 16;

__device__ __forceinline__ unsigned cvtpk(float lo, float hi) {
  unsigned r; asm volatile("v_cvt_pk_bf16_f32 %0, %1, %2" : "=v"(r) : "v"(lo), "v"(hi)); return r;
}
__device__ __forceinline__ float bf2f(bf16_t b) { return __uint_as_float(((unsigned)b) << 16); }
__device__ __forceinline__ bf16_t f2bf(float f) { return (bf16_t)(cvtpk(f, f) & 0xffffu); }
__device__ __forceinline__ float sigmoidf_(float x) { return 1.f / (1.f + __expf(-x)); }
__device__ __forceinline__ float gelu_tanh(float x) {
  float u = 0.7978845608028654f * (x + 0.044715f * x * x * x);
  float e = __expf(2.f * u);
  float th = 1.f - 2.f / (e + 1.f);
  return 0.5f * x * (1.f + th);
}
__device__ __forceinline__ float lane_xor(float v, int lane, int o) { return __int_as_float(__builtin_amdgcn_ds_bpermute((lane ^ o) << 2, __float_as_int(v))); }
__device__ __forceinline__ float wave_sum(float v, int lane) {
#pragma unroll
  for (int o = 32; o > 0; o >>= 1) v += lane_xor(v, lane, o);
  return v;
}
__device__ __forceinline__ void my_sincos(float a, float& s, float& c) {
  float k = rintf(a * 0.63661977236758134f);
  float r = fmaf(k, -1.5707962513e+00f, a);
  r = fmaf(k, -7.5497894159e-08f, r);
  r = fmaf(k, -5.3903029534e-15f, r);
  float r2 = r * r;
  float sp = r + r * r2 * (-1.6666667163e-01f + r2 * (8.3333337680e-03f + r2 * (-1.9841270114e-04f + r2 * 2.7557314297e-06f)));
  float cp = 1.f + r2 * (-0.5f + r2 * (4.1666667908e-02f + r2 * (-1.3888889225e-03f + r2 * 2.4801587642e-05f)));
  int q = ((int)k) & 3;
  float ss = (q & 1) ? cp : sp, cc = (q & 1) ? sp : cp;
  s = (q & 2) ? -ss : ss;
  c = ((q + 1) & 2) ? -cc : cc;
}
__device__ __forceinline__ int bid_() { int b = blockIdx.x; asm volatile("" : "+s"(b)); return b; }
__device__ __forceinline__ int gdim_() { int g = gridDim.x; asm volatile("" : "+s"(g)); return g; }
__device__ __forceinline__ int tid_() { int t = threadIdx.x; asm volatile("" : "+v"(t)); return t; }
__device__ __forceinline__ int cond_of_row(int row) { return row < MP ? 0 : 1 + ((row - MP) >> 12); }


#define XB_TMO      128
#define XB_XCNT(j)  (256  + 64 * (j))
#define XB_XSUB(j)  (1280 + 64 * (j))
#define XB_XGEN(j)  (2304 + 64 * (j))
#define XB_TOP      3328
#define XB_TOPGEN   3392
#define XCD_BAR_WORDS 3456
#define XB_SPIN_CAP (1u << 20)
#define LAS __attribute__((address_space(3)))
__device__ __forceinline__ unsigned xb_ld(unsigned* p)              { return __hip_atomic_load(p, __ATOMIC_RELAXED, __HIP_MEMORY_SCOPE_AGENT); }
__device__ __forceinline__ unsigned xb_add(unsigned* p, unsigned v) { return __hip_atomic_fetch_add(p, v, __ATOMIC_RELAXED, __HIP_MEMORY_SCOPE_AGENT); }
__device__ __forceinline__ unsigned xb_xcc_id() { return (unsigned)__builtin_amdgcn_s_getreg((3 << 11) | 20) & 0xFu; }
#define XB_SPIN(cond, bar) do { unsigned _sp = 0; while (cond) { __builtin_amdgcn_s_sleep(1); \
    if ((++_sp & 255u) == 0u) { if (xb_ld(&(bar)[XB_TMO])) break; if (_sp > XB_SPIN_CAP) { atomicAdd(&(bar)[XB_TMO], 1u); break; } } } } while (0)
struct XcdBarrier { unsigned* bar; volatile LAS unsigned* st; };
__device__ __forceinline__ XcdBarrier xcd_barrier_post(unsigned* bar, volatile LAS unsigned* st) {
  XcdBarrier b; b.bar = bar; b.st = st;
  if (threadIdx.x == 0) (void)xb_add(&bar[XB_XCNT(xb_xcc_id())], 1u);
  return b;
}
__device__ __forceinline__ void xcd_barrier_complete(unsigned* bar, unsigned x, unsigned& nloc, unsigned& nx) {
  const unsigned G = (unsigned)gdim_();
  unsigned sum, cnt, mine, sp = 0u;
  for (;;) {
    sum = 0u; cnt = 0u; mine = 0u;
#pragma unroll
    for (unsigned j = 0; j < 16; ++j) { const unsigned c = xb_ld(&bar[XB_XCNT(j)]); sum += c; cnt += (c > 0u) ? 1u : 0u; mine = (j == x) ? c : mine; }
    if (sum == G) break;
    __builtin_amdgcn_s_sleep(1);
    if ((++sp & 255u) == 0u) { if (xb_ld(&bar[XB_TMO])) break; if (sp > XB_SPIN_CAP) { atomicAdd(&bar[XB_TMO], 1u); break; } }
  }
  nloc = mine > 0u ? mine : 1u; nx = cnt > 0u ? cnt : 1u;
}
__device__ __forceinline__ void xcd_barrier(const XcdBarrier& b) {
  asm volatile("s_waitcnt vmcnt(0)" ::: "memory");
  __syncthreads();
  if (threadIdx.x == 0) {
    unsigned* bar = b.bar; unsigned bx = xb_xcc_id(); asm volatile("" : "+s"(bx));
    __builtin_amdgcn_s_waitcnt(0);
    unsigned nloc = b.st[0], nx = b.st[1];
    if (nloc == 0u) { xcd_barrier_complete(bar, bx, nloc, nx); b.st[0] = nloc; b.st[1] = nx; }
    const unsigned old = xb_add(&bar[XB_XSUB(bx)], 1u);
    const unsigned gen = old / nloc;
    if (old + 1u == (gen + 1u) * nloc) {
      __builtin_amdgcn_fence(__ATOMIC_RELEASE, "agent");
      asm volatile("s_waitcnt vmcnt(0)" ::: "memory");
      const unsigned og = xb_add(&bar[XB_TOP], 1u);
      const unsigned tg = og / nx;
      if (og + 1u == (tg + 1u) * nx) xb_add(&bar[XB_TOPGEN], 1u);
      else XB_SPIN(xb_ld(&bar[XB_TOPGEN]) == tg, bar);
      __builtin_amdgcn_fence(__ATOMIC_ACQUIRE, "agent");
      xb_add(&bar[XB_XGEN(bx)], 1u);
      asm volatile("s_waitcnt vmcnt(0)" ::: "memory");
    } else {
      XB_SPIN(xb_ld(&bar[XB_XGEN(bx)]) == gen, bar);
      __builtin_amdgcn_fence(__ATOMIC_ACQUIRE, "agent");
      asm volatile("s_waitcnt vmcnt(0)" ::: "memory");
    }
  }
  __syncthreads();
}

constexpr int BM = 256, BK = 64, HALF = 128, HT = HALF * BK, NXCD = 8, WGM = 8;
__device__ __forceinline__ int lds_byte(int r, int c) {
  int st = (r >> 4) * 2 + (c >> 5), rr = r & 15, cc = c & 31, ob = rr * 64 + cc * 2;
  return st * 1024 + (ob ^ (((ob >> 9) & 1) << 5));
}
__device__ __forceinline__ void stage_rc(int b, int& R, int& C) {
  int st = b / 1024, sb = b % 1024, swz = sb ^ (((sb >> 9) & 1) << 5);
  R = (st >> 1) * 16 + swz / 64; C = (st & 1) * 32 + (swz % 64) / 2;
}

struct GemmDesc {
  const bf16_t* A; const bf16_t* Bt; int lda, ldb, Mrows, N, K;
  int mode;
  void* out; int ldc;
  const float* src0; const float* src1; const float* gate; int row_off; int dry;
};

__device__ __forceinline__ void gemm_epi(const GemmDesc& g, int row, int col, f32x4 v) {
#if PROBE_PH >= 0
  if (g.dry) return;
#endif
  if (g.mode == 0) {
    u32x2 w; w.x = cvtpk(v[0], v[1]); w.y = cvtpk(v[2], v[3]);
    *(u32x2*)((bf16_t*)g.out + (size_t)row * g.ldc + col) = w;
  } else if (g.mode == 1) {
    float a = fmaxf(v[0], 0.f), b = fmaxf(v[1], 0.f), c = fmaxf(v[2], 0.f), d = fmaxf(v[3], 0.f);
    u32x2 w; w.x = cvtpk(a * a, b * b); w.y = cvtpk(c * c, d * d);
    *(u32x2*)((bf16_t*)g.out + (size_t)row * g.ldc + col) = w;
  } else if (g.mode == 2) {
    int rg = row + g.row_off;
    const float* sp = rg < MP ? g.src0 + (size_t)rg * DM + col : g.src1 + (size_t)(rg - MP) * DM + col;
    f32x4 x = *(const f32x4*)sp;
    f32x4 gt = *(const f32x4*)(g.gate + cond_of_row(rg) * 6144 + col);
    *(f32x4*)((float*)g.out + (size_t)rg * DM + col) = x + gt * v;
  } else {
    *(f32x4*)((float*)g.out + (size_t)row * g.ldc + col) = v;
  }
}

template <int MF>
__device__ __forceinline__ void gemm_tile(const GemmDesc& g, int brow, int bcol) {
  constexpr int AH = MF * 32;
  bf16_t* shm = (bf16_t*)dyn_shm;
  const bf16_t* A = g.A; const bf16_t* Bt = g.Bt; const int lda = g.lda, ldb = g.ldb, K = g.K;
#define SA(b,h) (shm+((b)*2+(h))*HT)
#define SB(b,h) (shm+(4+(b)*2+(h))*HT)
#define STAGE(P,BASE,LD,VO,br,kt) do{const unsigned char* _ub=(const unsigned char*)(BASE)+((size_t)(br)*(LD)+(size_t)(kt)*BK)*2; \
    const unsigned char* _ub2=_ub+(size_t)(LD)*128; \
    const unsigned _m0=(unsigned)(uintptr_t)(__attribute__((address_space(3))) unsigned char*)((unsigned char*)(P))+ldsw; \
    asm volatile("s_mov_b32 m0, %0\n\ts_nop 0\n\tglobal_load_lds_dwordx4 %1, %2\n\ts_mov_b32 m0, %3\n\ts_nop 0\n\tglobal_load_lds_dwordx4 %1, %4" \
      :: "s"(_m0), "v"(VO), "s"(_ub), "s"(_m0+8192u), "s"(_ub2) : "m0", "memory");}while(0)
#define LDA(dst,b,h) for(int m=0;m<MF;++m)for(int k=0;k<2;++k) \
    dst[m][k]=*reinterpret_cast<const bf16x8*>((char*)SA(b,h)+lds_byte(wr*(MF*16)+m*16+fr,k*32+fq*8))
#define LDB(dst,b,h) for(int n=0;n<2;++n)for(int k=0;k<2;++k) \
    dst[n][k]=*reinterpret_cast<const bf16x8*>((char*)SB(b,h)+lds_byte(wc*32+n*16+fr,k*32+fq*8))
#define MMA(ai,bj,At,Bt_) do{__builtin_amdgcn_s_setprio(1); \
    for(int m=0;m<MF;++m)for(int n=0;n<2;++n)for(int k=0;k<2;++k) \
      acc[ai][bj][m][n]=__builtin_amdgcn_mfma_f32_16x16x32_bf16(Bt_[n][k],At[m][k],acc[ai][bj][m][n],0,0,0); \
    __builtin_amdgcn_s_setprio(0);}while(0)
#define WAIT_V(n) asm volatile("s_waitcnt vmcnt(" #n ")":::"memory")
#define WAIT_L(n) asm volatile("s_waitcnt lgkmcnt(" #n ")":::"memory")
#define BAR __builtin_amdgcn_s_barrier()
#define SCHED __builtin_amdgcn_sched_barrier(0)
  const int tid = tid_();
  const int wid = __builtin_amdgcn_readfirstlane(tid >> 6), lane = tid & 63, wr = wid >> 2, wc = wid & 3, fr = lane & 15, fq = lane >> 4;
  const unsigned ldsw = (unsigned)wid * 1024u;
  unsigned voA, voB;
  { int r_, c_; stage_rc(tid * 16, r_, c_); voA = (unsigned)(r_ * lda + c_) * 2u; voB = (unsigned)(r_ * ldb + c_) * 2u; }
  f32x4 acc[2][2][MF][2] = {};
  bf16x8 At[MF][2], B0[2][2], B1[2][2];
  const int nt = K / BK;
  __syncthreads();
  STAGE(SB(0,0),Bt,ldb,voB,bcol,0); STAGE(SA(0,0),A,lda,voA,brow,0);
  STAGE(SB(0,1),Bt,ldb,voB,bcol+HALF,0); STAGE(SA(0,1),A,lda,voA,brow+AH,0);
  if(wr==1)BAR;
  WAIT_V(4); BAR;
  STAGE(SB(1,0),Bt,ldb,voB,bcol,1); STAGE(SA(1,0),A,lda,voA,brow,1); STAGE(SB(1,1),Bt,ldb,voB,bcol+HALF,1);
  WAIT_V(6); BAR;
  for(int t=0;t<nt-2;t+=2){
    LDB(B0,0,0); SCHED; LDA(At,0,0); STAGE(SA(1,1),A,lda,voA,brow+AH,t+1);
    if (MF == 4) WAIT_L(8); else WAIT_L(6); BAR; WAIT_L(0); MMA(0,0,At,B0); BAR; SCHED;
    LDB(B1,0,1); STAGE(SB(0,0),Bt,ldb,voB,bcol,t+2);
    BAR; WAIT_L(0); MMA(0,1,At,B1); BAR;
    LDA(At,0,1); STAGE(SA(0,0),A,lda,voA,brow,t+2);
    BAR; WAIT_L(0); MMA(1,0,At,B0); BAR; SCHED;
    STAGE(SB(0,1),Bt,ldb,voB,bcol+HALF,t+2);
    WAIT_V(6); BAR; MMA(1,1,At,B1); BAR;
    LDB(B0,1,0); SCHED; LDA(At,1,0); STAGE(SA(0,1),A,lda,voA,brow+AH,t+2);
    if (MF == 4) WAIT_L(8); else WAIT_L(6); BAR; WAIT_L(0); MMA(0,0,At,B0); BAR; SCHED;
    LDB(B1,1,1); STAGE(SB(1,0),Bt,ldb,voB,bcol,t+3);
    BAR; WAIT_L(0); MMA(0,1,At,B1); BAR;
    LDA(At,1,1); STAGE(SA(1,0),A,lda,voA,brow,t+3);
    BAR; WAIT_L(0); MMA(1,0,At,B0); BAR; SCHED;
    STAGE(SB(1,1),Bt,ldb,voB,bcol+HALF,t+3);
    WAIT_V(6); BAR; MMA(1,1,At,B1); BAR;
  }
  { LDB(B0,0,0); LDA(At,0,0); STAGE(SA(1,1),A,lda,voA,brow+AH,nt-1);
    BAR; WAIT_L(0); MMA(0,0,At,B0); BAR;
    LDB(B1,0,1); BAR; WAIT_L(0); MMA(0,1,At,B1); BAR;
    LDA(At,0,1); WAIT_V(4); BAR; WAIT_L(0); MMA(1,0,At,B0); MMA(1,1,At,B1); BAR; }
  { LDB(B0,1,0); LDA(At,1,0); WAIT_V(2); BAR; WAIT_L(0); MMA(0,0,At,B0); BAR;
    LDB(B1,1,1); WAIT_V(0); BAR; WAIT_L(0); MMA(0,1,At,B1); BAR;
    LDA(At,1,1); BAR; WAIT_L(0); MMA(1,0,At,B0); MMA(1,1,At,B1); BAR; }
  if(wr==0)BAR;
  const int tid2 = tid_(); const int wid2 = tid2 >> 6, lane2 = tid2 & 63;
  if (g.mode <= 1) {
    unsigned char* st = dyn_shm;
    const int lrow = (wid2 >> 2) * (MF * 16) + (lane2 & 15), lcol = (wid2 & 3) * 32 + (lane2 >> 4) * 4;
    const bool sq = g.mode == 1;
#pragma unroll
    for(int ai=0;ai<2;++ai)
#pragma unroll
      for(int m=0;m<MF;++m)
#pragma unroll
        for(int bj=0;bj<2;++bj)
#pragma unroll
          for(int n=0;n<2;++n) {
            f32x4 v = acc[ai][bj][m][n];
            if (sq) { v[0] = fmaxf(v[0], 0.f); v[1] = fmaxf(v[1], 0.f); v[2] = fmaxf(v[2], 0.f); v[3] = fmaxf(v[3], 0.f); v = v * v; }
            u32x2 w; w.x = cvtpk(v[0], v[1]); w.y = cvtpk(v[2], v[3]);
            *(u32x2*)(st + (lrow + ai * AH + m * 16) * 544 + (lcol + bj * HALF + n * 16) * 2) = w;
          }
    __syncthreads();
#if PROBE_PH >= 0
    if (!g.dry)
#endif
    {
      bf16_t* ob = (bf16_t*)g.out + (size_t)brow * g.ldc + bcol;
      const int r0 = wid2 * (MF * 8) + (lane2 >> 5), c16 = (lane2 & 31);
#pragma unroll 4
      for (int i = 0; i < MF * 4; ++i) {
        const int r = r0 + 2 * i;
        u32x4 w = *(const u32x4*)(st + r * 544 + c16 * 16);
        *(u32x4*)(ob + (size_t)r * g.ldc + c16 * 8) = w;
      }
    }
  } else {
  const int erow = brow + (wid2 >> 2) * (MF * 16) + (lane2 & 15), ecol = bcol + (wid2 & 3) * 32 + (lane2 >> 4) * 4;
#pragma unroll
  for(int ai=0;ai<2;++ai)
#pragma unroll
    for(int m=0;m<MF;++m)
#pragma unroll
      for(int bj=0;bj<2;++bj)
#pragma unroll
        for(int n=0;n<2;++n)
          gemm_epi(g, erow+ai*AH+m*16, ecol+bj*HALF+n*16, acc[ai][bj][m][n]);
  }
#undef SA
#undef SB
#undef STAGE
#undef LDA
#undef LDB
#undef MMA
}

__device__ __forceinline__ void tile_of(int L, int nM, int nN, int nwg, int th, int& brow, int& bcol) {
  int wgid = L;
  { const int q = nwg / NXCD, r = nwg % NXCD, xcd = wgid % NXCD, off = wgid / NXCD; wgid = (xcd < r ? xcd * (q + 1) : r * (q + 1) + (xcd - r) * q) + off; }
  const int nig = WGM * nN, gid = wgid / nig, fm = gid * WGM, gsz = (nM - fm) < WGM ? (nM - fm) : WGM;
  brow = (fm + ((wgid % nig) % gsz)) * th; bcol = ((wgid % nig) / gsz) * BM;
}
__device__ __forceinline__ void gemm_phase(const GemmDesc& g) {
  const int G = gdim_();
  const bool m3 = (g.Mrows % 192) == 0 && g.N <= 1536;
  const int th = m3 ? 192 : 256;
  const int nM = g.Mrows / th, nN = g.N / BM, nwg = nM * nN;
  for (int L = bid_(); L < nwg; L += G) {
    int brow, bcol; tile_of(L, nM, nN, nwg, th, brow, bcol);
    if (m3) gemm_tile<3>(g, brow, bcol); else gemm_tile<4>(g, brow, bcol);
  }
}

constexpr float ATT_SCALE = 0.10206207261596577f;
constexpr float ATT_THR = 8.f;
constexpr int SHM_V = 64 * 64 * 2, SHM_K = 64 * 128 * 2;
#define KSWZ(row, colB) ((row) * 256 + ((colB) ^ (((row) & 7) << 4)))
#define SBAR() __builtin_amdgcn_sched_barrier(0)
__device__ __forceinline__ int crow(int r, int hi) { return (r & 3) + 8 * (r >> 2) + 4 * hi; }

__device__ __forceinline__ void partialSM(f32x16& p0, f32x16& p1, float& m_reg, float& alpha, bool first) {
  constexpr float THRL = ATT_THR * 1.4426950408889634f;
  float pmax = p0[0];
#pragma unroll
  for (int r = 1; r < 16; ++r) pmax = fmaxf(pmax, p0[r]);
#pragma unroll
  for (int r = 0; r < 16; ++r) pmax = fmaxf(pmax, p1[r]);
  { auto rr = __builtin_amdgcn_permlane32_swap(__float_as_uint(pmax), __float_as_uint(pmax), false, false);
    pmax = fmaxf(__uint_as_float(rr[0]), __uint_as_float(rr[1])); }
  if (first) {
    alpha = 0.f; m_reg = pmax;
#pragma unroll
    for (int r = 0; r < 16; ++r) p0[r] -= pmax;
#pragma unroll
    for (int r = 0; r < 16; ++r) p1[r] -= pmax;
  } else if (__builtin_expect(__all(pmax <= THRL), 1)) { alpha = 1.f; }
  else { const float d = fmaxf(pmax, 0.f); alpha = __builtin_amdgcn_exp2f(-d); m_reg += d;
#pragma unroll
    for (int r = 0; r < 16; ++r) p0[r] -= d;
#pragma unroll
    for (int r = 0; r < 16; ++r) p1[r] -= d;
  }
#pragma unroll
  for (int r = 0; r < 16; ++r) p0[r] = __builtin_amdgcn_exp2f(p0[r]);
}
__device__ __forceinline__ void finishSM(f32x16& p0, f32x16& p1, float alpha, float& l_reg, bf16x8& pa0, bf16x8& pa1, bf16x8& pa2, bf16x8& pa3) {
#pragma unroll
  for (int r = 0; r < 16; ++r) p1[r] = __builtin_amdgcn_exp2f(p1[r]);
  float ps = 0;
#pragma unroll
  for (int r = 0; r < 16; ++r) ps += p0[r];
#pragma unroll
  for (int r = 0; r < 16; ++r) ps += p1[r];
  { auto rr = __builtin_amdgcn_permlane32_swap(__float_as_uint(ps), __float_as_uint(ps), false, false);
    ps = __uint_as_float(rr[0]) + __uint_as_float(rr[1]); }
  l_reg = l_reg * alpha + ps;
#define PK4(P, BASE, OUT) do { unsigned a0 = cvtpk(P[BASE + 0], P[BASE + 1]), a1 = cvtpk(P[BASE + 2], P[BASE + 3]);   \
    unsigned b0 = cvtpk(P[BASE + 4], P[BASE + 5]), b1 = cvtpk(P[BASE + 6], P[BASE + 7]);                              \
    auto r0 = __builtin_amdgcn_permlane32_swap(a0, b0, false, false); auto r1 = __builtin_amdgcn_permlane32_swap(a1, b1, false, false); \
    u32x4 w = {r0[0], r1[0], r0[1], r1[1]}; OUT = *reinterpret_cast<bf16x8*>(&w); } while (0)
  PK4(p0, 0, pa0); PK4(p0, 8, pa1); PK4(p1, 0, pa2); PK4(p1, 8, pa3);
#undef PK4
}
__device__ __forceinline__ void qkt(f32x16& p0, f32x16& p1, const unsigned char* Ks, const bf16x8* qr, int r32, int hi, float init) {
#pragma unroll
  for (int r = 0; r < 16; ++r) { p0[r] = init; p1[r] = init; }
#pragma unroll
  for (int d0 = 0; d0 < 6; ++d0) { int cb = (d0 * 16 + hi * 8) * 2;
    bf16x8 b0 = *reinterpret_cast<const bf16x8*>(Ks + KSWZ(r32, cb));
    bf16x8 b1 = *reinterpret_cast<const bf16x8*>(Ks + KSWZ(32 + r32, cb));
    p0 = __builtin_amdgcn_mfma_f32_32x32x16_bf16(b0, qr[d0], p0, 0, 0, 0);
    p1 = __builtin_amdgcn_mfma_f32_32x32x16_bf16(b1, qr[d0], p1, 0, 0, 0); }
}
__device__ __forceinline__ int v_st(int k, int c) { const int kk = (k & ~0xC) | ((k & 4) << 1) | ((k & 8) >> 1); return ((kk >> 3) * 2 + (c >> 5)) * 512 + ((kk & 7) * 32 + (c & 31)) * 2; }
__device__ __forceinline__ int v_rd_base(int lane) { return ((lane & 3) << 3) | (((lane >> 2) & 3) << 6) | (((lane >> 4) & 1) << 5) | (((lane >> 5) & 1) << 8); }
constexpr int v_rd_off(int d0, int ks, int half) { return d0 * 512 + ks * 2048 + half * 1024; }
template <int OFF> __device__ __forceinline__ s16x4 tr_read(int vb) {
  s16x4 r; asm volatile("ds_read_b64_tr_b16 %0, %1 offset:%2" : "=&v"(r) : "v"(vb), "i"(OFF) : "memory"); return r;
}
__device__ __forceinline__ void pv_d0(f32x16* o, int vb, bf16x8 pa0, bf16x8 pa1, bf16x8 pa2, bf16x8 pa3) {
  const s16x4 l0 = tr_read<v_rd_off(0, 0, 0)>(vb), h0 = tr_read<v_rd_off(0, 0, 1)>(vb), l1 = tr_read<v_rd_off(0, 1, 0)>(vb), h1 = tr_read<v_rd_off(0, 1, 1)>(vb);
  const s16x4 l2 = tr_read<v_rd_off(0, 2, 0)>(vb), h2 = tr_read<v_rd_off(0, 2, 1)>(vb), l3 = tr_read<v_rd_off(0, 3, 0)>(vb), h3 = tr_read<v_rd_off(0, 3, 1)>(vb);
  const s16x4 m0 = tr_read<v_rd_off(1, 0, 0)>(vb), n0 = tr_read<v_rd_off(1, 0, 1)>(vb), m1 = tr_read<v_rd_off(1, 1, 0)>(vb), n1 = tr_read<v_rd_off(1, 1, 1)>(vb);
  const s16x4 m2 = tr_read<v_rd_off(1, 2, 0)>(vb), n2 = tr_read<v_rd_off(1, 2, 1)>(vb), m3 = tr_read<v_rd_off(1, 3, 0)>(vb), n3 = tr_read<v_rd_off(1, 3, 1)>(vb);
  asm volatile("s_waitcnt lgkmcnt(0)" ::: "memory"); SBAR();
#define PK(L, H) (bf16x8){L[0], L[1], L[2], L[3], H[0], H[1], H[2], H[3]}
  o[0] = __builtin_amdgcn_mfma_f32_32x32x16_bf16(pa0, PK(l0, h0), o[0], 0, 0, 0);
  o[1] = __builtin_amdgcn_mfma_f32_32x32x16_bf16(pa0, PK(m0, n0), o[1], 0, 0, 0);
  o[0] = __builtin_amdgcn_mfma_f32_32x32x16_bf16(pa1, PK(l1, h1), o[0], 0, 0, 0);
  o[1] = __builtin_amdgcn_mfma_f32_32x32x16_bf16(pa1, PK(m1, n1), o[1], 0, 0, 0);
  o[0] = __builtin_amdgcn_mfma_f32_32x32x16_bf16(pa2, PK(l2, h2), o[0], 0, 0, 0);
  o[1] = __builtin_amdgcn_mfma_f32_32x32x16_bf16(pa2, PK(m2, n2), o[1], 0, 0, 0);
  o[0] = __builtin_amdgcn_mfma_f32_32x32x16_bf16(pa3, PK(l3, h3), o[0], 0, 0, 0);
  o[1] = __builtin_amdgcn_mfma_f32_32x32x16_bf16(pa3, PK(m3, n3), o[1], 0, 0, 0);
#undef PK
}

__device__ __forceinline__ void attn_unit(bf16_t* Qrows, int h, const bf16_t* KVb, const bf16_t* KPb, int nkeys, bool rope, int s0, const float* ropetab, int dry) {
  unsigned char* lds = dyn_shm;
  const int tid = tid_(), wid = tid >> 6, lane = tid & 63, r32 = lane & 31, hi = lane >> 5;
  unsigned char* V_lds = lds; unsigned char* K_lds = lds + 3 * SHM_V;
  float* ws = (float*)(lds + 3 * SHM_V + 3 * SHM_K) + wid * 64; float* li_l = ws; float* al_l = ws + 32;
  float m_reg = -1e30f, l_reg = 0; f32x16 o[2] = {}; bf16x8 qr[6];
  __syncthreads();
  {
    const int row = wid * 32 + r32;
    const bf16_t* Qn = Qrows + (size_t)row * 1536 + h * 64 + hi * 8;
#pragma unroll
    for (int d0 = 0; d0 < 4; ++d0) qr[d0] = *reinterpret_cast<const bf16x8*>(Qn + d0 * 16);
    const bf16_t* Qp = Qrows + (size_t)row * 1536 + 1024 + h * 32;
    const int s = s0 + row;
#pragma unroll
    for (int blk = 0; blk < 2; ++blk) {
      bf16x8 x1 = *reinterpret_cast<const bf16x8*>(Qp + blk * 16), x2 = *reinterpret_cast<const bf16x8*>(Qp + blk * 16 + 8);
      if (rope) {
        const int pos = blk == 0 ? (s >> 6) : (s & 63);
        const float* tb = ropetab + pos * 16;
        float ov[8];
#pragma unroll
        for (int j = 0; j < 8; ++j) {
          float a = bf2f((bf16_t)x1[j]), b = bf2f((bf16_t)x2[j]), cs = tb[2 * j], sn = tb[2 * j + 1];
          ov[j] = hi == 0 ? a * cs - b * sn : b * cs + a * sn;
        }
        u32x4 w = {cvtpk(ov[0], ov[1]), cvtpk(ov[2], ov[3]), cvtpk(ov[4], ov[5]), cvtpk(ov[6], ov[7])};
        qr[4 + blk] = *reinterpret_cast<bf16x8*>(&w);
      } else {
        qr[4 + blk] = hi == 0 ? x1 : x2;
      }
    }
  }
  const int vrow = tid >> 3, vc = (tid & 7) * 8, vst = v_st(vrow, vc);
  const bf16_t* vsrc = KVb + (size_t)vrow * 2048 + h * 128 + 64 + vc;
  const bool kact = tid < 384;
  const int kr = kact ? tid / 12 : 0, kc = kact ? (tid % 12) * 8 : 0;
  const bf16_t* ksrc = kc < 64 ? KVb + (size_t)kr * 2048 + h * 128 + kc : KPb + (size_t)kr * 32 + (kc - 64);
  const long kstride = kc < 64 ? 2048 : 32;
  const int kst0 = KSWZ(kr, kc * 2), kst1 = KSWZ(32 + kr, kc * 2);
  const int vb0 = (int)(uintptr_t)V_lds + v_rd_base(lane);
  struct { bf16x8 vs, ks0, ks1; } sr_[2];
#define SLOAD(i, k0) do { sr_[i].vs = *reinterpret_cast<const bf16x8*>(vsrc + (size_t)(k0) * 2048); \
    if (kact) { sr_[i].ks0 = *reinterpret_cast<const bf16x8*>(ksrc + (long)(k0) * kstride); sr_[i].ks1 = *reinterpret_cast<const bf16x8*>(ksrc + (long)((k0) + 32) * kstride); } } while (0)
#define SWRITE(b, i) do { *(bf16x8*)(V_lds + (b) * SHM_V + vst) = sr_[i].vs; \
    if (kact) { *(bf16x8*)(K_lds + (b) * SHM_K + kst0) = sr_[i].ks0; *(bf16x8*)(K_lds + (b) * SHM_K + kst1) = sr_[i].ks1; } } while (0)
#define RESC(a) do { if (__any((a) < 1.f)) { if (hi == 0) al_l[r32] = (a); asm volatile("s_waitcnt lgkmcnt(0)" ::: "memory"); \
    for (int d = 0; d < 2; ++d) for (int r = 0; r < 16; ++r) o[d][r] *= al_l[crow(r, hi)]; } } while (0)
  f32x16 pA0, pA1, pB0, pB1; float alA, alB; bf16x8 pa0, pa1, pa2, pa3; const int NT = nkeys / 64;
  constexpr int SE = 0, SO = 1;
  SLOAD(SE, 0); SWRITE(0, SE); SLOAD(SO, 64); __syncthreads();
  qkt(pA0, pA1, K_lds, qr, r32, hi, 0.f); partialSM(pA0, pA1, m_reg, alA, true);
  SWRITE(1, SO); if (2 < NT) SLOAD(SE, 128);
  int bc = 1;
  for (int j = 1; j + 1 < NT; j += 2) {
    const int bp = bc == 0 ? 2 : bc - 1, bn = bc == 2 ? 0 : bc + 1;
    __syncthreads();
    SBAR(); qkt(pB0, pB1, K_lds + bc * SHM_K, qr, r32, hi, -m_reg);
    finishSM(pA0, pA1, alA, l_reg, pa0, pa1, pa2, pa3); SBAR();
    SLOAD(SO, (j + 2) * 64); SBAR();
    pv_d0(o, vb0 + bp * SHM_V, pa0, pa1, pa2, pa3); partialSM(pB0, pB1, m_reg, alB, false);
    SWRITE(bn, SE);
    RESC(alB);
    __syncthreads();
    SBAR(); qkt(pA0, pA1, K_lds + bn * SHM_K, qr, r32, hi, -m_reg);
    finishSM(pB0, pB1, alB, l_reg, pa0, pa1, pa2, pa3); SBAR();
    if (j + 3 < NT) SLOAD(SE, (j + 3) * 64); SBAR();
    pv_d0(o, vb0 + bc * SHM_V, pa0, pa1, pa2, pa3); partialSM(pA0, pA1, m_reg, alA, false);
    SWRITE(bp, SO);
    RESC(alA);
    bc = bp;
  }
  { const int bp = bc == 0 ? 2 : bc - 1;
    __syncthreads();
    SBAR(); qkt(pB0, pB1, K_lds + bc * SHM_K, qr, r32, hi, -m_reg);
    finishSM(pA0, pA1, alA, l_reg, pa0, pa1, pa2, pa3); SBAR();
    pv_d0(o, vb0 + bp * SHM_V, pa0, pa1, pa2, pa3); partialSM(pB0, pB1, m_reg, alB, false);
    RESC(alB);
    finishSM(pB0, pB1, alB, l_reg, pa0, pa1, pa2, pa3); SBAR();
    pv_d0(o, vb0 + bc * SHM_V, pa0, pa1, pa2, pa3); }
  if (hi == 0) li_l[r32] = l_reg; asm volatile("s_waitcnt lgkmcnt(0)" ::: "memory");
  float rli[16];
#pragma unroll
  for (int r = 0; r < 16; ++r) rli[r] = __builtin_amdgcn_rcpf(li_l[crow(r, hi)]);
  bf16_t* Ow = Qrows + (size_t)(wid * 32) * 1536 + h * 64;
  if (!dry)
#pragma unroll
  for (int r = 0; r < 16; ++r) { int orow = crow(r, hi);
#pragma unroll
    for (int d0 = 0; d0 < 2; ++d0) Ow[(size_t)orow * 1536 + d0 * 32 + r32] = f2bf(o[d0][r] * rli[r]); }
#undef SLOAD
#undef SWRITE
#undef RESC
}

__device__ __forceinline__ void attn_phase(KP p, int dry) {
  bf16_t* Q = (bf16_t*)(p->ws + WS_Q); const bf16_t* KV = (const bf16_t*)(p->ws + WS_KV); const bf16_t* KP = (const bf16_t*)(p->ws + WS_KPE);
  const float* ropetab = (const float*)(p->ws + WS_ROPE);
  const int xcd = bid_() & 7, slot = bid_() >> 3;
  const int G = gdim_();
  const int nit = G == 256 ? 6 : (1536 + G - 1) / G;
  for (int i = 0; i < nit; ++i) {
    int u;
    if (G == 256) u = i < 4 ? ((i * 16 + xcd * 2 + (slot >> 4)) << 4) + (slot & 15) : 1024 + (i - 4) * 256 + xcd * 32 + slot;
    else { u = bid_() + i * G; if (u >= 1536) break; }
    const bool samp = u < 1024;
    const int pair = samp ? u >> 4 : u - 1024, qb = samp ? u & 15 : 0, b = pair >> 4, h = pair & 15;
    const size_t qrow = samp ? (size_t)(MP + b * DSEQ + qb * 256) : (size_t)(b * SEQ);
    const size_t krow = samp ? (size_t)(MP + b * SKEYS) : (size_t)(b * SEQ);
    attn_unit(Q + qrow * 1536, h, KV + krow * 2048, KP + krow * 32, samp ? SKEYS : SEQ, samp, qb * 256, ropetab, dry);
  }
}

__device__ void mod_gemv_item(KP p, int it) {
  float* lds = (float*)dyn_shm;
  const int l = it / 96, n0 = (it % 96) * 64, tid = tid_();
  const float* wmod = p->in[l == 0 ? 7 : 24]; const float* bmod = p->in[l == 0 ? 8 : 25];
  __syncthreads();
  for (int e = tid; e < 5 * 1024; e += 512) { int c = e >> 10, k = e & 1023; float v = c == 0 ? p->in[6][k] : p->in[5][(c - 1) * 1024 + k]; lds[e] = v / (1.f + __expf(-v)); }
  __syncthreads();
  const int col = tid & 63, ks = tid >> 6;
  float a0 = 0, a1 = 0, a2 = 0, a3 = 0, a4 = 0;
  const float* wp = wmod + (size_t)(ks * 128) * 6144 + n0 + col;
#pragma unroll 8
  for (int k = 0; k < 128; ++k) { float w = wp[(size_t)k * 6144]; int kk = ks * 128 + k;
    a0 += lds[kk] * w; a1 += lds[1024 + kk] * w; a2 += lds[2048 + kk] * w; a3 += lds[3072 + kk] * w; a4 += lds[4096 + kk] * w; }
  float* red = lds + 5 * 1024;
  red[(ks * 5 + 0) * 64 + col] = a0; red[(ks * 5 + 1) * 64 + col] = a1; red[(ks * 5 + 2) * 64 + col] = a2; red[(ks * 5 + 3) * 64 + col] = a3; red[(ks * 5 + 4) * 64 + col] = a4;
  __syncthreads();
  if (tid < 320) { int c = tid >> 6, cc = tid & 63; float s = 0;
#pragma unroll
    for (int k8 = 0; k8 < 8; ++k8) s += red[(k8 * 5 + c) * 64 + cc];
    ((float*)(p->ws + WS_MOD))[(l * 5 + c) * 6144 + n0 + cc] = s + bmod[n0 + cc]; }
}

struct CvtMat { const float* src; int K, N, Npad; bf16_t* dst; int ldk, perm; };
__device__ __forceinline__ CvtMat get_mat(KP p, int layer, int i) {
  bf16_t* WB = (bf16_t*)(p->ws + WS_WB);
  if (layer == 0) {
    switch (i) {
      case 0: return CvtMat{p->in[11], 1024, 1536, 1536, WB + W0_IN, 1024, 0};
      case 1: return CvtMat{p->in[21], 1024, 1024, 1024, WB + W0_OUT, 1024, 0};
      case 2: return CvtMat{p->in[22], 1024, 4096, 4096, WB + W0_W1, 1024, 0};
      default: return CvtMat{p->in[23], 4096, 1024, 1024, WB + W0_W2, 4096, 0};
    }
  } else {
    switch (i) {
      case 0: return CvtMat{p->in[28], 1024, 672, 768, WB + W1_IN, 1024, 0};
      case 1: return CvtMat{p->in[30], 384, 1536, 1536, WB + W1_QB, 384, 1};
      case 2: return CvtMat{p->in[32], 256, 2048, 2048, WB + W1_KVB, 256, 0};
      case 3: return CvtMat{p->in[33], 1024, 1024, 1024, WB + W1_OUT, 1024, 0};
      case 4: return CvtMat{p->in[34], 1024, 4096, 4096, WB + W1_W1, 1024, 0};
      default: return CvtMat{p->in[35], 4096, 1024, 1024, WB + W1_W2, 4096, 0};
    }
  }
}
struct CvtTile { const float* src; int K, N; bf16_t* dst; int ldk, perm, k0, n0; float wsc; };
__device__ __forceinline__ CvtTile cvt_desc(KP p, int layer, int t, int total) {
  bf16_t* WB = (bf16_t*)(p->ws + WS_WB);
  const int nm = layer == 0 ? 4 : 6;
  if (t < total) {
    int tt = t, i = 0;
    for (; i < nm - 1; ++i) { CvtMat m = get_mat(p, layer, i); int c = (m.K / 64) * (m.Npad / 64); if (tt < c) break; tt -= c; }
    const CvtMat m = get_mat(p, layer, i);
    const int nn = m.Npad / 64;
    return CvtTile{m.src, m.K, m.N, m.dst, m.ldk, m.perm, (tt / nn) * 64, (tt % nn) * 64, m.perm ? ATT_SCALE * 1.4426950408889634f : 1.f};
  }
  const int e = t - total;
  if (e < 32) {
    const int dg = e >> 3, nb = e & 7, dir = dg >> 1, gate = dg & 1;
    return CvtTile{p->in[gate == 0 ? 14 : 16] + (size_t)(dir * 8 + nb) * 4096, 64, 64, WB + W0_G + (size_t)e * 4096, 64, 0, 0, 0, -1.4426950408889634f};
  }
  const int e2 = e - 32, gi = e2 >> 2, q = e2 & 3;
  return CvtTile{p->in[19] + (size_t)gi * 16384, 128, 128, WB + W0_P + (size_t)gi * 16384, 128, 0, (q >> 1) * 64, (q & 1) * 64, 1.f};
}
__device__ __forceinline__ void cvt_load(const CvtTile& d, int tid, f32x4& v0, f32x4& v1) {
  const int kk = tid >> 4, n4 = (tid & 15) * 4;
  const f32x4 zero = {0.f, 0.f, 0.f, 0.f};
  const bool ok = d.n0 + n4 < d.N;
  const float* sp = d.src + (size_t)(d.k0 + kk) * d.N + d.n0 + (ok ? n4 : 0);
  v0 = ok ? *(const f32x4*)sp : zero;
  v1 = ok ? *(const f32x4*)(sp + (size_t)32 * d.N) : zero;
}
__device__ void cvt_weights(KP p, int layer, int start, int stride) {
  float* tile = (float*)dyn_shm;
  const int total = layer == 0 ? 384 + 256 + 1024 + 1024 : 192 + 144 + 128 + 256 + 1024 + 1024;
  const int all = total + (layer == 0 ? 32 + 16 : 0);
  const int tid = tid_();
  int t = start;
  if (t >= all) return;
  CvtTile d = cvt_desc(p, layer, t, total);
  f32x4 v0, v1; cvt_load(d, tid, v0, v1);
  for (;;) {
    const int kk = tid >> 4, n4 = (tid & 15) * 4;
    __syncthreads();
    tile[kk * 65 + n4 + 0] = v0[0]; tile[kk * 65 + n4 + 1] = v0[1]; tile[kk * 65 + n4 + 2] = v0[2]; tile[kk * 65 + n4 + 3] = v0[3];
    tile[(kk + 32) * 65 + n4 + 0] = v1[0]; tile[(kk + 32) * 65 + n4 + 1] = v1[1]; tile[(kk + 32) * 65 + n4 + 2] = v1[2]; tile[(kk + 32) * 65 + n4 + 3] = v1[3];
    __syncthreads();
    const int tn = t + stride; const bool more = tn < all;
    CvtTile dn = d;
    if (more) { dn = cvt_desc(p, layer, tn, total); cvt_load(dn, tid, v0, v1); }
    {
      int n = tid >> 3, k8 = (tid & 7) * 8, ng = d.n0 + n;
      if (d.perm) { int hh = ng / 96, dd = ng % 96; ng = dd < 64 ? hh * 64 + dd : 1024 + hh * 32 + (dd - 64); }
      float v[8];
#pragma unroll
      for (int j = 0; j < 8; ++j) v[j] = tile[(k8 + j) * 65 + n];
      const float wsc = d.wsc;
      u32x4 w = {cvtpk(v[0] * wsc, v[1] * wsc), cvtpk(v[2] * wsc, v[3] * wsc), cvtpk(v[4] * wsc, v[5] * wsc), cvtpk(v[6] * wsc, v[7] * wsc)};
      *(u32x4*)(d.dst + (size_t)ng * d.ldk + d.k0 + k8) = w;
    }
    if (!more) break;
    t = tn; d = dn;
  }
}

__device__ __forceinline__ void mod_row_store(bf16_t* H, int row, int lane, const f32x4 (&x)[4], const f32x4 (&gv)[4], float ss, const float* modl, int chunk_shift) {
  const float rstd = rsqrtf(ss * (1.f / DM) + EPS);
  const float* mc = modl + cond_of_row(row) * 6144 + chunk_shift * 1024;
#pragma unroll
  for (int i = 0; i < 4; ++i) {
    const int col = (i * 64 + lane) * 4;
    f32x4 sh = *(const f32x4*)(mc + col), sc = *(const f32x4*)(mc + 1024 + col);
    f32x4 y = x[i] * rstd * gv[i] * (sc + 1.f) + sh;
    u32x2 w; w.x = cvtpk(y[0], y[1]); w.y = cvtpk(y[2], y[3]);
    *(u32x2*)(H + (size_t)row * DM + col) = w;
  }
}
__device__ void modulate_phase(KP p, const float* src0, const float* src1, const float* g, const float* modl, int chunk_shift) {
  bf16_t* H = (bf16_t*)(p->ws + WS_H);
  const int tid = tid_(); const int wid = tid >> 6, lane = tid & 63;
  f32x4 gv[4];
#pragma unroll
  for (int i = 0; i < 4; ++i) gv[i] = *(const f32x4*)(g + (i * 64 + lane) * 4);
  const int stride = gdim_() * 8;
  for (int row = bid_() * 8 + wid; row < M; row += 2 * stride) {
    const int row2 = row + stride; const bool v2 = row2 < M; const int r2 = v2 ? row2 : row;
    const float* xp = row < MP ? src0 + (size_t)row * DM : src1 + (size_t)(row - MP) * DM;
    const float* xq = r2 < MP ? src0 + (size_t)r2 * DM : src1 + (size_t)(r2 - MP) * DM;
    f32x4 x[4], z[4]; float ss = 0, s2 = 0;
#pragma unroll
    for (int i = 0; i < 4; ++i) { x[i] = *(const f32x4*)(xp + (i * 64 + lane) * 4); z[i] = *(const f32x4*)(xq + (i * 64 + lane) * 4); }
#pragma unroll
    for (int i = 0; i < 4; ++i) { ss += x[i][0] * x[i][0] + x[i][1] * x[i][1] + x[i][2] * x[i][2] + x[i][3] * x[i][3]; s2 += z[i][0] * z[i][0] + z[i][1] * z[i][1] + z[i][2] * z[i][2] + z[i][3] * z[i][3]; }
    ss = wave_sum(ss, lane); s2 = wave_sum(s2, lane);
    mod_row_store(H, row, lane, x, gv, ss, modl, chunk_shift);
    if (v2) mod_row_store(H, row2, lane, z, gv, s2, modl, chunk_shift);
  }
}
__device__ void final_norm_phase(KP p, int dry) {
  float* X = p->out; const float* g = p->in[36];
  const int tid = tid_(); const int wid = tid >> 6, lane = tid & 63;
  f32x4 gv[4];
#pragma unroll
  for (int i = 0; i < 4; ++i) gv[i] = *(const f32x4*)(g + (i * 64 + lane) * 4);
  const int stride = gdim_() * 8;
  for (int row = bid_() * 8 + wid; row < M; row += 2 * stride) {
    const int row2 = row + stride; const bool v2 = row2 < M; const int r2 = v2 ? row2 : row;
    float* xp = X + (size_t)row * DM; float* xq = X + (size_t)r2 * DM;
    f32x4 x[4], z[4]; float ss = 0, s2 = 0;
#pragma unroll
    for (int i = 0; i < 4; ++i) { x[i] = *(const f32x4*)(xp + (i * 64 + lane) * 4); z[i] = *(const f32x4*)(xq + (i * 64 + lane) * 4); }
#pragma unroll
    for (int i = 0; i < 4; ++i) { ss += x[i][0] * x[i][0] + x[i][1] * x[i][1] + x[i][2] * x[i][2] + x[i][3] * x[i][3]; s2 += z[i][0] * z[i][0] + z[i][1] * z[i][1] + z[i][2] * z[i][2] + z[i][3] * z[i][3]; }
    ss = wave_sum(ss, lane); s2 = wave_sum(s2, lane);
    const float rstd = rsqrtf(ss * (1.f / DM) + EPS), rstd2 = rsqrtf(s2 * (1.f / DM) + EPS);
    if (!dry) {
#pragma unroll
      for (int i = 0; i < 4; ++i) *(f32x4*)(xp + (i * 64 + lane) * 4) = x[i] * rstd * gv[i];
      if (v2) {
#pragma unroll
        for (int i = 0; i < 4; ++i) *(f32x4*)(xq + (i * 64 + lane) * 4) = z[i] * rstd2 * gv[i];
      }
    }
  }
}
struct L1Row { f32x4 qa, qb, kv; float kp; };
__device__ __forceinline__ f32x4 bf4_to_f32(u32x2 w) {
  return (f32x4){__uint_as_float(w.x << 16), __uint_as_float(w.x & 0xffff0000u), __uint_as_float(w.y << 16), __uint_as_float(w.y & 0xffff0000u)};
}
__device__ __forceinline__ void l1_row_load(const bf16_t* Z1, int row, int lane, L1Row& r) {
  const bf16_t* z = Z1 + (size_t)row * 768;
  const u32x2 zero = {0u, 0u};
  r.qa = bf4_to_f32(lane < 48 ? *(const u32x2*)(z + lane * 4) : zero);
  r.qb = bf4_to_f32(lane < 48 ? *(const u32x2*)(z + 192 + lane * 4) : zero);
  r.kv = bf4_to_f32(*(const u32x2*)(z + 384 + lane * 4));
  r.kp = lane < 32 ? bf2f(z[640 + lane]) : 0.f;
}
__device__ __forceinline__ void l1_row_finish(KP p, int row, int lane, const L1Row& r, const f32x4& gqa, const f32x4& gqb, const f32x4& gk) {
  bf16_t* CQN = (bf16_t*)(p->ws + WS_CQN); bf16_t* CKVN = (bf16_t*)(p->ws + WS_CKVN); bf16_t* KPE = (bf16_t*)(p->ws + WS_KPE);
  const float* ropetab = (const float*)(p->ws + WS_ROPE);
  float ss = r.qa[0] * r.qa[0] + r.qa[1] * r.qa[1] + r.qa[2] * r.qa[2] + r.qa[3] * r.qa[3] + r.qb[0] * r.qb[0] + r.qb[1] * r.qb[1] + r.qb[2] * r.qb[2] + r.qb[3] * r.qb[3];
  ss = wave_sum(ss, lane);
  const float rstd = rsqrtf(ss * (1.f / 384) + EPS);
  if (lane < 48) {
    const f32x4 ya = r.qa * rstd * gqa, yb = r.qb * rstd * gqb;
    u32x2 wa; wa.x = cvtpk(ya[0], ya[1]); wa.y = cvtpk(ya[2], ya[3]);
    u32x2 wb; wb.x = cvtpk(yb[0], yb[1]); wb.y = cvtpk(yb[2], yb[3]);
    *(u32x2*)(CQN + (size_t)row * 384 + lane * 4) = wa; *(u32x2*)(CQN + (size_t)row * 384 + 192 + lane * 4) = wb;
  }
  const float s2 = wave_sum(r.kv[0] * r.kv[0] + r.kv[1] * r.kv[1] + r.kv[2] * r.kv[2] + r.kv[3] * r.kv[3], lane);
  const float r2 = rsqrtf(s2 * (1.f / 256) + EPS);
  const f32x4 y = r.kv * r2 * gk;
  int krow; bool rope; int s = 0;
  if (row < MP) { krow = row; rope = false; *(f32x4*)(p->out + O_CKV + (size_t)row * 256 + lane * 4) = y; }
  else { int b = (row - MP) >> 12; s = (row - MP) & 4095; krow = MP + b * SKEYS + s; rope = true; }
  u32x2 w; w.x = cvtpk(y[0], y[1]); w.y = cvtpk(y[2], y[3]);
  *(u32x2*)(CKVN + (size_t)krow * 256 + lane * 4) = w;
  const float kp = r.kp;
  const float partner = lane_xor(kp, lane, 8);
  if (!rope) { if (lane < 32) { p->out[O_KPE + (size_t)row * 32 + lane] = kp; KPE[(size_t)krow * 32 + lane] = f2bf(kp); } }
  else if (lane < 32) {
    int pos = lane < 16 ? (s >> 6) : (s & 63); int j = lane & 7;
    float cs = ropetab[pos * 16 + 2 * j], sn = ropetab[pos * 16 + 2 * j + 1];
    float ov = (lane & 8) == 0 ? kp * cs - partner * sn : kp * cs + partner * sn;
    KPE[(size_t)krow * 32 + lane] = f2bf(ov);
  }
}
__device__ void l1_rows_phase(KP p) {
  const bf16_t* Z1 = (const bf16_t*)(p->ws + WS_Z1);
  bf16_t* CKVN = (bf16_t*)(p->ws + WS_CKVN); bf16_t* KPE = (bf16_t*)(p->ws + WS_KPE);
  const int tid = tid_(); const int wid = tid >> 6, lane = tid & 63;
  const int l48 = lane < 48 ? lane : 0;
  const f32x4 gqa = *(const f32x4*)(p->in[29] + l48 * 4), gqb = *(const f32x4*)(p->in[29] + 192 + l48 * 4), gk = *(const f32x4*)(p->in[31] + lane * 4);
  const int stride = gdim_() * 8;
  for (int row = bid_() * 8 + wid; row < M; row += 2 * stride) {
    const int row2 = row + stride; const bool v2 = row2 < M;
    L1Row ra, rb;
    l1_row_load(Z1, row, lane, ra); l1_row_load(Z1, v2 ? row2 : row, lane, rb);
    l1_row_finish(p, row, lane, ra, gqa, gqb, gk);
    if (v2) l1_row_finish(p, row2, lane, rb, gqa, gqb, gk);
  }
  for (int idx = bid_() * 8 + wid; idx < NB_S * PAST; idx += stride) {
    const int b = idx >> 9, j = idx & 511, krow = MP + b * SKEYS + DSEQ + j;
    f32x4 kv = *(const f32x4*)(p->in[3] + ((size_t)(b * PAST + j)) * 256 + lane * 4);
    u32x2 w; w.x = cvtpk(kv[0], kv[1]); w.y = cvtpk(kv[2], kv[3]);
    *(u32x2*)(CKVN + (size_t)krow * 256 + lane * 4) = w;
    if (lane < 32) KPE[(size_t)krow * 32 + lane] = f2bf(p->in[4][((size_t)(b * PAST + j)) * 32 + lane]);
  }
}

__device__ __forceinline__ float fast_sigmoid(float x) { return __builtin_amdgcn_rcpf(1.f + __expf(-x)); }
__device__ __forceinline__ float fast_gelu(float x) {
  float u = 0.7978845608028654f * (x + 0.044715f * x * x * x);
  float e = __expf(2.f * u);
  float th = 1.f - 2.f * __builtin_amdgcn_rcpf(e + 1.f);
  return 0.5f * x * (1.f + th);
}
__device__ __forceinline__ float bperm(int srclane, float v) { return __int_as_float(__builtin_amdgcn_ds_bpermute(srclane << 2, __float_as_int(v))); }
__device__ __forceinline__ void scan4(float& P, float& H, int lane, int stepl, int oq) {
  { const float Pp = bperm(lane - stepl, P), Hp = bperm(lane - stepl, H); if (oq >= 1) { H = P * Hp + H; P = Pp * P; } }
  { const float Pp = bperm(lane - 2 * stepl, P), Hp = bperm(lane - 2 * stepl, H); if (oq >= 2) { H = P * Hp + H; P = Pp * P; } }
}
__device__ void lru_item(KP p, int cidx, int nb, int mode) {
  const bf16_t* Z0 = (const bf16_t*)(p->ws + WS_Z0); bf16_t* H = (bf16_t*)(p->ws + WS_H);
  const bf16_t* Wg = (const bf16_t*)(p->ws + WS_WB) + W0_G;
  const float* LS8 = (const float*)(p->ws + WS_LS8);
  float2* SUM = (float2*)(p->ws + WS_SUM);
  float* xrL = (float*)dyn_shm;
  float* xc = xrL + 67 * 64;
  bf16_t* xcb = (bf16_t*)(xc + 64 * 64);
  float* Hs = (float*)(xcb + 64 * 72);
  const int tid = tid_(), lane = tid & 63, fr = lane & 15, fq = lane >> 4;
  const int wid = __builtin_amdgcn_readfirstlane(tid >> 6), dir = wid >> 2, wq = wid & 3;
  const int t0 = cidx * 64;
  int s0, s1, bsamp = -1;
  if (t0 < MP) { s0 = (t0 / SEQ) * SEQ; s1 = s0 + SEQ; } else { bsamp = (t0 - MP) / DSEQ; s0 = MP + bsamp * DSEQ; s1 = s0 + DSEQ; }
  const int c0 = s0 / 64, c1 = s1 / 64;
  const int chc = tid & 63, cgc = nb * 64 + chc;
  const int ch = wq * 16 + fr, cg_ = nb * 64 + ch;
  const int oq = dir ? 3 - fq : fq, stepl = dir ? -16 : 16, lastl = fr + (dir ? 0 : 48);
  unsigned xv[5];
#pragma unroll
  for (int i = 0; i < 5; ++i) { int e = tid + i * 512; int r = e >> 5, c2 = (e & 31) * 2, t = t0 - 2 + r;
    xv[i] = (e < 67 * 32 && t >= s0 && t < s1) ? *(const unsigned*)(Z0 + (size_t)t * 1536 + nb * 64 + c2) : 0u; }
  const float* cw = p->in[12];
  const float w0 = cw[cgc], w1 = cw[512 + cgc], w2 = cw[1024 + cgc], w3 = cw[1536 + cgc], bb = p->in[13][cgc];
  const float ba = -1.4426950408889634f * p->in[15][dir * 512 + cg_], bi = -1.4426950408889634f * p->in[17][dir * 512 + cg_], l8 = LS8[dir * 512 + cg_];
  bf16x8 wa[2], wi[2];
  { const bf16_t* pa = Wg + (size_t)((dir * 2 + 0) * 8 + nb) * 4096 + (size_t)ch * 64 + fq * 8; const bf16_t* pi = pa + 8 * 4096;
    wa[0] = *(const bf16x8*)pa; wa[1] = *(const bf16x8*)(pa + 32); wi[0] = *(const bf16x8*)pi; wi[1] = *(const bf16x8*)(pi + 32); }
  unsigned gz[4] = {0u, 0u, 0u, 0u};
  if (mode == 1) {
#pragma unroll
    for (int i = 0; i < 4; ++i) { int e = tid + i * 512; int t = e >> 5, c2 = (e & 31) * 2; gz[i] = *(const unsigned*)(Z0 + (size_t)(t0 + t) * 1536 + 512 + nb * 64 + c2); }
  }
  float cP = 1.f, cH = 0.f;
  if (mode == 1) {
    int lo, hi;
    if (dir == 0) { const int n = cidx - c0, q = (n + 3) >> 2; lo = c0 + fq * q; hi = lo + q < cidx ? lo + q : cidx;
      for (int c = lo; c < hi; c += 4) { float2 sm[4];
#pragma unroll
        for (int j = 0; j < 4; ++j) sm[j] = (c + j < hi) ? SUM[((size_t)(c + j) * 2) * 512 + cg_] : make_float2(1.f, 0.f);
#pragma unroll
        for (int j = 0; j < 4; ++j) { cH = sm[j].x * cH + sm[j].y; cP *= sm[j].x; } }
    } else { const int n = c1 - 1 - cidx, q = (n + 3) >> 2; hi = c1 - 1 - fq * q; lo = hi - q > cidx ? hi - q : cidx;
      for (int c = hi; c > lo; c -= 4) { float2 sm[4];
#pragma unroll
        for (int j = 0; j < 4; ++j) sm[j] = (c - j > lo) ? SUM[((size_t)(c - j) * 2 + 1) * 512 + cg_] : make_float2(1.f, 0.f);
#pragma unroll
        for (int j = 0; j < 4; ++j) { cH = sm[j].x * cH + sm[j].y; cP *= sm[j].x; } }
    }
  }
  __syncthreads();
#pragma unroll
  for (int i = 0; i < 5; ++i) { int e = tid + i * 512; if (e < 67 * 32) { int r = e >> 5, c2 = (e & 31) * 2;
    xrL[r * 64 + c2] = bf2f((bf16_t)(xv[i] & 0xffff)); xrL[r * 64 + c2 + 1] = bf2f((bf16_t)(xv[i] >> 16)); } }
  __syncthreads();
#pragma unroll
  for (int i = 0; i < 8; ++i) { int t = (tid >> 6) + 8 * i;
    float v = bb + w0 * xrL[t * 64 + chc] + w1 * xrL[(t + 1) * 64 + chc] + w2 * xrL[(t + 2) * 64 + chc] + w3 * xrL[(t + 3) * 64 + chc];
    xc[t * 64 + chc] = v; xcb[t * 72 + chc] = f2bf(v); }
  __syncthreads();
  float av[4][4], uv[4][4], Pt[4], Ht[4], Pe[4], He[4];
#pragma unroll
  for (int mt = 0; mt < 4; ++mt) {
    const bf16x8 a0 = *(const bf16x8*)(xcb + (mt * 16 + fr) * 72 + fq * 8), a1 = *(const bf16x8*)(xcb + (mt * 16 + fr) * 72 + 32 + fq * 8);
    f32x4 ga = {0.f, 0.f, 0.f, 0.f}, gi = {0.f, 0.f, 0.f, 0.f};
    ga = __builtin_amdgcn_mfma_f32_16x16x32_bf16(a0, wa[0], ga, 0, 0, 0); ga = __builtin_amdgcn_mfma_f32_16x16x32_bf16(a1, wa[1], ga, 0, 0, 0);
    gi = __builtin_amdgcn_mfma_f32_16x16x32_bf16(a0, wi[0], gi, 0, 0, 0); gi = __builtin_amdgcn_mfma_f32_16x16x32_bf16(a1, wi[1], gi, 0, 0, 0);
#pragma unroll
    for (int j = 0; j < 4; ++j) {
      const float ea = 1.f + __builtin_amdgcn_exp2f(fminf(ga[j] + ba, 57.f)), ei = 1.f + __builtin_amdgcn_exp2f(fminf(gi[j] + bi, 57.f));
      const float rc = __builtin_amdgcn_rcpf(ea * ei);
      const float r = rc * ei, ii = rc * ea;
      const float l2 = r * l8;
      const float a = __builtin_amdgcn_exp2f(l2);
      const float x2 = l2 * (2.f * 0.6931471805599453f);
      const float ser = -x2 * fmaf(x2, fmaf(x2, fmaf(x2, fmaf(x2, fmaf(x2, 1.f / 720.f, 1.f / 120.f), 1.f / 24.f), 1.f / 6.f), 0.5f), 1.f);
      const float om = x2 > -0.25f ? ser : 1.f - a * a;
      av[mt][j] = a; uv[mt][j] = __builtin_amdgcn_sqrtf(om) * ii * xc[(mt * 16 + fq * 4 + j) * 64 + ch];
    }
    float P = 1.f, Hh = 0.f;
    if (dir == 0) {
#pragma unroll
      for (int j = 0; j < 4; ++j) { Hh = av[mt][j] * Hh + uv[mt][j]; P *= av[mt][j]; }
    } else {
#pragma unroll
      for (int j = 3; j >= 0; --j) { Hh = av[mt][j] * Hh + uv[mt][j]; P *= av[mt][j]; }
    }
    scan4(P, Hh, lane, stepl, oq);
    const float Pp = bperm(lane - stepl, P), Hp = bperm(lane - stepl, Hh);
    Pe[mt] = oq >= 1 ? Pp : 1.f; He[mt] = oq >= 1 ? Hp : 0.f;
    Pt[mt] = bperm(lastl, P); Ht[mt] = bperm(lastl, Hh);
  }
  if (mode == 0) {
    float P = 1.f, Hh = 0.f;
    if (dir == 0) {
#pragma unroll
      for (int mt = 0; mt < 4; ++mt) { Hh = Pt[mt] * Hh + Ht[mt]; P *= Pt[mt]; }
    } else {
#pragma unroll
      for (int mt = 3; mt >= 0; --mt) { Hh = Pt[mt] * Hh + Ht[mt]; P *= Pt[mt]; }
    }
    if (fq == 0) SUM[((size_t)cidx * 2 + dir) * 512 + cg_] = make_float2(P, Hh);
    return;
  }
  scan4(cP, cH, lane, 16, fq);
  const float tP = bperm(fr + 48, cP), tH = bperm(fr + 48, cH);
  float c = bsamp >= 0 ? p->in[2][(bsamp * 2 + dir) * 512 + cg_] : 0.f;
  c = tP * c + tH;
  float* hp = Hs + dir * 4096 + ch;
  if (dir == 0) {
#pragma unroll
    for (int mt = 0; mt < 4; ++mt) { float s = Pe[mt] * c + He[mt];
#pragma unroll
      for (int j = 0; j < 4; ++j) { s = av[mt][j] * s + uv[mt][j]; hp[(mt * 16 + fq * 4 + j) * 64] = s; }
      c = Pt[mt] * c + Ht[mt]; }
    if (bsamp < 0 && cidx == c1 - 1 && fq == 0) p->out[O_LRU + (size_t)((t0 / SEQ) * 2 + 0) * 512 + cg_] = c;
  } else {
#pragma unroll
    for (int mt = 3; mt >= 0; --mt) { float s = Pe[mt] * c + He[mt];
#pragma unroll
      for (int j = 3; j >= 0; --j) { s = av[mt][j] * s + uv[mt][j]; hp[(mt * 16 + fq * 4 + j) * 64] = s; }
      c = Pt[mt] * c + Ht[mt]; }
    if (bsamp < 0 && cidx == c0 && fq == 0) p->out[O_LRU + (size_t)((t0 / SEQ) * 2 + 1) * 512 + cg_] = c;
  }
  __syncthreads();
#pragma unroll
  for (int i = 0; i < 4; ++i) { int e = tid + i * 512; int t = e >> 5, c2 = (e & 31) * 2;
    float g0 = bf2f((bf16_t)(gz[i] & 0xffff)), g1 = bf2f((bf16_t)(gz[i] >> 16));
    float y0 = (Hs[t * 64 + c2] + Hs[4096 + t * 64 + c2]) * fast_gelu(g0);
    float y1 = (Hs[t * 64 + c2 + 1] + Hs[4096 + t * 64 + c2 + 1]) * fast_gelu(g1);
    *(unsigned*)(H + (size_t)(t0 + t) * DM + nb * 64 + c2) = cvtpk(y0, y1); }
}

__device__ void pool_item(KP p, int cidx, int gi) {
  const bf16_t* Z0 = (const bf16_t*)(p->ws + WS_Z0); bf16_t* H = (bf16_t*)(p->ws + WS_H);
  const bf16_t* Wp = (const bf16_t*)(p->ws + WS_WB) + W0_P + (size_t)gi * 16384;
  float* xp = (float*)dyn_shm;
  bf16_t* dL = (bf16_t*)(xp + 80 * 128);
  const int tid = tid_(), wid = tid >> 6, lane = tid & 63, fr = lane & 15, fq = lane >> 4;
  const int t0 = cidx * 64;
  int s0, s1;
  if (t0 < MP) { s0 = (t0 / SEQ) * SEQ; s1 = s0 + SEQ; } else { int b = (t0 - MP) / DSEQ; s0 = MP + b * DSEQ; s1 = s0 + DSEQ; }
  __syncthreads();
  for (int e = tid; e < 80 * 64; e += 512) { int r = e >> 6, c2 = (e & 63) * 2, t = t0 - 8 + r;
    float a = 0.f, b = 0.f;
    if (t >= s0 && t < s1) { unsigned v = *(const unsigned*)(Z0 + (size_t)t * 1536 + 1024 + gi * 128 + c2); a = bf2f((bf16_t)(v & 0xffff)); b = bf2f((bf16_t)(v >> 16)); }
    xp[r * 128 + c2] = a; xp[r * 128 + c2 + 1] = b; }
  __syncthreads();
  const int w = 2 << gi, left = w >> 1, right = w - 1 - left;
  {
    const int c = tid & 127, tq = tid >> 7, tb = tq * 16;
    float S = 0.f;
    for (int k = tb - left; k <= tb + right; ++k) S += xp[(k + 8) * 128 + c];
#pragma unroll
    for (int i = 0; i < 16; ++i) { const int t = tb + i, tg = t0 + t;
      const int lo = tg - left < s0 ? s0 : tg - left, hi = tg + right > s1 - 1 ? s1 - 1 : tg + right;
      const float d = S * __builtin_amdgcn_rcpf((float)(hi - lo + 1)) - xp[(t + 8) * 128 + c];
      dL[t * 136 + c] = f2bf(d);
      S += xp[(t + 1 + right + 8) * 128 + c] - xp[(t - left + 8) * 128 + c]; }
  }
  __syncthreads();
  {
    bf16x8 wf[4];
#pragma unroll
    for (int ks = 0; ks < 4; ++ks) wf[ks] = *(const bf16x8*)(Wp + (size_t)(wid * 16 + fr) * 128 + ks * 32 + fq * 8);
    const f32x4 sc = *(const f32x4*)(p->in[20] + gi * 128 + wid * 16 + fq * 4);
#pragma unroll
    for (int mt = 0; mt < 4; ++mt) {
      f32x4 acc = {0.f, 0.f, 0.f, 0.f};
#pragma unroll
      for (int ks = 0; ks < 4; ++ks) {
        bf16x8 df = *(const bf16x8*)(dL + (mt * 16 + fr) * 136 + ks * 32 + fq * 8);
        acc = __builtin_amdgcn_mfma_f32_16x16x32_bf16(wf[ks], df, acc, 0, 0, 0);
      }
      acc = acc * sc;
      u32x2 o; o.x = cvtpk(acc[0], acc[1]); o.y = cvtpk(acc[2], acc[3]);
      *(u32x2*)(H + (size_t)(t0 + mt * 16 + fr) * DM + 512 + gi * 128 + wid * 16 + fq * 4) = o;
    }
  }
}

__global__ void __launch_bounds__(512, 2) fwd_megakernel(Params kparams) {
  cg::grid_group grid = cg::this_grid();
  KP p = (KP)__builtin_amdgcn_kernarg_segment_ptr();
  unsigned char* ws = p->ws;
  bf16_t* WB = (bf16_t*)(ws + WS_WB);
  bf16_t* H = (bf16_t*)(ws + WS_H);
  float* X = p->out;
  const float* MOD = (const float*)(ws + WS_MOD);
  volatile LAS unsigned* xst = (volatile LAS unsigned*)(dyn_shm + LDS_MAIN);
  if (threadIdx.x == 0) { xst[0] = 0u; xst[1] = 0u; }
  __syncthreads();
  (void)xcd_barrier_post((unsigned*)(ws + WS_BAR), xst);
  int rep = 0;
  const int p_lo = p->p_lo, p_hi = p->p_hi, probe = p->pad, coop = p->coop;
  for (int ph = p_lo; ph < p_hi; ++ph) {
    asm volatile("" : "+s"(p));
    const int G = gdim_(), bid = bid_();
    unsigned char* ws = p->ws; bf16_t* WB = (bf16_t*)(ws + WS_WB); bf16_t* H = (bf16_t*)(ws + WS_H); float* X = p->out; const float* MOD = (const float*)(ws + WS_MOD);
#if PROBE_PH >= 0
    const int dry = (ph == probe && rep == 0) ? 1 : 0;
#else
    const int dry = 0;
#endif
    if (PROBE_PH == 99 && probe == 99 && ph == 1) { XcdBarrier xb; xb.bar = (unsigned*)(ws + WS_BAR); xb.st = (volatile LAS unsigned*)(dyn_shm + LDS_MAIN); for (int q = 0; q < 10; ++q) xcd_barrier(xb); }
    GemmDesc g1{nullptr, nullptr, 0, 0, 0, 0, 0, 0, nullptr, 0, nullptr, nullptr, nullptr, 0, 0};
    bool isg = false;
    const float* MODL = MOD + (ph >= 11 ? 5 * 6144 : 0);
    const bf16_t* U = (const bf16_t*)(ws + WS_U);
    switch (ph) {
      case 0: {
        for (int it = bid; it < 192; it += G) mod_gemv_item(p, it);
        if (bid == G - 1) { int t = tid_(); int pos = t >> 3, j = t & 7;
          float inv = exp2f(-(float)j * 0.125f * 13.287712379549449f);
          float s, c; my_sincos((float)pos * inv, s, c);
          float* rt = (float*)(ws + WS_ROPE); rt[t * 2] = c; rt[t * 2 + 1] = s; }
        if (bid == G - 2) { int t = tid_(); float* l8 = (float*)(ws + WS_LS8);
          for (int e = t; e < 1024; e += 512) l8[e] = -8.f * 1.4426950408889634f * log1pf(__expf(-p->in[18][e])); }
      } break;
      case 2: g1 = GemmDesc{H, WB + W0_IN, 1024, 1024, M, 1536, 1024, 0, ws + WS_Z0, 1536, nullptr, nullptr, nullptr, 0, 0}; isg = true; break;
      case 5: g1 = GemmDesc{H, WB + W0_OUT, 1024, 1024, M, 1024, 1024, 2, X, 1024, p->in[0], p->in[1], MOD + 2 * 1024, 0, 0}; isg = true; break;
      case 7: case 9: case 19: case 21: { int ro = (ph == 7 || ph == 19) ? 0 : MH;
        g1 = GemmDesc{H + (size_t)ro * DM, WB + (ph < 11 ? W0_W1 : W1_W1), 1024, 1024, MH, 4096, 1024, 1, ws + WS_U, 4096, nullptr, nullptr, nullptr, 0, 0}; isg = true; } break;
      case 8: case 10: case 20: case 22: { int ro = (ph == 8 || ph == 20) ? 0 : MH;
        g1 = GemmDesc{U, WB + (ph < 11 ? W0_W2 : W1_W2), 4096, 4096, MH, 1024, 4096, 2, X, 1024, X, X + (size_t)MP * DM, MODL + 5 * 1024, ro, 0}; isg = true; } break;
      case 12: g1 = GemmDesc{H, WB + W1_IN, 1024, 1024, M, 768, 1024, 0, ws + WS_Z1, 768, nullptr, nullptr, nullptr, 0, 0}; isg = true; break;
      case 13: l1_rows_phase(p); break;
      case 14: g1 = GemmDesc{(const bf16_t*)(ws + WS_CQN), WB + W1_QB, 384, 384, M, 1536, 384, 0, ws + WS_Q, 1536, nullptr, nullptr, nullptr, 0, 0}; isg = true; break;
      case 15: g1 = GemmDesc{(const bf16_t*)(ws + WS_CKVN), WB + W1_KVB, 256, 256, KROWS, 2048, 256, 0, ws + WS_KV, 2048, nullptr, nullptr, nullptr, 0, 0}; isg = true; break;
#ifndef NO_ATTN
      case 16: attn_phase(p, dry); break;
#endif
      case 17: g1 = GemmDesc{(const bf16_t*)(ws + WS_Q), WB + W1_OUT, 1536, 1024, M, 1024, 1024, 2, X, 1024, X, X + (size_t)MP * DM, MODL + 2 * 1024, 0, 0}; isg = true; break;
      case 23: final_norm_phase(p, dry); break;
      default: break;
    }
    if (ph == 1 || ph == 6 || ph == 11 || ph == 18) {
      const bool first = ph == 1;
      modulate_phase(p, first ? p->in[0] : X, first ? p->in[1] : X + (size_t)MP * DM, p->in[ph == 1 ? 9 : ph == 6 ? 10 : ph == 11 ? 26 : 27], MODL, (ph == 1 || ph == 11) ? 0 : 3);
    }
    if (ph == 0 || ph == 11) cvt_weights(p, ph == 0 ? 0 : 1, ph == 0 ? (bid + G - 192 % G) % G : bid, G);
#ifndef NO_LRU
    if (ph == 3 || ph == 4) {
      const int nit = ph == 3 ? 3072 + 1536 : 3072;
      for (int it = bid; it < nit; it += G) { if (it < 3072) lru_item(p, it >> 3, it & 7, ph - 3); else pool_item(p, (it - 3072) >> 2, (it - 3072) & 3); }
    }
#endif
#ifndef NO_GEMM
    g1.dry = (dry && g1.mode == 2 && ph != 5) ? 1 : 0;
    if (isg) gemm_phase(g1);
#endif
    if (coop && ph + 1 < p_hi && ph != 14) {
      if (ph == 0 && !dry) grid.sync(); else { XcdBarrier xb; xb.bar = (unsigned*)(ws + WS_BAR); xb.st = (volatile LAS unsigned*)(dyn_shm + LDS_MAIN); xcd_barrier(xb); } }
#if PROBE_PH >= 0
    if (dry) { rep = 1; --ph; }
#endif
  }
}

#ifndef MK_SPLIT
#define MK_SPLIT 0
#endif
extern "C" void kernel_launch(void* const* d_in, const int* in_sizes, int n_in, void* d_out, int out_size, void* d_ws, size_t ws_size, hipStream_t stream) {
  static int grid = 0;
  if (grid == 0) {
    if (n_in != 37 || ws_size < WS_END) { fprintf(stderr, "kernel_launch: bad n_in %d or ws %zu < %zu\n", n_in, ws_size, (size_t)WS_END); grid = -1; return; }
    int dev = 0, cus = 0, per_cu = 0;
    hipGetDevice(&dev); hipDeviceGetAttribute(&cus, hipDeviceAttributeMultiprocessorCount, dev);
    if (hipFuncSetAttribute((const void*)fwd_megakernel, hipFuncAttributeMaxDynamicSharedMemorySize, LDS_BYTES) != hipSuccess) { fprintf(stderr, "kernel_launch: hipFuncSetAttribute failed\n"); grid = -1; return; }
    if (hipOccupancyMaxActiveBlocksPerMultiprocessor(&per_cu, (const void*)fwd_megakernel, 512, LDS_BYTES) != hipSuccess || per_cu < 1) { fprintf(stderr, "kernel_launch: occupancy query gave %d\n", per_cu); grid = -1; return; }
    grid = cus;
  }
  if (grid < 0) return;
  if (hipMemsetAsync((char*)d_ws + WS_BAR, 0, XCD_BAR_WORDS * 4, stream) != hipSuccess) { fprintf(stderr, "kernel_launch: memset failed\n"); return; }
  Params p{};
  for (int i = 0; i < 37; ++i) p.in[i] = (const float*)d_in[i];
  p.out = (float*)d_out; p.ws = (unsigned char*)d_ws; p.pad = PROBE_PH;
#if MK_SPLIT
  for (int ph = 0; ph < NPH; ++ph) {
    p.p_lo = ph; p.p_hi = ph + 1; p.coop = 0;
    hipLaunchKernelGGL(fwd_megakernel, dim3(grid), dim3(512), LDS_BYTES, stream, p);
  }
#else
  p.p_lo = 0; p.p_hi = NPH; p.coop = 1;
  void* args[] = {&p};
  hipError_t e = hipLaunchCooperativeKernel((const void*)fwd_megakernel, dim3(grid), dim3(512), args, LDS_BYTES, stream);
  if (e != hipSuccess) fprintf(stderr, "cooperative launch failed: %s (grid %d)\n", hipGetErrorString(e), grid);
#endif
}
```

```cpp
#include <hip/hip_runtime.h>
#include <hip/hip_cooperative_groups.h>
#include <cstdio>
#include <cstdint>
namespace cg = cooperative_groups;
#ifndef PROBE_PH
#define PROBE_PH -1
#endif

typedef unsigned short bf16_t;
typedef short bf16x8 __attribute__((ext_vector_type(8)));
typedef short s16x4 __attribute__((ext_vector_type(4)));
typedef float f32x4 __attribute__((ext_vector_type(4)));
typedef float f32x16 __attribute__((ext_vector_type(16)));
typedef unsigned u32x4 __attribute__((ext_vector_type(4)));
typedef unsigned u32x2 __attribute__((ext_vector_type(2)));

constexpr int DM = 1024, MP = 8192, MS = 16384, M = MP + MS, DFF = 4096;
constexpr int SEQ = 256, DSEQ = 4096, PAST = 512, NB_S = 4;
constexpr int KROWS = MP + NB_S * (DSEQ + PAST);
constexpr int SKEYS = DSEQ + PAST;
constexpr int MH = M / 2;
constexpr float EPS = 1e-6f;
constexpr int NPH = 24;

constexpr size_t MiB = 1u << 20;
constexpr size_t WS_MOD = 0;
constexpr size_t WS_ROPE = 256 * 1024;
constexpr size_t WS_LS8 = 260 * 1024;
constexpr size_t WS_SUM = 512 * 1024;
constexpr size_t WS_BAR = 3840 * 1024;
constexpr size_t WS_WB = 4 * MiB;
constexpr size_t WS_R1 = 26 * MiB;
constexpr size_t WS_H = WS_R1;
constexpr size_t WS_Z0 = WS_R1 + 48 * MiB;
constexpr size_t WS_U = WS_R1 + 48 * MiB;
constexpr size_t WS_KV = WS_R1;
constexpr size_t WS_Q = WS_R1 + 104 * MiB;
constexpr size_t WS_Z1 = WS_R1 + 104 * MiB;
constexpr size_t WS_CQN = WS_R1 + 176 * MiB;
constexpr size_t WS_CKVN = WS_R1 + 194 * MiB;
constexpr size_t WS_KPE = WS_R1 + 207 * MiB;
constexpr size_t WS_END = WS_R1 + 209 * MiB;
constexpr size_t W0_IN = 0, W0_OUT = 1572864, W0_W1 = 2621440, W0_W2 = 6815744, W0_G = 11010048, W0_P = 11141120;
constexpr size_t W1_IN = 0, W1_QB = 786432, W1_KVB = 1376256, W1_OUT = 1900544, W1_W1 = 2949120, W1_W2 = 7143424;
constexpr size_t O_Y = 0, O_LRU = 25165824, O_CKV = 25198592, O_KPE = 27295744;

struct Params {
  const float* in[37];
  float* out;
  unsigned char* ws;
  int p_lo, p_hi, coop, pad;
};

typedef const __attribute__((address_space(4))) Params* KP;
extern __shared__ __attribute__((aligned(16))) unsigned char dyn_shm[];
constexpr int LDS_MAIN = 139264;
constexpr int LDS_BYTES = LDS_MAIN + 16;

__device__ __forceinline__ unsigned cvtpk(float lo, float hi) {
  unsigned r; asm volatile("v_cvt_pk_bf16_f32 %0, %1, %2" : "=v"(r) : "v"(lo), "v"(hi)); return r;
}
__device__ __forceinline__ float bf2f(bf16_t b) { return __uint_as_float(((unsigned)b) << 16); }
__device__ __forceinline__ bf16_t f2bf(float f) { return (bf16_t)(cvtpk(f, f) & 0xffffu); }
__device__ __forceinline__ float sigmoidf_(float x) { return 1.f / (1.f + __expf(-x)); }
__device__ __forceinline__ float gelu_tanh(float x) {
  float u = 0.7978845608028654f * (x + 0.044715f * x * x * x);
  float e = __expf(2.f * u);
  float th = 1.f - 2.f / (e + 1.f);
  return 0.5f * x * (1.f + th);
}
__device__ __forceinline__ float lane_xor(float v, int lane, int o) { return __int_as_float(__builtin_amdgcn_ds_bpermute((lane ^ o) << 2, __float_as_int(v))); }
__device__ __forceinline__ float wave_sum(float v, int lane) {
#pragma unroll
  for (int o = 32; o > 0; o >>= 1) v += lane_xor(v, lane, o);
  return v;
}
__device__ __forceinline__ void my_sincos(float a, float& s, float& c) {
  float k = rintf(a * 0.63661977236758134f);
  float r = fmaf(k, -1.5707962513e+00f, a);
  r = fmaf(k, -7.5497894159e-08f, r);
  r = fmaf(k, -5.3903029534e-15f, r);
  float r2 = r * r;
  float sp = r + r * r2 * (-1.6666667163e-01f + r2 * (8.3333337680e-03f + r2 * (-1.9841270114e-04f + r2 * 2.7557314297e-06f)));
  float cp = 1.f + r2 * (-0.5f + r2 * (4.1666667908e-02f + r2 * (-1.3888889225e-03f + r2 * 2.4801587642e-05f)));
  int q = ((int)k) & 3;
  float ss = (q & 1) ? cp : sp, cc = (q & 1) ? sp : cp;
  s = (q & 2) ? -ss : ss;
  c = ((q + 1) & 2) ? -cc : cc;
}
__device__ __forceinline__ int bid_() { int b = blockIdx.x; asm volatile("" : "+s"(b)); return b; }
__device__ __forceinline__ int gdim_() { int g = gridDim.x; asm volatile("" : "+s"(g)); return g; }
__device__ __forceinline__ int tid_() { int t = threadIdx.x; asm volatile("" : "+v"(t)); return t; }
__device__ __forceinline__ int cond_of_row(int row) { return row < MP ? 0 : 1 + ((row - MP) >> 12); }


#define XB_TMO      128
#define XB_XCNT(j)  (256  + 64 * (j))
#define XB_XSUB(j)  (1280 + 64 * (j))
#define XB_XGEN(j)  (2304 + 64 * (j))
#define XB_TOP      3328
#define XB_TOPGEN   3392
#define XCD_BAR_WORDS 3456
#define XB_SPIN_CAP (1u << 20)
#define LAS __attribute__((address_space(3)))
__device__ __forceinline__ unsigned xb_ld(unsigned* p)              { return __hip_atomic_load(p, __ATOMIC_RELAXED, __HIP_MEMORY_SCOPE_AGENT); }
__device__ __forceinline__ unsigned xb_add(unsigned* p, unsigned v) { return __hip_atomic_fetch_add(p, v, __ATOMIC_RELAXED, __HIP_MEMORY_SCOPE_AGENT); }
__device__ __forceinline__ unsigned xb_xcc_id() { return (unsigned)__builtin_amdgcn_s_getreg((3 << 11) | 20) & 0xFu; }
#define XB_SPIN(cond, bar) do { unsigned _sp = 0; while (cond) { __builtin_amdgcn_s_sleep(1); \
    if ((++_sp & 255u) == 0u) { if (xb_ld(&(bar)[XB_TMO])) break; if (_sp > XB_SPIN_CAP) { atomicAdd(&(bar)[XB_TMO], 1u); break; } } } } while (0)
struct XcdBarrier { unsigned* bar; volatile LAS unsigned* st; };
__device__ __forceinline__ XcdBarrier xcd_barrier_post(unsigned* bar, volatile LAS unsigned* st) {
  XcdBarrier b; b.bar = bar; b.st = st;
  if (threadIdx.x == 0) (void)xb_add(&bar[XB_XCNT(xb_xcc_id())], 1u);
  return b;
}
__device__ __forceinline__ void xcd_barrier_complete(unsigned* bar, unsigned x, unsigned& nloc, unsigned& nx) {
  const unsigned G = (unsigned)gdim_();
  unsigned sum, cnt, mine, sp = 0u;
  for (;;) {
    sum = 0u; cnt = 0u; mine = 0u;
#pragma unroll
    for (unsigned j = 0; j < 16; ++j) { const unsigned c = xb_ld(&bar[XB_XCNT(j)]); sum += c; cnt += (c > 0u) ? 1u : 0u; mine = (j == x) ? c : mine; }
    if (sum == G) break;
    __builtin_amdgcn_s_sleep(1);
    if ((++sp & 255u) == 0u) { if (xb_ld(&bar[XB_TMO])) break; if (sp > XB_SPIN_CAP) { atomicAdd(&bar[XB_TMO], 1u); break; } }
  }
  nloc = mine > 0u ? mine : 1u; nx = cnt > 0u ? cnt : 1u;
}
__device__ __forceinline__ void xcd_barrier(const XcdBarrier& b) {
  asm volatile("s_waitcnt vmcnt(0)" ::: "memory");
  __syncthreads();
  if (threadIdx.x == 0) {
    unsigned* bar = b.bar; unsigned bx = xb_xcc_id(); asm volatile("" : "+s"(bx));
    __builtin_amdgcn_s_waitcnt(0);
    unsigned nloc = b.st[0], nx = b.st[1];
    if (nloc == 0u) { xcd_barrier_complete(bar, bx, nloc, nx); b.st[0] = nloc; b.st[1] = nx; }
    const unsigned old = xb_add(&bar[XB_XSUB(bx)], 1u);
    const unsigned gen = old / nloc;
    if (old + 1u == (gen + 1u) * nloc) {
      __builtin_amdgcn_fence(__ATOMIC_RELEASE, "agent");
      asm volatile("s_waitcnt vmcnt(0)" ::: "memory");
      const unsigned og = xb_add(&bar[XB_TOP], 1u);
      const unsigned tg = og / nx;
      if (og + 1u == (tg + 1u) * nx) xb_add(&bar[XB_TOPGEN], 1u);
      else XB_SPIN(xb_ld(&bar[XB_TOPGEN]) == tg, bar);
      __builtin_amdgcn_fence(__ATOMIC_ACQUIRE, "agent");
      xb_add(&bar[XB_XGEN(bx)], 1u);
      asm volatile("s_waitcnt vmcnt(0)" ::: "memory");
    } else {
      XB_SPIN(xb_ld(&bar[XB_XGEN(bx)]) == gen, bar);
      __builtin_amdgcn_fence(__ATOMIC_ACQUIRE, "agent");
      asm volatile("s_waitcnt vmcnt(0)" ::: "memory");
    }
  }
  __syncthreads();
}

constexpr int BM = 256, BK = 64, HALF = 128, HT = HALF * BK, NXCD = 8, WGM = 8;
__device__ __forceinline__ int lds_byte(int r, int c) {
  int st = (r >> 4) * 2 + (c >> 5), rr = r & 15, cc = c & 31, ob = rr * 64 + cc * 2;
  return st * 1024 + (ob ^ (((ob >> 9) & 1) << 5));
}
__device__ __forceinline__ void stage_rc(int b, int& R, int& C) {
  int st = b / 1024, sb = b % 1024, swz = sb ^ (((sb >> 9) & 1) << 5);
  R = (st >> 1) * 16 + swz / 64; C = (st & 1) * 32 + (swz % 64) / 2;
}

struct GemmDesc {
  const bf16_t* A; const bf16_t* Bt; int lda, ldb, Mrows, N, K;
  int mode;
  void* out; int ldc;
  const float* src0; const float* src1; const float* gate; int row_off; int dry;
};

__device__ __forceinline__ void gemm_epi(const GemmDesc& g, int row, int col, f32x4 v) {
#if PROBE_PH >= 0
  if (g.dry) return;
#endif
  if (g.mode == 0) {
    u32x2 w; w.x = cvtpk(v[0], v[1]); w.y = cvtpk(v[2], v[3]);
    *(u32x2*)((bf16_t*)g.out + (size_t)row * g.ldc + col) = w;
  } else if (g.mode == 1) {
    float a = fmaxf(v[0], 0.f), b = fmaxf(v[1], 0.f), c = fmaxf(v[2], 0.f), d = fmaxf(v[3], 0.f);
    u32x2 w; w.x = cvtpk(a * a, b * b); w.y = cvtpk(c * c, d * d);
    *(u32x2*)((bf16_t*)g.out + (size_t)row * g.ldc + col) = w;
  } else if (g.mode == 2) {
    int rg = row + g.row_off;
    const float* sp = rg < MP ? g.src0 + (size_t)rg * DM + col : g.src1 + (size_t)(rg - MP) * DM + col;
    f32x4 x = *(const f32x4*)sp;
    f32x4 gt = *(const f32x4*)(g.gate + cond_of_row(rg) * 6144 + col);
    *(f32x4*)((float*)g.out + (size_t)rg * DM + col) = x + gt * v;
  } else {
    *(f32x4*)((float*)g.out + (size_t)row * g.ldc + col) = v;
  }
}

template <int MF>
__device__ __forceinline__ void gemm_tile(const GemmDesc& g, int brow, int bcol) {
  constexpr int AH = MF * 32;
  bf16_t* shm = (bf16_t*)dyn_shm;
  const bf16_t* A = g.A; const bf16_t* Bt = g.Bt; const int lda = g.lda, ldb = g.ldb, K = g.K;
#define SA(b,h) (shm+((b)*2+(h))*HT)
#define SB(b,h) (shm+(4+(b)*2+(h))*HT)
#define STAGE(P,BASE,LD,VO,br,kt) do{const unsigned char* _ub=(const unsigned char*)(BASE)+((size_t)(br)*(LD)+(size_t)(kt)*BK)*2; \
    const unsigned char* _ub2=_ub+(size_t)(LD)*128; \
    const unsigned _m0=(unsigned)(uintptr_t)(__attribute__((address_space(3))) unsigned char*)((unsigned char*)(P))+ldsw; \
    asm volatile("s_mov_b32 m0, %0\n\ts_nop 0\n\tglobal_load_lds_dwordx4 %1, %2\n\ts_mov_b32 m0, %3\n\ts_nop 0\n\tglobal_load_lds_dwordx4 %1, %4" \
      :: "s"(_m0), "v"(VO), "s"(_ub), "s"(_m0+8192u), "s"(_ub2) : "m0", "memory");}while(0)
#define LDA(dst,b,h) for(int m=0;m<MF;++m)for(int k=0;k<2;++k) \
    dst[m][k]=*reinterpret_cast<const bf16x8*>((char*)SA(b,h)+lds_byte(wr*(MF*16)+m*16+fr,k*32+fq*8))
#define LDB(dst,b,h) for(int n=0;n<2;++n)for(int k=0;k<2;++k) \
    dst[n][k]=*reinterpret_cast<const bf16x8*>((char*)SB(b,h)+lds_byte(wc*32+n*16+fr,k*32+fq*8))
#define MMA(ai,bj,At,Bt_) do{__builtin_amdgcn_s_setprio(1); \
    for(int m=0;m<MF;++m)for(int n=0;n<2;++n)for(int k=0;k<2;++k) \
      acc[ai][bj][m][n]=__builtin_amdgcn_mfma_f32_16x16x32_bf16(Bt_[n][k],At[m][k],acc[ai][bj][m][n],0,0,0); \
    __builtin_amdgcn_s_setprio(0);}while(0)
#define WAIT_V(n) asm volatile("s_waitcnt vmcnt(" #n ")":::"memory")
#define WAIT_L(n) asm volatile("s_waitcnt lgkmcnt(" #n ")":::"memory")
#define BAR __builtin_amdgcn_s_barrier()
#define SCHED __builtin_amdgcn_sched_barrier(0)
  const int tid = tid_();
  const int wid = __builtin_amdgcn_readfirstlane(tid >> 6), lane = tid & 63, wr = wid >> 2, wc = wid & 3, fr = lane & 15, fq = lane >> 4;
  const unsigned ldsw = (unsigned)wid * 1024u;
  unsigned voA, voB;
  { int r_, c_; stage_rc(tid * 16, r_, c_); voA = (unsigned)(r_ * lda + c_) * 2u; voB = (unsigned)(r_ * ldb + c_) * 2u; }
  f32x4 acc[2][2][MF][2] = {};
  bf16x8 At[MF][2], B0[2][2], B1[2][2];
  const int nt = K / BK;
  __syncthreads();
  STAGE(SB(0,0),Bt,ldb,voB,bcol,0); STAGE(SA(0,0),A,lda,voA,brow,0);
  STAGE(SB(0,1),Bt,ldb,voB,bcol+HALF,0); STAGE(SA(0,1),A,lda,voA,brow+AH,0);
  if(wr==1)BAR;
  WAIT_V(4); BAR;
  STAGE(SB(1,0),Bt,ldb,voB,bcol,1); STAGE(SA(1,0),A,lda,voA,brow,1); STAGE(SB(1,1),Bt,ldb,voB,bcol+HALF,1);
  WAIT_V(6); BAR;
  for(int t=0;t<nt-2;t+=2){
    LDB(B0,0,0); SCHED; LDA(At,0,0); STAGE(SA(1,1),A,lda,voA,brow+AH,t+1);
    if (MF == 4) WAIT_L(8); else WAIT_L(6); BAR; WAIT_L(0); MMA(0,0,At,B0); BAR; SCHED;
    LDB(B1,0,1); STAGE(SB(0,0),Bt,ldb,voB,bcol,t+2);
    BAR; WAIT_L(0); MMA(0,1,At,B1); BAR;
    LDA(At,0,1); STAGE(SA(0,0),A,lda,voA,brow,t+2);
    BAR; WAIT_L(0); MMA(1,0,At,B0); BAR; SCHED;
    STAGE(SB(0,1),Bt,ldb,voB,bcol+HALF,t+2);
    WAIT_V(6); BAR; MMA(1,1,At,B1); BAR;
    LDB(B0,1,0); SCHED; LDA(At,1,0); STAGE(SA(0,1),A,lda,voA,brow+AH,t+2);
    if (MF == 4) WAIT_L(8); else WAIT_L(6); BAR; WAIT_L(0); MMA(0,0,At,B0); BAR; SCHED;
    LDB(B1,1,1); STAGE(SB(1,0),Bt,ldb,voB,bcol,t+3);
    BAR; WAIT_L(0); MMA(0,1,At,B1); BAR;
    LDA(At,1,1); STAGE(SA(1,0),A,lda,voA,brow,t+3);
    BAR; WAIT_L(0); MMA(1,0,At,B0); BAR; SCHED;
    STAGE(SB(1,1),Bt,ldb,voB,bcol+HALF,t+3);
    WAIT_V(6); BAR; MMA(1,1,At,B1); BAR;
  }
  { LDB(B0,0,0); LDA(At,0,0); STAGE(SA(1,1),A,lda,voA,brow+AH,nt-1);
    BAR; WAIT_L(0); MMA(0,0,At,B0); BAR;
    LDB(B1,0,1); BAR; WAIT_L(0); MMA(0,1,At,B1); BAR;
    LDA(At,0,1); WAIT_V(4); BAR; WAIT_L(0); MMA(1,0,At,B0); MMA(1,1,At,B1); BAR; }
  { LDB(B0,1,0); LDA(At,1,0); WAIT_V(2); BAR; WAIT_L(0); MMA(0,0,At,B0); BAR;
    LDB(B1,1,1); WAIT_V(0); BAR; WAIT_L(0); MMA(0,1,At,B1); BAR;
    LDA(At,1,1); BAR; WAIT_L(0); MMA(1,0,At,B0); MMA(1,1,At,B1); BAR; }
  if(wr==0)BAR;
  const int tid2 = tid_(); const int wid2 = tid2 >> 6, lane2 = tid2 & 63;
  if (g.mode <= 1) {
    unsigned char* st = dyn_shm;
    const int lrow = (wid2 >> 2) * (MF * 16) + (lane2 & 15), lcol = (wid2 & 3) * 32 + (lane2 >> 4) * 4;
    const bool sq = g.mode == 1;
#pragma unroll
    for(int ai=0;ai<2;++ai)
#pragma unroll
      for(int m=0;m<MF;++m)
#pragma unroll
        for(int bj=0;bj<2;++bj)
#pragma unroll
          for(int n=0;n<2;++n) {
            f32x4 v = acc[ai][bj][m][n];
            if (sq) { v[0] = fmaxf(v[0], 0.f); v[1] = fmaxf(v[1], 0.f); v[2] = fmaxf(v[2], 0.f); v[3] = fmaxf(v[3], 0.f); v = v * v; }
            u32x2 w; w.x = cvtpk(v[0], v[1]); w.y = cvtpk(v[2], v[3]);
            *(u32x2*)(st + (lrow + ai * AH + m * 16) * 544 + (lcol + bj * HALF + n * 16) * 2) = w;
          }
    __syncthreads();
#if PROBE_PH >= 0
    if (!g.dry)
#endif
    {
      bf16_t* ob = (bf16_t*)g.out + (size_t)brow * g.ldc + bcol;
      const int r0 = wid2 * (MF * 8) + (lane2 >> 5), c16 = (lane2 & 31);
#pragma unroll 4
      for (int i = 0; i < MF * 4; ++i) {
        const int r = r0 + 2 * i;
        u32x4 w = *(const u32x4*)(st + r * 544 + c16 * 16);
        *(u32x4*)(ob + (size_t)r * g.ldc + c16 * 8) = w;
      }
    }
  } else if (g.mode == 2) {
    unsigned char* st = dyn_shm;
    const int lr0 = (wid2 >> 2) * (MF * 16) + (lane2 & 15), lcol = (wid2 & 3) * 32 + (lane2 >> 4) * 4;
#pragma unroll
    for(int ai=0;ai<2;++ai) {
#pragma unroll
      for(int m=0;m<MF;++m)
#pragma unroll
        for(int bj=0;bj<2;++bj)
#pragma unroll
          for(int n=0;n<2;++n)
            *(f32x4*)(st + (lr0 + m * 16) * 1040 + (lcol + bj * HALF + n * 16) * 4) = acc[ai][bj][m][n];
      __syncthreads();
      {
        constexpr int RPW = MF * 4;
        const int rb = wid2 * RPW;
#pragma unroll
        for (int i0 = 0; i0 < RPW; i0 += 4) {
          f32x4 xv[4], gv[4]; int rgs[4];
#pragma unroll
          for (int i = 0; i < 4; ++i) { const int r = rb + i0 + i, rg = brow + ai * AH + r + g.row_off; rgs[i] = rg;
            xv[i] = *(const f32x4*)((rg < MP ? g.src0 + (size_t)rg * DM : g.src1 + (size_t)(rg - MP) * DM) + bcol + lane2 * 4);
            gv[i] = *(const f32x4*)(g.gate + cond_of_row(rg) * 6144 + bcol + lane2 * 4); }
#pragma unroll
          for (int i = 0; i < 4; ++i) { const int r = rb + i0 + i;
            const f32x4 v = *(const f32x4*)(st + r * 1040 + lane2 * 16);
            *(f32x4*)((float*)g.out + (size_t)rgs[i] * DM + bcol + lane2 * 4) = xv[i] + gv[i] * v; }
        }
      }
      __syncthreads();
    }
  } else {
  const int erow = brow + (wid2 >> 2) * (MF * 16) + (lane2 & 15), ecol = bcol + (wid2 & 3) * 32 + (lane2 >> 4) * 4;
#pragma unroll
  for(int ai=0;ai<2;++ai)
#pragma unroll
    for(int m=0;m<MF;++m)
#pragma unroll
      for(int bj=0;bj<2;++bj)
#pragma unroll
        for(int n=0;n<2;++n)
          gemm_epi(g, erow+ai*AH+m*16, ecol+bj*HALF+n*16, acc[ai][bj][m][n]);
  }
#undef SA
#undef SB
#undef STAGE
#undef LDA
#undef LDB
#undef MMA
}

__device__ __forceinline__ void tile_of(int L, int nM, int nN, int nwg, int th, int& brow, int& bcol) {
  int wgid = L;
  { const int q = nwg / NXCD, r = nwg % NXCD, xcd = wgid % NXCD, off = wgid / NXCD; wgid = (xcd < r ? xcd * (q + 1) : r * (q + 1) + (xcd - r) * q) + off; }
  const int nig = WGM * nN, gid = wgid / nig, fm = gid * WGM, gsz = (nM - fm) < WGM ? (nM - fm) : WGM;
  brow = (fm + ((wgid % nig) % gsz)) * th; bcol = ((wgid % nig) / gsz) * BM;
}
__device__ __forceinline__ void gemm_phase(const GemmDesc& g) {
  const int G = gdim_();
  const bool m3 = (g.Mrows % 192) == 0 && g.N <= 1536;
  const int th = m3 ? 192 : 256;
  const int nM = g.Mrows / th, nN = g.N / BM, nwg = nM * nN;
  for (int L = bid_(); L < nwg; L += G) {
    int brow, bcol; tile_of(L, nM, nN, nwg, th, brow, bcol);
    if (m3) gemm_tile<3>(g, brow, bcol); else gemm_tile<4>(g, brow, bcol);
  }
}

constexpr float ATT_SCALE = 0.10206207261596577f;
constexpr float ATT_THR = 8.f;
constexpr int SHM_V = 64 * 64 * 2, SHM_K = 64 * 128 * 2;
#define KSWZ(row, colB) ((row) * 256 + ((colB) ^ (((row) & 7) << 4)))
#define SBAR() __builtin_amdgcn_sched_barrier(0)
__device__ __forceinline__ int crow(int r, int hi) { return (r & 3) + 8 * (r >> 2) + 4 * hi; }

__device__ __forceinline__ void partialSM(f32x16& p0, f32x16& p1, float& m_reg, float& alpha, bool first) {
  constexpr float THRL = ATT_THR * 1.4426950408889634f;
  float pmax = p0[0];
#pragma unroll
  for (int r = 1; r < 16; ++r) pmax = fmaxf(pmax, p0[r]);
#pragma unroll
  for (int r = 0; r < 16; ++r) pmax = fmaxf(pmax, p1[r]);
  { auto rr = __builtin_amdgcn_permlane32_swap(__float_as_uint(pmax), __float_as_uint(pmax), false, false);
    pmax = fmaxf(__uint_as_float(rr[0]), __uint_as_float(rr[1])); }
  if (first) {
    alpha = 0.f; m_reg = pmax;
#pragma unroll
    for (int r = 0; r < 16; ++r) p0[r] -= pmax;
#pragma unroll
    for (int r = 0; r < 16; ++r) p1[r] -= pmax;
  } else if (__builtin_expect(__all(pmax <= THRL), 1)) { alpha = 1.f; }
  else { const float d = fmaxf(pmax, 0.f); alpha = __builtin_amdgcn_exp2f(-d); m_reg += d;
#pragma unroll
    for (int r = 0; r < 16; ++r) p0[r] -= d;
#pragma unroll
    for (int r = 0; r < 16; ++r) p1[r] -= d;
  }
#pragma unroll
  for (int r = 0; r < 16; ++r) p0[r] = __builtin_amdgcn_exp2f(p0[r]);
}
__device__ __forceinline__ void finishSM(f32x16& p0, f32x16& p1, float alpha, float& l_reg, bf16x8& pa0, bf16x8& pa1, bf16x8& pa2, bf16x8& pa3) {
#pragma unroll
  for (int r = 0; r < 16; ++r) p1[r] = __builtin_amdgcn_exp2f(p1[r]);
  float ps = 0;
#pragma unroll
  for (int r = 0; r < 16; ++r) ps += p0[r];
#pragma unroll
  for (int r = 0; r < 16; ++r) ps += p1[r];
  { auto rr = __builtin_amdgcn_permlane32_swap(__float_as_uint(ps), __float_as_uint(ps), false, false);
    ps = __uint_as_float(rr[0]) + __uint_as_float(rr[1]); }
  l_reg = l_reg * alpha + ps;
#define PK4(P, BASE, OUT) do { unsigned a0 = cvtpk(P[BASE + 0], P[BASE + 1]), a1 = cvtpk(P[BASE + 2], P[BASE + 3]);   \
    unsigned b0 = cvtpk(P[BASE + 4], P[BASE + 5]), b1 = cvtpk(P[BASE + 6], P[BASE + 7]);                              \
    auto r0 = __builtin_amdgcn_permlane32_swap(a0, b0, false, false); auto r1 = __builtin_amdgcn_permlane32_swap(a1, b1, false, false); \
    u32x4 w = {r0[0], r1[0], r0[1], r1[1]}; OUT = *reinterpret_cast<bf16x8*>(&w); } while (0)
  PK4(p0, 0, pa0); PK4(p0, 8, pa1); PK4(p1, 0, pa2); PK4(p1, 8, pa3);
#undef PK4
}
__device__ __forceinline__ void qkt(f32x16& p0, f32x16& p1, const unsigned char* Ks, const bf16x8* qr, int r32, int hi, float init) {
#pragma unroll
  for (int r = 0; r < 16; ++r) { p0[r] = init; p1[r] = init; }
#pragma unroll
  for (int d0 = 0; d0 < 6; ++d0) { int cb = (d0 * 16 + hi * 8) * 2;
    bf16x8 b0 = *reinterpret_cast<const bf16x8*>(Ks + KSWZ(r32, cb));
    bf16x8 b1 = *reinterpret_cast<const bf16x8*>(Ks + KSWZ(32 + r32, cb));
    p0 = __builtin_amdgcn_mfma_f32_32x32x16_bf16(b0, qr[d0], p0, 0, 0, 0);
    p1 = __builtin_amdgcn_mfma_f32_32x32x16_bf16(b1, qr[d0], p1, 0, 0, 0); }
}
__device__ __forceinline__ int v_st(int k, int c) { const int kk = (k & ~0xC) | ((k & 4) << 1) | ((k & 8) >> 1); return ((kk >> 3) * 2 + (c >> 5)) * 512 + ((kk & 7) * 32 + (c & 31)) * 2; }
__device__ __forceinline__ int v_rd_base(int lane) { return ((lane & 3) << 3) | (((lane >> 2) & 3) << 6) | (((lane >> 4) & 1) << 5) | (((lane >> 5) & 1) << 8); }
constexpr int v_rd_off(int d0, int ks, int half) { return d0 * 512 + ks * 2048 + half * 1024; }
template <int OFF> __device__ __forceinline__ s16x4 tr_read(int vb) {
  s16x4 r; asm volatile("ds_read_b64_tr_b16 %0, %1 offset:%2" : "=&v"(r) : "v"(vb), "i"(OFF) : "memory"); return r;
}
__device__ __forceinline__ void pv_d0(f32x16* o, int vb, bf16x8 pa0, bf16x8 pa1, bf16x8 pa2, bf16x8 pa3) {
  const s16x4 l0 = tr_read<v_rd_off(0, 0, 0)>(vb), h0 = tr_read<v_rd_off(0, 0, 1)>(vb), l1 = tr_read<v_rd_off(0, 1, 0)>(vb), h1 = tr_read<v_rd_off(0, 1, 1)>(vb);
  const s16x4 l2 = tr_read<v_rd_off(0, 2, 0)>(vb), h2 = tr_read<v_rd_off(0, 2, 1)>(vb), l3 = tr_read<v_rd_off(0, 3, 0)>(vb), h3 = tr_read<v_rd_off(0, 3, 1)>(vb);
  const s16x4 m0 = tr_read<v_rd_off(1, 0, 0)>(vb), n0 = tr_read<v_rd_off(1, 0, 1)>(vb), m1 = tr_read<v_rd_off(1, 1, 0)>(vb), n1 = tr_read<v_rd_off(1, 1, 1)>(vb);
  const s16x4 m2 = tr_read<v_rd_off(1, 2, 0)>(vb), n2 = tr_read<v_rd_off(1, 2, 1)>(vb), m3 = tr_read<v_rd_off(1, 3, 0)>(vb), n3 = tr_read<v_rd_off(1, 3, 1)>(vb);
  asm volatile("s_waitcnt lgkmcnt(0)" ::: "memory"); SBAR();
#define PK(L, H) (bf16x8){L[0], L[1], L[2], L[3], H[0], H[1], H[2], H[3]}
  o[0] = __builtin_amdgcn_mfma_f32_32x32x16_bf16(pa0, PK(l0, h0), o[0], 0, 0, 0);
  o[1] = __builtin_amdgcn_mfma_f32_32x32x16_bf16(pa0, PK(m0, n0), o[1], 0, 0, 0);
  o[0] = __builtin_amdgcn_mfma_f32_32x32x16_bf16(pa1, PK(l1, h1), o[0], 0, 0, 0);
  o[1] = __builtin_amdgcn_mfma_f32_32x32x16_bf16(pa1, PK(m1, n1), o[1], 0, 0, 0);
  o[0] = __builtin_amdgcn_mfma_f32_32x32x16_bf16(pa2, PK(l2, h2), o[0], 0, 0, 0);
  o[1] = __builtin_amdgcn_mfma_f32_32x32x16_bf16(pa2, PK(m2, n2), o[1], 0, 0, 0);
  o[0] = __builtin_amdgcn_mfma_f32_32x32x16_bf16(pa3, PK(l3, h3), o[0], 0, 0, 0);
  o[1] = __builtin_amdgcn_mfma_f32_32x32x16_bf16(pa3, PK(m3, n3), o[1], 0, 0, 0);
#undef PK
}

__device__ __forceinline__ void attn_unit(bf16_t* Qrows, int h, const bf16_t* KVb, const bf16_t* KPb, int nkeys, bool rope, int s0, const float* ropetab, int dry) {
  unsigned char* lds = dyn_shm;
  const int tid = tid_(), wid = tid >> 6, lane = tid & 63, r32 = lane & 31, hi = lane >> 5;
  unsigned char* V_lds = lds; unsigned char* K_lds = lds + 3 * SHM_V;
  float* ws = (float*)(lds + 3 * SHM_V + 3 * SHM_K) + wid * 64; float* li_l = ws; float* al_l = ws + 32;
  float m_reg = -1e30f, l_reg = 0; f32x16 o[2] = {}; bf16x8 qr[6];
  __syncthreads();
  {
    const int row = wid * 32 + r32;
    const bf16_t* Qn = Qrows + (size_t)row * 1536 + h * 64 + hi * 8;
#pragma unroll
    for (int d0 = 0; d0 < 4; ++d0) qr[d0] = *reinterpret_cast<const bf16x8*>(Qn + d0 * 16);
    const bf16_t* Qp = Qrows + (size_t)row * 1536 + 1024 + h * 32;
    const int s = s0 + row;
#pragma unroll
    for (int blk = 0; blk < 2; ++blk) {
      bf16x8 x1 = *reinterpret_cast<const bf16x8*>(Qp + blk * 16), x2 = *reinterpret_cast<const bf16x8*>(Qp + blk * 16 + 8);
      if (rope) {
        const int pos = blk == 0 ? (s >> 6) : (s & 63);
        const float* tb = ropetab + pos * 16;
        float ov[8];
#pragma unroll
        for (int j = 0; j < 8; ++j) {
          float a = bf2f((bf16_t)x1[j]), b = bf2f((bf16_t)x2[j]), cs = tb[2 * j], sn = tb[2 * j + 1];
          ov[j] = hi == 0 ? a * cs - b * sn : b * cs + a * sn;
        }
        u32x4 w = {cvtpk(ov[0], ov[1]), cvtpk(ov[2], ov[3]), cvtpk(ov[4], ov[5]), cvtpk(ov[6], ov[7])};
        qr[4 + blk] = *reinterpret_cast<bf16x8*>(&w);
      } else {
        qr[4 + blk] = hi == 0 ? x1 : x2;
      }
    }
  }
  const int vrow = tid >> 3, vc = (tid & 7) * 8, vst = v_st(vrow, vc);
  const bf16_t* vsrc = KVb + (size_t)vrow * 2048 + h * 128 + 64 + vc;
  const bool kact = tid < 384;
  const int kr = kact ? tid / 12 : 0, kc = kact ? (tid % 12) * 8 : 0;
  const bf16_t* ksrc = kc < 64 ? KVb + (size_t)kr * 2048 + h * 128 + kc : KPb + (size_t)kr * 32 + (kc - 64);
  const long kstride = kc < 64 ? 2048 : 32;
  const int kst0 = KSWZ(kr, kc * 2), kst1 = KSWZ(32 + kr, kc * 2);
  const int vb0 = (int)(uintptr_t)V_lds + v_rd_base(lane);
  struct { bf16x8 vs, ks0, ks1; } sr_[2];
#define SLOAD(i, k0) do { sr_[i].vs = *reinterpret_cast<const bf16x8*>(vsrc + (size_t)(k0) * 2048); \
    if (kact) { sr_[i].ks0 = *reinterpret_cast<const bf16x8*>(ksrc + (long)(k0) * kstride); sr_[i].ks1 = *reinterpret_cast<const bf16x8*>(ksrc + (long)((k0) + 32) * kstride); } } while (0)
#define SWRITE(b, i) do { *(bf16x8*)(V_lds + (b) * SHM_V + vst) = sr_[i].vs; \
    if (kact) { *(bf16x8*)(K_lds + (b) * SHM_K + kst0) = sr_[i].ks0; *(bf16x8*)(K_lds + (b) * SHM_K + kst1) = sr_[i].ks1; } } while (0)
#define RESC(a) do { if (__any((a) < 1.f)) { if (hi == 0) al_l[r32] = (a); asm volatile("s_waitcnt lgkmcnt(0)" ::: "memory"); \
    for (int d = 0; d < 2; ++d) for (int r = 0; r < 16; ++r) o[d][r] *= al_l[crow(r, hi)]; } } while (0)
  f32x16 pA0, pA1, pB0, pB1; float alA, alB; bf16x8 pa0, pa1, pa2, pa3; const int NT = nkeys / 64;
  constexpr int SE = 0, SO = 1;
  SLOAD(SE, 0); SWRITE(0, SE); SLOAD(SO, 64); __syncthreads();
  qkt(pA0, pA1, K_lds, qr, r32, hi, 0.f); partialSM(pA0, pA1, m_reg, alA, true);
  SWRITE(1, SO); if (2 < NT) SLOAD(SE, 128);
  int bc = 1;
  for (int j = 1; j + 1 < NT; j += 2) {
    const int bp = bc == 0 ? 2 : bc - 1, bn = bc == 2 ? 0 : bc + 1;
    __syncthreads();
    SBAR(); qkt(pB0, pB1, K_lds + bc * SHM_K, qr, r32, hi, -m_reg);
    finishSM(pA0, pA1, alA, l_reg, pa0, pa1, pa2, pa3); SBAR();
    SLOAD(SO, (j + 2) * 64); SBAR();
    pv_d0(o, vb0 + bp * SHM_V, pa0, pa1, pa2, pa3); partialSM(pB0, pB1, m_reg, alB, false);
    SWRITE(bn, SE);
    RESC(alB);
    __syncthreads();
    SBAR(); qkt(pA0, pA1, K_lds + bn * SHM_K, qr, r32, hi, -m_reg);
    finishSM(pB0, pB1, alB, l_reg, pa0, pa1, pa2, pa3); SBAR();
    if (j + 3 < NT) SLOAD(SE, (j + 3) * 64); SBAR();
    pv_d0(o, vb0 + bc * SHM_V, pa0, pa1, pa2, pa3); partialSM(pA0, pA1, m_reg, alA, false);
    SWRITE(bp, SO);
    RESC(alA);
    bc = bp;
  }
  { const int bp = bc == 0 ? 2 : bc - 1;
    __syncthreads();
    SBAR(); qkt(pB0, pB1, K_lds + bc * SHM_K, qr, r32, hi, -m_reg);
    finishSM(pA0, pA1, alA, l_reg, pa0, pa1, pa2, pa3); SBAR();
    pv_d0(o, vb0 + bp * SHM_V, pa0, pa1, pa2, pa3); partialSM(pB0, pB1, m_reg, alB, false);
    RESC(alB);
    finishSM(pB0, pB1, alB, l_reg, pa0, pa1, pa2, pa3); SBAR();
    pv_d0(o, vb0 + bc * SHM_V, pa0, pa1, pa2, pa3); }
  if (hi == 0) li_l[r32] = l_reg; asm volatile("s_waitcnt lgkmcnt(0)" ::: "memory");
  float rli[16];
#pragma unroll
  for (int r = 0; r < 16; ++r) rli[r] = __builtin_amdgcn_rcpf(li_l[crow(r, hi)]);
  bf16_t* Ow = Qrows + (size_t)(wid * 32) * 1536 + h * 64;
  if (!dry)
#pragma unroll
  for (int r = 0; r < 16; ++r) { int orow = crow(r, hi);
#pragma unroll
    for (int d0 = 0; d0 < 2; ++d0) Ow[(size_t)orow * 1536 + d0 * 32 + r32] = f2bf(o[d0][r] * rli[r]); }
#undef SLOAD
#undef SWRITE
#undef RESC
}

__device__ __forceinline__ void attn_phase(KP p, int dry) {
  bf16_t* Q = (bf16_t*)(p->ws + WS_Q); const bf16_t* KV = (const bf16_t*)(p->ws + WS_KV); const bf16_t* KP = (const bf16_t*)(p->ws + WS_KPE);
  const float* ropetab = (const float*)(p->ws + WS_ROPE);
  const int xcd = bid_() & 7, slot = bid_() >> 3;
  const int G = gdim_();
  const int nit = G == 256 ? 6 : (1536 + G - 1) / G;
  for (int i = 0; i < nit; ++i) {
    int u;
    if (G == 256) u = i < 4 ? ((i * 16 + xcd * 2 + (slot >> 4)) << 4) + (slot & 15) : 1024 + (i - 4) * 256 + xcd * 32 + slot;
    else { u = bid_() + i * G; if (u >= 1536) break; }
    const bool samp = u < 1024;
    const int pair = samp ? u >> 4 : u - 1024, qb = samp ? u & 15 : 0, b = pair >> 4, h = pair & 15;
    const size_t qrow = samp ? (size_t)(MP + b * DSEQ + qb * 256) : (size_t)(b * SEQ);
    const size_t krow = samp ? (size_t)(MP + b * SKEYS) : (size_t)(b * SEQ);
    attn_unit(Q + qrow * 1536, h, KV + krow * 2048, KP + krow * 32, samp ? SKEYS : SEQ, samp, qb * 256, ropetab, dry);
  }
}

__device__ void mod_gemv_item(KP p, int it) {
  float* lds = (float*)dyn_shm;
  const int l = it / 96, n0 = (it % 96) * 64, tid = tid_();
  const float* wmod = p->in[l == 0 ? 7 : 24]; const float* bmod = p->in[l == 0 ? 8 : 25];
  __syncthreads();
  for (int e = tid; e < 5 * 1024; e += 512) { int c = e >> 10, k = e & 1023; float v = c == 0 ? p->in[6][k] : p->in[5][(c - 1) * 1024 + k]; lds[e] = v / (1.f + __expf(-v)); }
  __syncthreads();
  const int col = tid & 63, ks = tid >> 6;
  float a0 = 0, a1 = 0, a2 = 0, a3 = 0, a4 = 0;
  const float* wp = wmod + (size_t)(ks * 128) * 6144 + n0 + col;
#pragma unroll 8
  for (int k = 0; k < 128; ++k) { float w = wp[(size_t)k * 6144]; int kk = ks * 128 + k;
    a0 += lds[kk] * w; a1 += lds[1024 + kk] * w; a2 += lds[2048 + kk] * w; a3 += lds[3072 + kk] * w; a4 += lds[4096 + kk] * w; }
  float* red = lds + 5 * 1024;
  red[(ks * 5 + 0) * 64 + col] = a0; red[(ks * 5 + 1) * 64 + col] = a1; red[(ks * 5 + 2) * 64 + col] = a2; red[(ks * 5 + 3) * 64 + col] = a3; red[(ks * 5 + 4) * 64 + col] = a4;
  __syncthreads();
  if (tid < 320) { int c = tid >> 6, cc = tid & 63; float s = 0;
#pragma unroll
    for (int k8 = 0; k8 < 8; ++k8) s += red[(k8 * 5 + c) * 64 + cc];
    ((float*)(p->ws + WS_MOD))[(l * 5 + c) * 6144 + n0 + cc] = s + bmod[n0 + cc]; }
}

struct CvtMat { const float* src; int K, N, Npad; bf16_t* dst; int ldk, perm; };
__device__ __forceinline__ CvtMat get_mat(KP p, int layer, int i) {
  bf16_t* WB = (bf16_t*)(p->ws + WS_WB);
  if (layer == 0) {
    switch (i) {
      case 0: return CvtMat{p->in[11], 1024, 1536, 1536, WB + W0_IN, 1024, 0};
      case 1: return CvtMat{p->in[21], 1024, 1024, 1024, WB + W0_OUT, 1024, 0};
      case 2: return CvtMat{p->in[22], 1024, 4096, 4096, WB + W0_W1, 1024, 0};
      default: return CvtMat{p->in[23], 4096, 1024, 1024, WB + W0_W2, 4096, 0};
    }
  } else {
    switch (i) {
      case 0: return CvtMat{p->in[28], 1024, 672, 768, WB + W1_IN, 1024, 0};
      case 1: return CvtMat{p->in[30], 384, 1536, 1536, WB + W1_QB, 384, 1};
      case 2: return CvtMat{p->in[32], 256, 2048, 2048, WB + W1_KVB, 256, 0};
      case 3: return CvtMat{p->in[33], 1024, 1024, 1024, WB + W1_OUT, 1024, 0};
      case 4: return CvtMat{p->in[34], 1024, 4096, 4096, WB + W1_W1, 1024, 0};
      default: return CvtMat{p->in[35], 4096, 1024, 1024, WB + W1_W2, 4096, 0};
    }
  }
}
struct CvtTile { const float* src; int K, N; bf16_t* dst; int ldk, perm, k0, n0; float wsc; };
__device__ __forceinline__ CvtTile cvt_desc(KP p, int layer, int t, int total) {
  bf16_t* WB = (bf16_t*)(p->ws + WS_WB);
  const int nm = layer == 0 ? 4 : 6;
  if (t < total) {
    int tt = t, i = 0;
    for (; i < nm - 1; ++i) { CvtMat m = get_mat(p, layer, i); int c = (m.K / 64) * (m.Npad / 64); if (tt < c) break; tt -= c; }
    const CvtMat m = get_mat(p, layer, i);
    const int nn = m.Npad / 64;
    return CvtTile{m.src, m.K, m.N, m.dst, m.ldk, m.perm, (tt / nn) * 64, (tt % nn) * 64, m.perm ? ATT_SCALE * 1.4426950408889634f : 1.f};
  }
  const int e = t - total;
  if (e < 32) {
    const int dg = e >> 3, nb = e & 7, dir = dg >> 1, gate = dg & 1;
    return CvtTile{p->in[gate == 0 ? 14 : 16] + (size_t)(dir * 8 + nb) * 4096, 64, 64, WB + W0_G + (size_t)e * 4096, 64, 0, 0, 0, -1.4426950408889634f};
  }
  const int e2 = e - 32, gi = e2 >> 2, q = e2 & 3;
  return CvtTile{p->in[19] + (size_t)gi * 16384, 128, 128, WB + W0_P + (size_t)gi * 16384, 128, 0, (q >> 1) * 64, (q & 1) * 64, 1.f};
}
__device__ __forceinline__ void cvt_load(const CvtTile& d, int tid, f32x4& v0, f32x4& v1) {
  const int kk = tid >> 4, n4 = (tid & 15) * 4;
  const f32x4 zero = {0.f, 0.f, 0.f, 0.f};
  const bool ok = d.n0 + n4 < d.N;
  const float* sp = d.src + (size_t)(d.k0 + kk) * d.N + d.n0 + (ok ? n4 : 0);
  v0 = ok ? *(const f32x4*)sp : zero;
  v1 = ok ? *(const f32x4*)(sp + (size_t)32 * d.N) : zero;
}
__device__ void cvt_weights(KP p, int layer, int start, int stride) {
  float* tile = (float*)dyn_shm;
  const int total = layer == 0 ? 384 + 256 + 1024 + 1024 : 192 + 144 + 128 + 256 + 1024 + 1024;
  const int all = total + (layer == 0 ? 32 + 16 : 0);
  const int tid = tid_();
  int t = start;
  if (t >= all) return;
  CvtTile d = cvt_desc(p, layer, t, total);
  f32x4 v0, v1; cvt_load(d, tid, v0, v1);
  for (;;) {
    const int kk = tid >> 4, n4 = (tid & 15) * 4;
    __syncthreads();
    tile[kk * 65 + n4 + 0] = v0[0]; tile[kk * 65 + n4 + 1] = v0[1]; tile[kk * 65 + n4 + 2] = v0[2]; tile[kk * 65 + n4 + 3] = v0[3];
    tile[(kk + 32) * 65 + n4 + 0] = v1[0]; tile[(kk + 32) * 65 + n4 + 1] = v1[1]; tile[(kk + 32) * 65 + n4 + 2] = v1[2]; tile[(kk + 32) * 65 + n4 + 3] = v1[3];
    __syncthreads();
    const int tn = t + stride; const bool more = tn < all;
    CvtTile dn = d;
    if (more) { dn = cvt_desc(p, layer, tn, total); cvt_load(dn, tid, v0, v1); }
    {
      int n = tid >> 3, k8 = (tid & 7) * 8, ng = d.n0 + n;
      if (d.perm) { int hh = ng / 96, dd = ng % 96; ng = dd < 64 ? hh * 64 + dd : 1024 + hh * 32 + (dd - 64); }
      float v[8];
#pragma unroll
      for (int j = 0; j < 8; ++j) v[j] = tile[(k8 + j) * 65 + n];
      const float wsc = d.wsc;
      u32x4 w = {cvtpk(v[0] * wsc, v[1] * wsc), cvtpk(v[2] * wsc, v[3] * wsc), cvtpk(v[4] * wsc, v[5] * wsc), cvtpk(v[6] * wsc, v[7] * wsc)};
      *(u32x4*)(d.dst + (size_t)ng * d.ldk + d.k0 + k8) = w;
    }
    if (!more) break;
    t = tn; d = dn;
  }
}

__device__ __forceinline__ void mod_row_store(bf16_t* H, int row, int lane, const f32x4 (&x)[4], const f32x4 (&gv)[4], float ss, const float* modl, int chunk_shift) {
  const float rstd = rsqrtf(ss * (1.f / DM) + EPS);
  const float* mc = modl + cond_of_row(row) * 6144 + chunk_shift * 1024;
#pragma unroll
  for (int i = 0; i < 4; ++i) {
    const int col = (i * 64 + lane) * 4;
    f32x4 sh = *(const f32x4*)(mc + col), sc = *(const f32x4*)(mc + 1024 + col);
    f32x4 y = x[i] * rstd * gv[i] * (sc + 1.f) + sh;
    u32x2 w; w.x = cvtpk(y[0], y[1]); w.y = cvtpk(y[2], y[3]);
    *(u32x2*)(H + (size_t)row * DM + col) = w;
  }
}
__device__ void modulate_phase(KP p, const float* src0, const float* src1, const float* g, const float* modl, int chunk_shift) {
  bf16_t* H = (bf16_t*)(p->ws + WS_H);
  const int tid = tid_(); const int wid = tid >> 6, lane = tid & 63;
  f32x4 gv[4];
#pragma unroll
  for (int i = 0; i < 4; ++i) gv[i] = *(const f32x4*)(g + (i * 64 + lane) * 4);
  const int stride = gdim_() * 8;
  for (int row = bid_() * 8 + wid; row < M; row += 2 * stride) {
    const int row2 = row + stride; const bool v2 = row2 < M; const int r2 = v2 ? row2 : row;
    const float* xp = row < MP ? src0 + (size_t)row * DM : src1 + (size_t)(row - MP) * DM;
    const float* xq = r2 < MP ? src0 + (size_t)r2 * DM : src1 + (size_t)(r2 - MP) * DM;
    f32x4 x[4], z[4]; float ss = 0, s2 = 0;
#pragma unroll
    for (int i = 0; i < 4; ++i) { x[i] = *(const f32x4*)(xp + (i * 64 + lane) * 4); z[i] = *(const f32x4*)(xq + (i * 64 + lane) * 4); }
#pragma unroll
    for (int i = 0; i < 4; ++i) { ss += x[i][0] * x[i][0] + x[i][1] * x[i][1] + x[i][2] * x[i][2] + x[i][3] * x[i][3]; s2 += z[i][0] * z[i][0] + z[i][1] * z[i][1] + z[i][2] * z[i][2] + z[i][3] * z[i][3]; }
    ss = wave_sum(ss, lane); s2 = wave_sum(s2, lane);
    mod_row_store(H, row, lane, x, gv, ss, modl, chunk_shift);
    if (v2) mod_row_store(H, row2, lane, z, gv, s2, modl, chunk_shift);
  }
}
__device__ void final_norm_phase(KP p, int dry) {
  float* X = p->out; const float* g = p->in[36];
  const int tid = tid_(); const int wid = tid >> 6, lane = tid & 63;
  f32x4 gv[4];
#pragma unroll
  for (int i = 0; i < 4; ++i) gv[i] = *(const f32x4*)(g + (i * 64 + lane) * 4);
  const int stride = gdim_() * 8;
  for (int row = bid_() * 8 + wid; row < M; row += 2 * stride) {
    const int row2 = row + stride; const bool v2 = row2 < M; const int r2 = v2 ? row2 : row;
    float* xp = X + (size_t)row * DM; float* xq = X + (size_t)r2 * DM;
    f32x4 x[4], z[4]; float ss = 0, s2 = 0;
#pragma unroll
    for (int i = 0; i < 4; ++i) { x[i] = *(const f32x4*)(xp + (i * 64 + lane) * 4); z[i] = *(const f32x4*)(xq + (i * 64 + lane) * 4); }
#pragma unroll
    for (int i = 0; i < 4; ++i) { ss += x[i][0] * x[i][0] + x[i][1] * x[i][1] + x[i][2] * x[i][2] + x[i][3] * x[i][3]; s2 += z[i][0] * z[i][0] + z[i][1] * z[i][1] + z[i][2] * z[i][2] + z[i][3] * z[i][3]; }
    ss = wave_sum(ss, lane); s2 = wave_sum(s2, lane);
    const float rstd = rsqrtf(ss * (1.f / DM) + EPS), rstd2 = rsqrtf(s2 * (1.f / DM) + EPS);
    if (!dry) {
#pragma unroll
      for (int i = 0; i < 4; ++i) *(f32x4*)(xp + (i * 64 + lane) * 4) = x[i] * rstd * gv[i];
      if (v2) {
#pragma unroll
        for (int i = 0; i < 4; ++i) *(f32x4*)(xq + (i * 64 + lane) * 4) = z[i] * rstd2 * gv[i];
      }
    }
  }
}
struct L1Row { f32x4 qa, qb, kv; float kp; };
__device__ __forceinline__ f32x4 bf4_to_f32(u32x2 w) {
  return (f32x4){__uint_as_float(w.x << 16), __uint_as_float(w.x & 0xffff0000u), __uint_as_float(w.y << 16), __uint_as_float(w.y & 0xffff0000u)};
}
__device__ __forceinline__ void l1_row_load(const bf16_t* Z1, int row, int lane, L1Row& r) {
  const bf16_t* z = Z1 + (size_t)row * 768;
  const u32x2 zero = {0u, 0u};
  r.qa = bf4_to_f32(lane < 48 ? *(const u32x2*)(z + lane * 4) : zero);
  r.qb = bf4_to_f32(lane < 48 ? *(const u32x2*)(z + 192 + lane * 4) : zero);
  r.kv = bf4_to_f32(*(const u32x2*)(z + 384 + lane * 4));
  r.kp = lane < 32 ? bf2f(z[640 + lane]) : 0.f;
}
__device__ __forceinline__ void l1_row_finish(KP p, int row, int lane, const L1Row& r, const f32x4& gqa, const f32x4& gqb, const f32x4& gk) {
  bf16_t* CQN = (bf16_t*)(p->ws + WS_CQN); bf16_t* CKVN = (bf16_t*)(p->ws + WS_CKVN); bf16_t* KPE = (bf16_t*)(p->ws + WS_KPE);
  const float* ropetab = (const float*)(p->ws + WS_ROPE);
  float ss = r.qa[0] * r.qa[0] + r.qa[1] * r.qa[1] + r.qa[2] * r.qa[2] + r.qa[3] * r.qa[3] + r.qb[0] * r.qb[0] + r.qb[1] * r.qb[1] + r.qb[2] * r.qb[2] + r.qb[3] * r.qb[3];
  ss = wave_sum(ss, lane);
  const float rstd = rsqrtf(ss * (1.f / 384) + EPS);
  if (lane < 48) {
    const f32x4 ya = r.qa * rstd * gqa, yb = r.qb * rstd * gqb;
    u32x2 wa; wa.x = cvtpk(ya[0], ya[1]); wa.y = cvtpk(ya[2], ya[3]);
    u32x2 wb; wb.x = cvtpk(yb[0], yb[1]); wb.y = cvtpk(yb[2], yb[3]);
    *(u32x2*)(CQN + (size_t)row * 384 + lane * 4) = wa; *(u32x2*)(CQN + (size_t)row * 384 + 192 + lane * 4) = wb;
  }
  const float s2 = wave_sum(r.kv[0] * r.kv[0] + r.kv[1] * r.kv[1] + r.kv[2] * r.kv[2] + r.kv[3] * r.kv[3], lane);
  const float r2 = rsqrtf(s2 * (1.f / 256) + EPS);
  const f32x4 y = r.kv * r2 * gk;
  int krow; bool rope; int s = 0;
  if (row < MP) { krow = row; rope = false; *(f32x4*)(p->out + O_CKV + (size_t)row * 256 + lane * 4) = y; }
  else { int b = (row - MP) >> 12; s = (row - MP) & 4095; krow = MP + b * SKEYS + s; rope = true; }
  u32x2 w; w.x = cvtpk(y[0], y[1]); w.y = cvtpk(y[2], y[3]);
  *(u32x2*)(CKVN + (size_t)krow * 256 + lane * 4) = w;
  const float kp = r.kp;
  const float partner = lane_xor(kp, lane, 8);
  if (!rope) { if (lane < 32) { p->out[O_KPE + (size_t)row * 32 + lane] = kp; KPE[(size_t)krow * 32 + lane] = f2bf(kp); } }
  else if (lane < 32) {
    int pos = lane < 16 ? (s >> 6) : (s & 63); int j = lane & 7;
    float cs = ropetab[pos * 16 + 2 * j], sn = ropetab[pos * 16 + 2 * j + 1];
    float ov = (lane & 8) == 0 ? kp * cs - partner * sn : kp * cs + partner * sn;
    KPE[(size_t)krow * 32 + lane] = f2bf(ov);
  }
}
__device__ void l1_rows_phase(KP p) {
  const bf16_t* Z1 = (const bf16_t*)(p->ws + WS_Z1);
  bf16_t* CKVN = (bf16_t*)(p->ws + WS_CKVN); bf16_t* KPE = (bf16_t*)(p->ws + WS_KPE);
  const int tid = tid_(); const int wid = tid >> 6, lane = tid & 63;
  const int l48 = lane < 48 ? lane : 0;
  const f32x4 gqa = *(const f32x4*)(p->in[29] + l48 * 4), gqb = *(const f32x4*)(p->in[29] + 192 + l48 * 4), gk = *(const f32x4*)(p->in[31] + lane * 4);
  const int stride = gdim_() * 8;
  for (int row = bid_() * 8 + wid; row < M; row += 2 * stride) {
    const int row2 = row + stride; const bool v2 = row2 < M;
    L1Row ra, rb;
    l1_row_load(Z1, row, lane, ra); l1_row_load(Z1, v2 ? row2 : row, lane, rb);
    l1_row_finish(p, row, lane, ra, gqa, gqb, gk);
    if (v2) l1_row_finish(p, row2, lane, rb, gqa, gqb, gk);
  }
  for (int idx = bid_() * 8 + wid; idx < NB_S * PAST; idx += stride) {
    const int b = idx >> 9, j = idx & 511, krow = MP + b * SKEYS + DSEQ + j;
    f32x4 kv = *(const f32x4*)(p->in[3] + ((size_t)(b * PAST + j)) * 256 + lane * 4);
    u32x2 w; w.x = cvtpk(kv[0], kv[1]); w.y = cvtpk(kv[2], kv[3]);
    *(u32x2*)(CKVN + (size_t)krow * 256 + lane * 4) = w;
    if (lane < 32) KPE[(size_t)krow * 32 + lane] = f2bf(p->in[4][((size_t)(b * PAST + j)) * 32 + lane]);
  }
}

__device__ __forceinline__ float fast_sigmoid(float x) { return __builtin_amdgcn_rcpf(1.f + __expf(-x)); }
__device__ __forceinline__ float fast_gelu(float x) {
  float u = 0.7978845608028654f * (x + 0.044715f * x * x * x);
  float e = __expf(2.f * u);
  float th = 1.f - 2.f * __builtin_amdgcn_rcpf(e + 1.f);
  return 0.5f * x * (1.f + th);
}
__device__ __forceinline__ float bperm(int srclane, float v) { return __int_as_float(__builtin_amdgcn_ds_bpermute(srclane << 2, __float_as_int(v))); }
__device__ __forceinline__ void scan4(float& P, float& H, int lane, int stepl, int oq) {
  { const float Pp = bperm(lane - stepl, P), Hp = bperm(lane - stepl, H); if (oq >= 1) { H = P * Hp + H; P = Pp * P; } }
  { const float Pp = bperm(lane - 2 * stepl, P), Hp = bperm(lane - 2 * stepl, H); if (oq >= 2) { H = P * Hp + H; P = Pp * P; } }
}
__device__ void lru_item(KP p, int cidx, int nb, int mode) {
  const bf16_t* Z0 = (const bf16_t*)(p->ws + WS_Z0); bf16_t* H = (bf16_t*)(p->ws + WS_H);
  const bf16_t* Wg = (const bf16_t*)(p->ws + WS_WB) + W0_G;
  const float* LS8 = (const float*)(p->ws + WS_LS8);
  float2* SUM = (float2*)(p->ws + WS_SUM);
  float* xrL = (float*)dyn_shm;
  float* xc = xrL + 67 * 64;
  bf16_t* xcb = (bf16_t*)(xc + 64 * 64);
  float* Hs = (float*)(xcb + 64 * 72);
  const int tid = tid_(), lane = tid & 63, fr = lane & 15, fq = lane >> 4;
  const int wid = __builtin_amdgcn_readfirstlane(tid >> 6), dir = wid >> 2, wq = wid & 3;
  const int t0 = cidx * 64;
  int s0, s1, bsamp = -1;
  if (t0 < MP) { s0 = (t0 / SEQ) * SEQ; s1 = s0 + SEQ; } else { bsamp = (t0 - MP) / DSEQ; s0 = MP + bsamp * DSEQ; s1 = s0 + DSEQ; }
  const int c0 = s0 / 64, c1 = s1 / 64;
  const int chc = tid & 63, cgc = nb * 64 + chc;
  const int ch = wq * 16 + fr, cg_ = nb * 64 + ch;
  const int oq = dir ? 3 - fq : fq, stepl = dir ? -16 : 16, lastl = fr + (dir ? 0 : 48);
  unsigned xv[5];
#pragma unroll
  for (int i = 0; i < 5; ++i) { int e = tid + i * 512; int r = e >> 5, c2 = (e & 31) * 2, t = t0 - 2 + r;
    xv[i] = (e < 67 * 32 && t >= s0 && t < s1) ? *(const unsigned*)(Z0 + (size_t)t * 1536 + nb * 64 + c2) : 0u; }
  const float* cw = p->in[12];
  const float w0 = cw[cgc], w1 = cw[512 + cgc], w2 = cw[1024 + cgc], w3 = cw[1536 + cgc], bb = p->in[13][cgc];
  const float ba = -1.4426950408889634f * p->in[15][dir * 512 + cg_], bi = -1.4426950408889634f * p->in[17][dir * 512 + cg_], l8 = LS8[dir * 512 + cg_];
  bf16x8 wa[2], wi[2];
  { const bf16_t* pa = Wg + (size_t)((dir * 2 + 0) * 8 + nb) * 4096 + (size_t)ch * 64 + fq * 8; const bf16_t* pi = pa + 8 * 4096;
    wa[0] = *(const bf16x8*)pa; wa[1] = *(const bf16x8*)(pa + 32); wi[0] = *(const bf16x8*)pi; wi[1] = *(const bf16x8*)(pi + 32); }
  unsigned gz[4] = {0u, 0u, 0u, 0u};
  if (mode == 1) {
#pragma unroll
    for (int i = 0; i < 4; ++i) { int e = tid + i * 512; int t = e >> 5, c2 = (e & 31) * 2; gz[i] = *(const unsigned*)(Z0 + (size_t)(t0 + t) * 1536 + 512 + nb * 64 + c2); }
  }
  float cP = 1.f, cH = 0.f;
  if (mode == 1) {
    int lo, hi;
    if (dir == 0) { const int n = cidx - c0, q = (n + 3) >> 2; lo = c0 + fq * q; hi = lo + q < cidx ? lo + q : cidx;
      for (int c = lo; c < hi; c += 4) { float2 sm[4];
#pragma unroll
        for (int j = 0; j < 4; ++j) sm[j] = (c + j < hi) ? SUM[((size_t)(c + j) * 2) * 512 + cg_] : make_float2(1.f, 0.f);
#pragma unroll
        for (int j = 0; j < 4; ++j) { cH = sm[j].x * cH + sm[j].y; cP *= sm[j].x; } }
    } else { const int n = c1 - 1 - cidx, q = (n + 3) >> 2; hi = c1 - 1 - fq * q; lo = hi - q > cidx ? hi - q : cidx;
      for (int c = hi; c > lo; c -= 4) { float2 sm[4];
#pragma unroll
        for (int j = 0; j < 4; ++j) sm[j] = (c - j > lo) ? SUM[((size_t)(c - j) * 2 + 1) * 512 + cg_] : make_float2(1.f, 0.f);
#pragma unroll
        for (int j = 0; j < 4; ++j) { cH = sm[j].x * cH + sm[j].y; cP *= sm[j].x; } }
    }
  }
  __syncthreads();
#pragma unroll
  for (int i = 0; i < 5; ++i) { int e = tid + i * 512; if (e < 67 * 32) { int r = e >> 5, c2 = (e & 31) * 2;
    xrL[r * 64 + c2] = bf2f((bf16_t)(xv[i] & 0xffff)); xrL[r * 64 + c2 + 1] = bf2f((bf16_t)(xv[i] >> 16)); } }
  __syncthreads();
#pragma unroll
  for (int i = 0; i < 8; ++i) { int t = (tid >> 6) + 8 * i;
    float v = bb + w0 * xrL[t * 64 + chc] + w1 * xrL[(t + 1) * 64 + chc] + w2 * xrL[(t + 2) * 64 + chc] + w3 * xrL[(t + 3) * 64 + chc];
    xc[t * 64 + chc] = v; xcb[t * 72 + chc] = f2bf(v); }
  __syncthreads();
  float av[4][4], uv[4][4], Pt[4], Ht[4], Pe[4], He[4];
#pragma unroll
  for (int mt = 0; mt < 4; ++mt) {
    const bf16x8 a0 = *(const bf16x8*)(xcb + (mt * 16 + fr) * 72 + fq * 8), a1 = *(const bf16x8*)(xcb + (mt * 16 + fr) * 72 + 32 + fq * 8);
    f32x4 ga = {0.f, 0.f, 0.f, 0.f}, gi = {0.f, 0.f, 0.f, 0.f};
    ga = __builtin_amdgcn_mfma_f32_16x16x32_bf16(a0, wa[0], ga, 0, 0, 0); ga = __builtin_amdgcn_mfma_f32_16x16x32_bf16(a1, wa[1], ga, 0, 0, 0);
    gi = __builtin_amdgcn_mfma_f32_16x16x32_bf16(a0, wi[0], gi, 0, 0, 0); gi = __builtin_amdgcn_mfma_f32_16x16x32_bf16(a1, wi[1], gi, 0, 0, 0);
#pragma unroll
    for (int j = 0; j < 4; ++j) {
      const float ea = 1.f + __builtin_amdgcn_exp2f(fminf(ga[j] + ba, 57.f)), ei = 1.f + __builtin_amdgcn_exp2f(fminf(gi[j] + bi, 57.f));
      const float rc = __builtin_amdgcn_rcpf(ea * ei);
      const float r = rc * ei, ii = rc * ea;
      const float l2 = r * l8;
      const float a = __builtin_amdgcn_exp2f(l2);
      const float x2 = l2 * (2.f * 0.6931471805599453f);
      const float ser = -x2 * fmaf(x2, fmaf(x2, fmaf(x2, fmaf(x2, fmaf(x2, 1.f / 720.f, 1.f / 120.f), 1.f / 24.f), 1.f / 6.f), 0.5f), 1.f);
      const float om = x2 > -0.25f ? ser : 1.f - a * a;
      av[mt][j] = a; uv[mt][j] = __builtin_amdgcn_sqrtf(om) * ii * xc[(mt * 16 + fq * 4 + j) * 64 + ch];
    }
    float P = 1.f, Hh = 0.f;
    if (dir == 0) {
#pragma unroll
      for (int j = 0; j < 4; ++j) { Hh = av[mt][j] * Hh + uv[mt][j]; P *= av[mt][j]; }
    } else {
#pragma unroll
      for (int j = 3; j >= 0; --j) { Hh = av[mt][j] * Hh + uv[mt][j]; P *= av[mt][j]; }
    }
    scan4(P, Hh, lane, stepl, oq);
    const float Pp = bperm(lane - stepl, P), Hp = bperm(lane - stepl, Hh);
    Pe[mt] = oq >= 1 ? Pp : 1.f; He[mt] = oq >= 1 ? Hp : 0.f;
    Pt[mt] = bperm(lastl, P); Ht[mt] = bperm(lastl, Hh);
  }
  if (mode == 0) {
    float P = 1.f, Hh = 0.f;
    if (dir == 0) {
#pragma unroll
      for (int mt = 0; mt < 4; ++mt) { Hh = Pt[mt] * Hh + Ht[mt]; P *= Pt[mt]; }
    } else {
#pragma unroll
      for (int mt = 3; mt >= 0; --mt) { Hh = Pt[mt] * Hh + Ht[mt]; P *= Pt[mt]; }
    }
    if (fq == 0) SUM[((size_t)cidx * 2 + dir) * 512 + cg_] = make_float2(P, Hh);
    return;
  }
  scan4(cP, cH, lane, 16, fq);
  const float tP = bperm(fr + 48, cP), tH = bperm(fr + 48, cH);
  float c = bsamp >= 0 ? p->in[2][(bsamp * 2 + dir) * 512 + cg_] : 0.f;
  c = tP * c + tH;
  float* hp = Hs + dir * 4096 + ch;
  if (dir == 0) {
#pragma unroll
    for (int mt = 0; mt < 4; ++mt) { float s = Pe[mt] * c + He[mt];
#pragma unroll
      for (int j = 0; j < 4; ++j) { s = av[mt][j] * s + uv[mt][j]; hp[(mt * 16 + fq * 4 + j) * 64] = s; }
      c = Pt[mt] * c + Ht[mt]; }
    if (bsamp < 0 && cidx == c1 - 1 && fq == 0) p->out[O_LRU + (size_t)((t0 / SEQ) * 2 + 0) * 512 + cg_] = c;
  } else {
#pragma unroll
    for (int mt = 3; mt >= 0; --mt) { float s = Pe[mt] * c + He[mt];
#pragma unroll
      for (int j = 3; j >= 0; --j) { s = av[mt][j] * s + uv[mt][j]; hp[(mt * 16 + fq * 4 + j) * 64] = s; }
      c = Pt[mt] * c + Ht[mt]; }
    if (bsamp < 0 && cidx == c0 && fq == 0) p->out[O_LRU + (size_t)((t0 / SEQ) * 2 + 1) * 512 + cg_] = c;
  }
  __syncthreads();
#pragma unroll
  for (int i = 0; i < 4; ++i) { int e = tid + i * 512; int t = e >> 5, c2 = (e & 31) * 2;
    float g0 = bf2f((bf16_t)(gz[i] & 0xffff)), g1 = bf2f((bf16_t)(gz[i] >> 16));
    float y0 = (Hs[t * 64 + c2] + Hs[4096 + t * 64 + c2]) * fast_gelu(g0);
    float y1 = (Hs[t * 64 + c2 + 1] + Hs[4096 + t * 64 + c2 + 1]) * fast_gelu(g1);
    *(unsigned*)(H + (size_t)(t0 + t) * DM + nb * 64 + c2) = cvtpk(y0, y1); }
}

__device__ void pool_item(KP p, int cidx, int gi) {
  const bf16_t* Z0 = (const bf16_t*)(p->ws + WS_Z0); bf16_t* H = (bf16_t*)(p->ws + WS_H);
  const bf16_t* Wp = (const bf16_t*)(p->ws + WS_WB) + W0_P + (size_t)gi * 16384;
  float* xp = (float*)dyn_shm;
  bf16_t* dL = (bf16_t*)(xp + 80 * 128);
  const int tid = tid_(), wid = tid >> 6, lane = tid & 63, fr = lane & 15, fq = lane >> 4;
  const int t0 = cidx * 64;
  int s0, s1;
  if (t0 < MP) { s0 = (t0 / SEQ) * SEQ; s1 = s0 + SEQ; } else { int b = (t0 - MP) / DSEQ; s0 = MP + b * DSEQ; s1 = s0 + DSEQ; }
  __syncthreads();
  for (int e = tid; e < 80 * 64; e += 512) { int r = e >> 6, c2 = (e & 63) * 2, t = t0 - 8 + r;
    float a = 0.f, b = 0.f;
    if (t >= s0 && t < s1) { unsigned v = *(const unsigned*)(Z0 + (size_t)t * 1536 + 1024 + gi * 128 + c2); a = bf2f((bf16_t)(v & 0xffff)); b = bf2f((bf16_t)(v >> 16)); }
    xp[r * 128 + c2] = a; xp[r * 128 + c2 + 1] = b; }
  __syncthreads();
  const int w = 2 << gi, left = w >> 1, right = w - 1 - left;
  {
    const int c = tid & 127, tq = tid >> 7, tb = tq * 16;
    float S = 0.f;
    for (int k = tb - left; k <= tb + right; ++k) S += xp[(k + 8) * 128 + c];
#pragma unroll
    for (int i = 0; i < 16; ++i) { const int t = tb + i, tg = t0 + t;
      const int lo = tg - left < s0 ? s0 : tg - left, hi = tg + right > s1 - 1 ? s1 - 1 : tg + right;
      const float d = S * __builtin_amdgcn_rcpf((float)(hi - lo + 1)) - xp[(t + 8) * 128 + c];
      dL[t * 136 + c] = f2bf(d);
      S += xp[(t + 1 + right + 8) * 128 + c] - xp[(t - left + 8) * 128 + c]; }
  }
  __syncthreads();
  {
    bf16x8 wf[4];
#pragma unroll
    for (int ks = 0; ks < 4; ++ks) wf[ks] = *(const bf16x8*)(Wp + (size_t)(wid * 16 + fr) * 128 + ks * 32 + fq * 8);
    const f32x4 sc = *(const f32x4*)(p->in[20] + gi * 128 + wid * 16 + fq * 4);
#pragma unroll
    for (int mt = 0; mt < 4; ++mt) {
      f32x4 acc = {0.f, 0.f, 0.f, 0.f};
#pragma unroll
      for (int ks = 0; ks < 4; ++ks) {
        bf16x8 df = *(const bf16x8*)(dL + (mt * 16 + fr) * 136 + ks * 32 + fq * 8);
        acc = __builtin_amdgcn_mfma_f32_16x16x32_bf16(wf[ks], df, acc, 0, 0, 0);
      }
      acc = acc * sc;
      u32x2 o; o.x = cvtpk(acc[0], acc[1]); o.y = cvtpk(acc[2], acc[3]);
      *(u32x2*)(H + (size_t)(t0 + mt * 16 + fr) * DM + 512 + gi * 128 + wid * 16 + fq * 4) = o;
    }
  }
}

__global__ void __launch_bounds__(512, 2) fwd_megakernel(Params kparams) {
  cg::grid_group grid = cg::this_grid();
  KP p = (KP)__builtin_amdgcn_kernarg_segment_ptr();
  unsigned char* ws = p->ws;
  bf16_t* WB = (bf16_t*)(ws + WS_WB);
  bf16_t* H = (bf16_t*)(ws + WS_H);
  float* X = p->out;
  const float* MOD = (const float*)(ws + WS_MOD);
  volatile LAS unsigned* xst = (volatile LAS unsigned*)(dyn_shm + LDS_MAIN);
  if (threadIdx.x == 0) { xst[0] = 0u; xst[1] = 0u; }
  __syncthreads();
  (void)xcd_barrier_post((unsigned*)(ws + WS_BAR), xst);
  int rep = 0;
  const int p_lo = p->p_lo, p_hi = p->p_hi, probe = p->pad, coop = p->coop;
  for (int ph = p_lo; ph < p_hi; ++ph) {
    asm volatile("" : "+s"(p));
    const int G = gdim_(), bid = bid_();
    unsigned char* ws = p->ws; bf16_t* WB = (bf16_t*)(ws + WS_WB); bf16_t* H = (bf16_t*)(ws + WS_H); float* X = p->out; const float* MOD = (const float*)(ws + WS_MOD);
#if PROBE_PH >= 0
    const int dry = (ph == probe && rep == 0) ? 1 : 0;
#else
    const int dry = 0;
#endif
    if (PROBE_PH == 99 && probe == 99 && ph == 1) { XcdBarrier xb; xb.bar = (unsigned*)(ws + WS_BAR); xb.st = (volatile LAS unsigned*)(dyn_shm + LDS_MAIN); for (int q = 0; q < 10; ++q) xcd_barrier(xb); }
    GemmDesc g1{nullptr, nullptr, 0, 0, 0, 0, 0, 0, nullptr, 0, nullptr, nullptr, nullptr, 0, 0};
    bool isg = false;
    const float* MODL = MOD + (ph >= 11 ? 5 * 6144 : 0);
    const bf16_t* U = (const bf16_t*)(ws + WS_U);
    switch (ph) {
      case 0: {
        for (int it = bid; it < 192; it += G) mod_gemv_item(p, it);
        if (bid == G - 1) { int t = tid_(); int pos = t >> 3, j = t & 7;
          float inv = exp2f(-(float)j * 0.125f * 13.287712379549449f);
          float s, c; my_sincos((float)pos * inv, s, c);
          float* rt = (float*)(ws + WS_ROPE); rt[t * 2] = c; rt[t * 2 + 1] = s; }
        if (bid == G - 2) { int t = tid_(); float* l8 = (float*)(ws + WS_LS8);
          for (int e = t; e < 1024; e += 512) l8[e] = -8.f * 1.4426950408889634f * log1pf(__expf(-p->in[18][e])); }
      } break;
      case 2: g1 = GemmDesc{H, WB + W0_IN, 1024, 1024, M, 1536, 1024, 0, ws + WS_Z0, 1536, nullptr, nullptr, nullptr, 0, 0}; isg = true; break;
      case 5: g1 = GemmDesc{H, WB + W0_OUT, 1024, 1024, M, 1024, 1024, 2, X, 1024, p->in[0], p->in[1], MOD + 2 * 1024, 0, 0}; isg = true; break;
      case 7: case 9: case 19: case 21: { int ro = (ph == 7 || ph == 19) ? 0 : MH;
        g1 = GemmDesc{H + (size_t)ro * DM, WB + (ph < 11 ? W0_W1 : W1_W1), 1024, 1024, MH, 4096, 1024, 1, ws + WS_U, 4096, nullptr, nullptr, nullptr, 0, 0}; isg = true; } break;
      case 8: case 10: case 20: case 22: { int ro = (ph == 8 || ph == 20) ? 0 : MH;
        g1 = GemmDesc{U, WB + (ph < 11 ? W0_W2 : W1_W2), 4096, 4096, MH, 1024, 4096, 2, X, 1024, X, X + (size_t)MP * DM, MODL + 5 * 1024, ro, 0}; isg = true; } break;
      case 12: g1 = GemmDesc{H, WB + W1_IN, 1024, 1024, M, 768, 1024, 0, ws + WS_Z1, 768, nullptr, nullptr, nullptr, 0, 0}; isg = true; break;
      case 13: l1_rows_phase(p); break;
      case 14: g1 = GemmDesc{(const bf16_t*)(ws + WS_CQN), WB + W1_QB, 384, 384, M, 1536, 384, 0, ws + WS_Q, 1536, nullptr, nullptr, nullptr, 0, 0}; isg = true; break;
      case 15: g1 = GemmDesc{(const bf16_t*)(ws + WS_CKVN), WB + W1_KVB, 256, 256, KROWS, 2048, 256, 0, ws + WS_KV, 2048, nullptr, nullptr, nullptr, 0, 0}; isg = true; break;
#ifndef NO_ATTN
      case 16: attn_phase(p, dry); break;
#endif
      case 17: g1 = GemmDesc{(const bf16_t*)(ws + WS_Q), WB + W1_OUT, 1536, 1024, M, 1024, 1024, 2, X, 1024, X, X + (size_t)MP * DM, MODL + 2 * 1024, 0, 0}; isg = true; break;
      case 23: final_norm_phase(p, dry); break;
      default: break;
    }
    if (ph == 1 || ph == 6 || ph == 11 || ph == 18) {
      const bool first = ph == 1;
      modulate_phase(p, first ? p->in[0] : X, first ? p->in[1] : X + (size_t)MP * DM, p->in[ph == 1 ? 9 : ph == 6 ? 10 : ph == 11 ? 26 : 27], MODL, (ph == 1 || ph == 11) ? 0 : 3);
    }
    if (ph == 0 || ph == 11) cvt_weights(p, ph == 0 ? 0 : 1, ph == 0 ? (bid + G - 192 % G) % G : bid, G);
#ifndef NO_LRU
    if (ph == 3 || ph == 4) {
      const int nit = ph == 3 ? 3072 + 1536 : 3072;
      for (int it = bid; it < nit; it += G) { if (it < 3072) lru_item(p, it >> 3, it & 7, ph - 3); else pool_item(p, (it - 3072) >> 2, (it - 3072) & 3); }
    }
#endif
#ifndef NO_GEMM
    g1.dry = (dry && g1.mode == 2 && ph != 5) ? 1 : 0;
    if (isg) gemm_phase(g1);
#endif
    if (coop && ph + 1 < p_hi && ph != 14) {
      if (ph == 0 && !dry) grid.sync(); else { XcdBarrier xb; xb.bar = (unsigned*)(ws + WS_BAR); xb.st = (volatile LAS unsigned*)(dyn_shm + LDS_MAIN); xcd_barrier(xb); } }
#if PROBE_PH >= 0
    if (dry) { rep = 1; --ph; }
#endif
  }
}

#ifndef MK_SPLIT
#define MK_SPLIT 0
#endif
extern "C" void kernel_launch(void* const* d_in, const int* in_sizes, int n_in, void* d_out, int out_size, void* d_ws, size_t ws_size, hipStream_t stream) {
  static int grid = 0;
  if (grid == 0) {
    if (n_in != 37 || ws_size < WS_END) { fprintf(stderr, "kernel_launch: bad n_in %d or ws %zu < %zu\n", n_in, ws_size, (size_t)WS_END); grid = -1; return; }
    int dev = 0, cus = 0, per_cu = 0;
    hipGetDevice(&dev); hipDeviceGetAttribute(&cus, hipDeviceAttributeMultiprocessorCount, dev);
    if (hipFuncSetAttribute((const void*)fwd_megakernel, hipFuncAttributeMaxDynamicSharedMemorySize, LDS_BYTES) != hipSuccess) { fprintf(stderr, "kernel_launch: hipFuncSetAttribute failed\n"); grid = -1; return; }
    if (hipOccupancyMaxActiveBlocksPerMultiprocessor(&per_cu, (const void*)fwd_megakernel, 512, LDS_BYTES) != hipSuccess || per_cu < 1) { fprintf(stderr, "kernel_launch: occupancy query gave %d\n", per_cu); grid = -1; return; }
    grid = cus;
  }
  if (grid < 0) return;
  if (hipMemsetAsync((char*)d_ws + WS_BAR, 0, XCD_BAR_WORDS * 4, stream) != hipSuccess) { fprintf(stderr, "kernel_launch: memset failed\n"); return; }
  Params p{};
  for (int i = 0; i < 37; ++i) p.in[i] = (const float*)d_in[i];
  p.out = (float*)d_out; p.ws = (unsigned char*)d_ws; p.pad = PROBE_PH;
#if MK_SPLIT
  for (int ph = 0; ph < NPH; ++ph) {
    p.p_lo = ph; p.p_hi = ph + 1; p.coop = 0;
    hipLaunchKernelGGL(fwd_megakernel, dim3(grid), dim3(512), LDS_BYTES, stream, p);
  }
#else
  p.p_lo = 0; p.p_hi = NPH; p.coop = 1;
  void* args[] = {&p};
  hipError_t e = hipLaunchCooperativeKernel((const void*)fwd_megakernel, dim3(grid), dim3(512), args, LDS_BYTES, stream);
  if (e != hipSuccess) fprintf(stderr, "cooperative launch failed: %s (grid %d)\n", hipGetErrorString(e), grid);
#endif
}
```

```cpp
#include <hip/hip_runtime.h>
#include <hip/hip_cooperative_groups.h>
#include <cstdio>
#include <cstdint>
namespace cg = cooperative_groups;
#ifndef PROBE_PH
#define PROBE_PH -1
#endif

typedef unsigned short bf16_t;
typedef short bf16x8 __attribute__((ext_vector_type(8)));
typedef short s16x4 __attribute__((ext_vector_type(4)));
typedef float f32x4 __attribute__((ext_vector_type(4)));
typedef float f32x16 __attribute__((ext_vector_type(16)));
typedef unsigned u32x4 __attribute__((ext_vector_type(4)));
typedef unsigned u32x2 __attribute__((ext_vector_type(2)));

constexpr int DM = 1024, MP = 8192, MS = 16384, M = MP + MS, DFF = 4096;
constexpr int SEQ = 256, DSEQ = 4096, PAST = 512, NB_S = 4;
constexpr int KROWS = MP + NB_S * (DSEQ + PAST);
constexpr int SKEYS = DSEQ + PAST;
constexpr int MH = M / 2;
constexpr float EPS = 1e-6f;
constexpr int NPH = 24;

constexpr size_t MiB = 1u << 20;
constexpr size_t WS_MOD = 0;
constexpr size_t WS_ROPE = 256 * 1024;
constexpr size_t WS_LS8 = 260 * 1024;
constexpr size_t WS_SUM = 512 * 1024;
constexpr size_t WS_BAR = 3840 * 1024;
constexpr size_t WS_WB = 4 * MiB;
constexpr size_t WS_R1 = 26 * MiB;
constexpr size_t WS_H = WS_R1;
constexpr size_t WS_Z0 = WS_R1 + 48 * MiB;
constexpr size_t WS_U = WS_R1 + 48 * MiB;
constexpr size_t WS_KV = WS_R1;
constexpr size_t WS_Q = WS_R1 + 104 * MiB;
constexpr size_t WS_Z1 = WS_R1 + 104 * MiB;
constexpr size_t WS_CQN = WS_R1 + 176 * MiB;
constexpr size_t WS_CKVN = WS_R1 + 194 * MiB;
constexpr size_t WS_KPE = WS_R1 + 207 * MiB;
constexpr size_t WS_END = WS_R1 + 209 * MiB;
constexpr size_t W0_IN = 0, W0_OUT = 1572864, W0_W1 = 2621440, W0_W2 = 6815744, W0_G = 11010048, W0_P = 11141120;
constexpr size_t W1_IN = 0, W1_QB = 786432, W1_KVB = 1376256, W1_OUT = 1900544, W1_W1 = 2949120, W1_W2 = 7143424;
constexpr size_t O_Y = 0, O_LRU = 25165824, O_CKV = 25198592, O_KPE = 27295744;

struct Params {
  const float* in[37];
  float* out;
  unsigned char* ws;
  int p_lo, p_hi, coop, pad;
};

typedef const __attribute__((address_space(4))) Params* KP;
extern __shared__ __attribute__((aligned(16))) unsigned char dyn_shm[];
constexpr int LDS_MAIN = 139264;
constexpr int LDS_BYTES = LDS_MAIN + 16;

__device__ __forceinline__ unsigned cvtpk(float lo, float hi) {
  unsigned r; asm volatile("v_cvt_pk_bf16_f32 %0, %1, %2" : "=v"(r) : "v"(lo), "v"(hi)); return r;
}
__device__ __forceinline__ float bf2f(bf16_t b) { return __uint_as_float(((unsigned)b) << 16); }
__device__ __forceinline__ bf16_t f2bf(float f) { return (bf16_t)(cvtpk(f, f) & 0xffffu); }
__device__ __forceinline__ float sigmoidf_(float x) { return 1.f / (1.f + __expf(-x)); }
__device__ __forceinline__ float gelu_tanh(float x) {
  float u = 0.7978845608028654f * (x + 0.044715f * x * x * x);
  float e = __expf(2.f * u);
  float th = 1.f - 2.f / (e + 1.f);
  return 0.5f * x * (1.f + th);
}
__device__ __forceinline__ float lane_xor(float v, int lane, int o) { return __int_as_float(__builtin_amdgcn_ds_bpermute((lane ^ o) << 2, __float_as_int(v))); }
__device__ __forceinline__ float wave_sum(float v, int lane) {
#pragma unroll
  for (int o = 32; o > 0; o >>= 1) v += lane_xor(v, lane, o);
  return v;
}
__device__ __forceinline__ void my_sincos(float a, float& s, float& c) {
  float k = rintf(a * 0.63661977236758134f);
  float r = fmaf(k, -1.5707962513e+00f, a);
  r = fmaf(k, -7.5497894159e-08f, r);
  r = fmaf(k, -5.3903029534e-15f, r);
  float r2 = r * r;
  float sp = r + r * r2 * (-1.6666667163e-01f + r2 * (8.3333337680e-03f + r2 * (-1.9841270114e-04f + r2 * 2.7557314297e-06f)));
  float cp = 1.f + r2 * (-0.5f + r2 * (4.1666667908e-02f + r2 * (-1.3888889225e-03f + r2 * 2.4801587642e-05f)));
  int q = ((int)k) & 3;
  float ss = (q & 1) ? cp : sp, cc = (q & 1) ? sp : cp;
  s = (q & 2) ? -ss : ss;
  c = ((q + 1) & 2) ? -cc : cc;
}
__device__ __forceinline__ int bid_() { int b = blockIdx.x; asm volatile("" : "+s"(b)); return b; }
__device__ __forceinline__ int gdim_() { int g = gridDim.x; asm volatile("" : "+s"(g)); return g; }
__device__ __forceinline__ int tid_() { int t = threadIdx.x; asm volatile("" : "+v"(t)); return t; }
__device__ __forceinline__ int cond_of_row(int row) { return row < MP ? 0 : 1 + ((row - MP) >> 12); }


#define XB_TMO      128
#define XB_XCNT(j)  (256  + 64 * (j))
#define XB_XSUB(j)  (1280 + 64 * (j))
#define XB_XGEN(j)  (2304 + 64 * (j))
#define XB_TOP      3328
#define XB_TOPGEN   3392
#define XCD_BAR_WORDS 3456
#define XB_SPIN_CAP (1u << 20)
#define LAS __attribute__((address_space(3)))
__device__ __forceinline__ unsigned xb_ld(unsigned* p)              { return __hip_atomic_load(p, __ATOMIC_RELAXED, __HIP_MEMORY_SCOPE_AGENT); }
__device__ __forceinline__ unsigned xb_add(unsigned* p, unsigned v) { return __hip_atomic_fetch_add(p, v, __ATOMIC_RELAXED, __HIP_MEMORY_SCOPE_AGENT); }
__device__ __forceinline__ unsigned xb_xcc_id() { return (unsigned)__builtin_amdgcn_s_getreg((3 << 11) | 20) & 0xFu; }
#define XB_SPIN(cond, bar) do { unsigned _sp = 0; while (cond) { __builtin_amdgcn_s_sleep(1); \
    if ((++_sp & 255u) == 0u) { if (xb_ld(&(bar)[XB_TMO])) break; if (_sp > XB_SPIN_CAP) { atomicAdd(&(bar)[XB_TMO], 1u); break; } } } } while (0)
struct XcdBarrier { unsigned* bar; volatile LAS unsigned* st; };
__device__ __forceinline__ XcdBarrier xcd_barrier_post(unsigned* bar, volatile LAS unsigned* st) {
  XcdBarrier b; b.bar = bar; b.st = st;
  if (threadIdx.x == 0) (void)xb_add(&bar[XB_XCNT(xb_xcc_id())], 1u);
  return b;
}
__device__ __forceinline__ void xcd_barrier_complete(unsigned* bar, unsigned x, unsigned& nloc, unsigned& nx) {
  const unsigned G = (unsigned)gdim_();
  unsigned sum, cnt, mine, sp = 0u;
  for (;;) {
    sum = 0u; cnt = 0u; mine = 0u;
#pragma unroll
    for (unsigned j = 0; j < 16; ++j) { const unsigned c = xb_ld(&bar[XB_XCNT(j)]); sum += c; cnt += (c > 0u) ? 1u : 0u; mine = (j == x) ? c : mine; }
    if (sum == G) break;
    __builtin_amdgcn_s_sleep(1);
    if ((++sp & 255u) == 0u) { if (xb_ld(&bar[XB_TMO])) break; if (sp > XB_SPIN_CAP) { atomicAdd(&bar[XB_TMO], 1u); break; } }
  }
  nloc = mine > 0u ? mine : 1u; nx = cnt > 0u ? cnt : 1u;
}
__device__ __forceinline__ void xcd_barrier(const XcdBarrier& b) {
  asm volatile("s_waitcnt vmcnt(0)" ::: "memory");
  __syncthreads();
  if (threadIdx.x == 0) {
    unsigned* bar = b.bar; unsigned bx = xb_xcc_id(); asm volatile("" : "+s"(bx));
    __builtin_amdgcn_s_waitcnt(0);
    unsigned nloc = b.st[0], nx = b.st[1];
    if (nloc == 0u) { xcd_barrier_complete(bar, bx, nloc, nx); b.st[0] = nloc; b.st[1] = nx; }
    const unsigned old = xb_add(&bar[XB_XSUB(bx)], 1u);
    const unsigned gen = old / nloc;
    if (old + 1u == (gen + 1u) * nloc) {
      __builtin_amdgcn_fence(__ATOMIC_RELEASE, "agent");
      asm volatile("s_waitcnt vmcnt(0)" ::: "memory");
      const unsigned og = xb_add(&bar[XB_TOP], 1u);
      const unsigned tg = og / nx;
      if (og + 1u == (tg + 1u) * nx) xb_add(&bar[XB_TOPGEN], 1u);
      else XB_SPIN(xb_ld(&bar[XB_TOPGEN]) == tg, bar);
      __builtin_amdgcn_fence(__ATOMIC_ACQUIRE, "agent");
      xb_add(&bar[XB_XGEN(bx)], 1u);
      asm volatile("s_waitcnt vmcnt(0)" ::: "memory");
    } else {
      XB_SPIN(xb_ld(&bar[XB_XGEN(bx)]) == gen, bar);
      __builtin_amdgcn_fence(__ATOMIC_ACQUIRE, "agent");
      asm volatile("s_waitcnt vmcnt(0)" ::: "memory");
    }
  }
  __syncthreads();
}

constexpr int BM = 256, BK = 64, HALF = 128, HT = HALF * BK, NXCD = 8, WGM = 8;
__device__ __forceinline__ int lds_byte(int r, int c) {
  int st = (r >> 4) * 2 + (c >> 5), rr = r & 15, cc = c & 31, ob = rr * 64 + cc * 2;
  return st * 1024 + (ob ^ (((ob >> 9) & 1) << 5));
}
__device__ __forceinline__ void stage_rc(int b, int& R, int& C) {
  int st = b / 1024, sb = b % 1024, swz = sb ^ (((sb >> 9) & 1) << 5);
  R = (st >> 1) * 16 + swz / 64; C = (st & 1) * 32 + (swz % 64) / 2;
}

struct GemmDesc {
  const bf16_t* A; const bf16_t* Bt; int lda, ldb, Mrows, N, K;
  int mode;
  void* out; int ldc;
  const float* src0; const float* src1; const float* gate; int row_off; int dry;
};

__device__ __forceinline__ void gemm_epi(const GemmDesc& g, int row, int col, f32x4 v) {
#if PROBE_PH >= 0
  if (g.dry) return;
#endif
  if (g.mode == 0) {
    u32x2 w; w.x = cvtpk(v[0], v[1]); w.y = cvtpk(v[2], v[3]);
    *(u32x2*)((bf16_t*)g.out + (size_t)row * g.ldc + col) = w;
  } else if (g.mode == 1) {
    float a = fmaxf(v[0], 0.f), b = fmaxf(v[1], 0.f), c = fmaxf(v[2], 0.f), d = fmaxf(v[3], 0.f);
    u32x2 w; w.x = cvtpk(a * a, b * b); w.y = cvtpk(c * c, d * d);
    *(u32x2*)((bf16_t*)g.out + (size_t)row * g.ldc + col) = w;
  } else if (g.mode == 2) {
    int rg = row + g.row_off;
    const float* sp = rg < MP ? g.src0 + (size_t)rg * DM + col : g.src1 + (size_t)(rg - MP) * DM + col;
    f32x4 x = *(const f32x4*)sp;
    f32x4 gt = *(const f32x4*)(g.gate + cond_of_row(rg) * 6144 + col);
    *(f32x4*)((float*)g.out + (size_t)rg * DM + col) = x + gt * v;
  } else {
    *(f32x4*)((float*)g.out + (size_t)row * g.ldc + col) = v;
  }
}

template <int MF>
__device__ __forceinline__ void gemm_tile(const GemmDesc& g, int brow, int bcol) {
  constexpr int AH = MF * 32;
  bf16_t* shm = (bf16_t*)dyn_shm;
  const bf16_t* A = g.A; const bf16_t* Bt = g.Bt; const int lda = g.lda, ldb = g.ldb, K = g.K;
#define SA(b,h) (shm+((b)*2+(h))*HT)
#define SB(b,h) (shm+(4+(b)*2+(h))*HT)
#define STAGE(P,BASE,LD,VO,br,kt) do{const unsigned char* _ub=(const unsigned char*)(BASE)+((size_t)(br)*(LD)+(size_t)(kt)*BK)*2; \
    const unsigned char* _ub2=_ub+(size_t)(LD)*128; \
    const unsigned _m0=(unsigned)(uintptr_t)(__attribute__((address_space(3))) unsigned char*)((unsigned char*)(P))+ldsw; \
    asm volatile("s_mov_b32 m0, %0\n\ts_nop 0\n\tglobal_load_lds_dwordx4 %1, %2\n\ts_mov_b32 m0, %3\n\ts_nop 0\n\tglobal_load_lds_dwordx4 %1, %4" \
      :: "s"(_m0), "v"(VO), "s"(_ub), "s"(_m0+8192u), "s"(_ub2) : "m0", "memory");}while(0)
#define LDA(dst,b,h) for(int m=0;m<MF;++m)for(int k=0;k<2;++k) \
    dst[m][k]=*reinterpret_cast<const bf16x8*>((char*)SA(b,h)+lds_byte(wr*(MF*16)+m*16+fr,k*32+fq*8))
#define LDB(dst,b,h) for(int n=0;n<2;++n)for(int k=0;k<2;++k) \
    dst[n][k]=*reinterpret_cast<const bf16x8*>((char*)SB(b,h)+lds_byte(wc*32+n*16+fr,k*32+fq*8))
#define MMA(ai,bj,At,Bt_) do{__builtin_amdgcn_s_setprio(1); \
    for(int m=0;m<MF;++m)for(int n=0;n<2;++n)for(int k=0;k<2;++k) \
      acc[ai][bj][m][n]=__builtin_amdgcn_mfma_f32_16x16x32_bf16(Bt_[n][k],At[m][k],acc[ai][bj][m][n],0,0,0); \
    __builtin_amdgcn_s_setprio(0);}while(0)
#define WAIT_V(n) asm volatile("s_waitcnt vmcnt(" #n ")":::"memory")
#define WAIT_L(n) asm volatile("s_waitcnt lgkmcnt(" #n ")":::"memory")
#define BAR __builtin_amdgcn_s_barrier()
#define SCHED __builtin_amdgcn_sched_barrier(0)
  const int tid = tid_();
  const int wid = __builtin_amdgcn_readfirstlane(tid >> 6), lane = tid & 63, wr = wid >> 2, wc = wid & 3, fr = lane & 15, fq = lane >> 4;
  const unsigned ldsw = (unsigned)wid * 1024u;
  unsigned voA, voB;
  { int r_, c_; stage_rc(tid * 16, r_, c_); voA = (unsigned)(r_ * lda + c_) * 2u; voB = (unsigned)(r_ * ldb + c_) * 2u; }
  f32x4 acc[2][2][MF][2] = {};
  bf16x8 At[MF][2], B0[2][2], B1[2][2];
  const int nt = K / BK;
  __syncthreads();
  STAGE(SB(0,0),Bt,ldb,voB,bcol,0); STAGE(SA(0,0),A,lda,voA,brow,0);
  STAGE(SB(0,1),Bt,ldb,voB,bcol+HALF,0); STAGE(SA(0,1),A,lda,voA,brow+AH,0);
  STAGE(SB(1,0),Bt,ldb,voB,bcol,1); STAGE(SA(1,0),A,lda,voA,brow,1); STAGE(SB(1,1),Bt,ldb,voB,bcol+HALF,1);
  if(wr==1)BAR;
  WAIT_V(10); BAR;
  WAIT_V(6); BAR;
  for(int t=0;t<nt-2;t+=2){
    LDB(B0,0,0); SCHED; LDA(At,0,0); STAGE(SA(1,1),A,lda,voA,brow+AH,t+1);
    if (MF == 4) WAIT_L(8); else WAIT_L(6); BAR; WAIT_L(0); MMA(0,0,At,B0); BAR; SCHED;
    LDB(B1,0,1); STAGE(SB(0,0),Bt,ldb,voB,bcol,t+2);
    BAR; WAIT_L(0); MMA(0,1,At,B1); BAR;
    LDA(At,0,1); STAGE(SA(0,0),A,lda,voA,brow,t+2);
    BAR; WAIT_L(0); MMA(1,0,At,B0); BAR; SCHED;
    STAGE(SB(0,1),Bt,ldb,voB,bcol+HALF,t+2);
    WAIT_V(6); BAR; MMA(1,1,At,B1); BAR;
    LDB(B0,1,0); SCHED; LDA(At,1,0); STAGE(SA(0,1),A,lda,voA,brow+AH,t+2);
    if (MF == 4) WAIT_L(8); else WAIT_L(6); BAR; WAIT_L(0); MMA(0,0,At,B0); BAR; SCHED;
    LDB(B1,1,1); STAGE(SB(1,0),Bt,ldb,voB,bcol,t+3);
    BAR; WAIT_L(0); MMA(0,1,At,B1); BAR;
    LDA(At,1,1); STAGE(SA(1,0),A,lda,voA,brow,t+3);
    BAR; WAIT_L(0); MMA(1,0,At,B0); BAR; SCHED;
    STAGE(SB(1,1),Bt,ldb,voB,bcol+HALF,t+3);
    WAIT_V(6); BAR; MMA(1,1,At,B1); BAR;
  }
  { LDB(B0,0,0); LDA(At,0,0); STAGE(SA(1,1),A,lda,voA,brow+AH,nt-1);
    BAR; WAIT_L(0); MMA(0,0,At,B0); BAR;
    LDB(B1,0,1); BAR; WAIT_L(0); MMA(0,1,At,B1); BAR;
    LDA(At,0,1); WAIT_V(4); BAR; WAIT_L(0); MMA(1,0,At,B0); MMA(1,1,At,B1); BAR; }
  { LDB(B0,1,0); LDA(At,1,0); WAIT_V(2); BAR; WAIT_L(0); MMA(0,0,At,B0); BAR;
    LDB(B1,1,1); WAIT_V(0); BAR; WAIT_L(0); MMA(0,1,At,B1); BAR;
    LDA(At,1,1); BAR; WAIT_L(0); MMA(1,0,At,B0); MMA(1,1,At,B1); BAR; }
  if(wr==0)BAR;
  const int tid2 = tid_(); const int wid2 = tid2 >> 6, lane2 = tid2 & 63;
  if (g.mode <= 1) {
    unsigned char* st = dyn_shm;
    const int lrow = (wid2 >> 2) * (MF * 16) + (lane2 & 15), lcol = (wid2 & 3) * 32 + (lane2 >> 4) * 4;
    const bool sq = g.mode == 1;
#pragma unroll
    for(int ai=0;ai<2;++ai)
#pragma unroll
      for(int m=0;m<MF;++m)
#pragma unroll
        for(int bj=0;bj<2;++bj)
#pragma unroll
          for(int n=0;n<2;++n) {
            f32x4 v = acc[ai][bj][m][n];
            if (sq) { v[0] = fmaxf(v[0], 0.f); v[1] = fmaxf(v[1], 0.f); v[2] = fmaxf(v[2], 0.f); v[3] = fmaxf(v[3], 0.f); v = v * v; }
            u32x2 w; w.x = cvtpk(v[0], v[1]); w.y = cvtpk(v[2], v[3]);
            *(u32x2*)(st + (lrow + ai * AH + m * 16) * 544 + (lcol + bj * HALF + n * 16) * 2) = w;
          }
    __syncthreads();
#if PROBE_PH >= 0
    if (!g.dry)
#endif
    {
      bf16_t* ob = (bf16_t*)g.out + (size_t)brow * g.ldc + bcol;
      const int r0 = wid2 * (MF * 8) + (lane2 >> 5), c16 = (lane2 & 31);
#pragma unroll 4
      for (int i = 0; i < MF * 4; ++i) {
        const int r = r0 + 2 * i;
        u32x4 w = *(const u32x4*)(st + r * 544 + c16 * 16);
        *(u32x4*)(ob + (size_t)r * g.ldc + c16 * 8) = w;
      }
    }
  } else if (g.mode == 2) {
    unsigned char* st = dyn_shm;
    const int lr0 = (wid2 >> 2) * (MF * 16) + (lane2 & 15), lcol = (wid2 & 3) * 32 + (lane2 >> 4) * 4;
#pragma unroll
    for(int ai=0;ai<2;++ai) {
#pragma unroll
      for(int m=0;m<MF;++m)
#pragma unroll
        for(int bj=0;bj<2;++bj)
#pragma unroll
          for(int n=0;n<2;++n)
            *(f32x4*)(st + (lr0 + m * 16) * 1040 + (lcol + bj * HALF + n * 16) * 4) = acc[ai][bj][m][n];
      __syncthreads();
      {
        constexpr int RPW = MF * 4;
        const int rb = wid2 * RPW;
#pragma unroll
        for (int i0 = 0; i0 < RPW; i0 += 4) {
          f32x4 xv[4], gv[4]; int rgs[4];
#pragma unroll
          for (int i = 0; i < 4; ++i) { const int r = rb + i0 + i, rg = brow + ai * AH + r + g.row_off; rgs[i] = rg;
            xv[i] = *(const f32x4*)((rg < MP ? g.src0 + (size_t)rg * DM : g.src1 + (size_t)(rg - MP) * DM) + bcol + lane2 * 4);
            gv[i] = *(const f32x4*)(g.gate + cond_of_row(rg) * 6144 + bcol + lane2 * 4); }
#pragma unroll
          for (int i = 0; i < 4; ++i) { const int r = rb + i0 + i;
            const f32x4 v = *(const f32x4*)(st + r * 1040 + lane2 * 16);
            *(f32x4*)((float*)g.out + (size_t)rgs[i] * DM + bcol + lane2 * 4) = xv[i] + gv[i] * v; }
        }
      }
      __syncthreads();
    }
  } else {
  const int erow = brow + (wid2 >> 2) * (MF * 16) + (lane2 & 15), ecol = bcol + (wid2 & 3) * 32 + (lane2 >> 4) * 4;
#pragma unroll
  for(int ai=0;ai<2;++ai)
#pragma unroll
    for(int m=0;m<MF;++m)
#pragma unroll
      for(int bj=0;bj<2;++bj)
#pragma unroll
        for(int n=0;n<2;++n)
          gemm_epi(g, erow+ai*AH+m*16, ecol+bj*HALF+n*16, acc[ai][bj][m][n]);
  }
#undef SA
#undef SB
#undef STAGE
#undef LDA
#undef LDB
#undef MMA
}

__device__ __forceinline__ void tile_of(int L, int nM, int nN, int nwg, int th, int& brow, int& bcol) {
  int wgid = L;
  { const int q = nwg / NXCD, r = nwg % NXCD, xcd = wgid % NXCD, off = wgid / NXCD; wgid = (xcd < r ? xcd * (q + 1) : r * (q + 1) + (xcd - r) * q) + off; }
  const int nig = WGM * nN, gid = wgid / nig, fm = gid * WGM, gsz = (nM - fm) < WGM ? (nM - fm) : WGM;
  brow = (fm + ((wgid % nig) % gsz)) * th; bcol = ((wgid % nig) / gsz) * BM;
}
__device__ __forceinline__ void gemm_phase(const GemmDesc& g) {
  const int G = gdim_();
  const bool m3 = (g.Mrows % 192) == 0 && g.N <= 1536;
  const int th = m3 ? 192 : 256;
  const int nM = g.Mrows / th, nN = g.N / BM, nwg = nM * nN;
  for (int L = bid_(); L < nwg; L += G) {
    int brow, bcol; tile_of(L, nM, nN, nwg, th, brow, bcol);
    if (m3) gemm_tile<3>(g, brow, bcol); else gemm_tile<4>(g, brow, bcol);
  }
}

constexpr float ATT_SCALE = 0.10206207261596577f;
constexpr float ATT_THR = 8.f;
constexpr int SHM_V = 64 * 64 * 2, SHM_K = 64 * 128 * 2;
#define KSWZ(row, colB) ((row) * 256 + ((colB) ^ (((row) & 7) << 4)))
#define SBAR() __builtin_amdgcn_sched_barrier(0)
__device__ __forceinline__ int crow(int r, int hi) { return (r & 3) + 8 * (r >> 2) + 4 * hi; }

__device__ __forceinline__ void partialSM(f32x16& p0, f32x16& p1, float& m_reg, float& alpha, bool first) {
  constexpr float THRL = ATT_THR * 1.4426950408889634f;
  float pmax = p0[0];
#pragma unroll
  for (int r = 1; r < 16; ++r) pmax = fmaxf(pmax, p0[r]);
#pragma unroll
  for (int r = 0; r < 16; ++r) pmax = fmaxf(pmax, p1[r]);
  { auto rr = __builtin_amdgcn_permlane32_swap(__float_as_uint(pmax), __float_as_uint(pmax), false, false);
    pmax = fmaxf(__uint_as_float(rr[0]), __uint_as_float(rr[1])); }
  if (first) {
    alpha = 0.f; m_reg = pmax;
#pragma unroll
    for (int r = 0; r < 16; ++r) p0[r] -= pmax;
#pragma unroll
    for (int r = 0; r < 16; ++r) p1[r] -= pmax;
  } else if (__builtin_expect(__all(pmax <= THRL), 1)) { alpha = 1.f; }
  else { const float d = fmaxf(pmax, 0.f); alpha = __builtin_amdgcn_exp2f(-d); m_reg += d;
#pragma unroll
    for (int r = 0; r < 16; ++r) p0[r] -= d;
#pragma unroll
    for (int r = 0; r < 16; ++r) p1[r] -= d;
  }
#pragma unroll
  for (int r = 0; r < 16; ++r) p0[r] = __builtin_amdgcn_exp2f(p0[r]);
}
__device__ __forceinline__ void finishSM(f32x16& p0, f32x16& p1, float alpha, float& l_reg, bf16x8& pa0, bf16x8& pa1, bf16x8& pa2, bf16x8& pa3) {
#pragma unroll
  for (int r = 0; r < 16; ++r) p1[r] = __builtin_amdgcn_exp2f(p1[r]);
  float ps = 0;
#pragma unroll
  for (int r = 0; r < 16; ++r) ps += p0[r];
#pragma unroll
  for (int r = 0; r < 16; ++r) ps += p1[r];
  { auto rr = __builtin_amdgcn_permlane32_swap(__float_as_uint(ps), __float_as_uint(ps), false, false);
    ps = __uint_as_float(rr[0]) + __uint_as_float(rr[1]); }
  l_reg = l_reg * alpha + ps;
#define PK4(P, BASE, OUT) do { unsigned a0 = cvtpk(P[BASE + 0], P[BASE + 1]), a1 = cvtpk(P[BASE + 2], P[BASE + 3]);   \
    unsigned b0 = cvtpk(P[BASE + 4], P[BASE + 5]), b1 = cvtpk(P[BASE + 6], P[BASE + 7]);                              \
    auto r0 = __builtin_amdgcn_permlane32_swap(a0, b0, false, false); auto r1 = __builtin_amdgcn_permlane32_swap(a1, b1, false, false); \
    u32x4 w = {r0[0], r1[0], r0[1], r1[1]}; OUT = *reinterpret_cast<bf16x8*>(&w); } while (0)
  PK4(p0, 0, pa0); PK4(p0, 8, pa1); PK4(p1, 0, pa2); PK4(p1, 8, pa3);
#undef PK4
}
__device__ __forceinline__ void qkt(f32x16& p0, f32x16& p1, const unsigned char* Ks, const bf16x8* qr, int r32, int hi, float init) {
#pragma unroll
  for (int r = 0; r < 16; ++r) { p0[r] = init; p1[r] = init; }
#pragma unroll
  for (int d0 = 0; d0 < 6; ++d0) { int cb = (d0 * 16 + hi * 8) * 2;
    bf16x8 b0 = *reinterpret_cast<const bf16x8*>(Ks + KSWZ(r32, cb));
    bf16x8 b1 = *reinterpret_cast<const bf16x8*>(Ks + KSWZ(32 + r32, cb));
    p0 = __builtin_amdgcn_mfma_f32_32x32x16_bf16(b0, qr[d0], p0, 0, 0, 0);
    p1 = __builtin_amdgcn_mfma_f32_32x32x16_bf16(b1, qr[d0], p1, 0, 0, 0); }
}
__device__ __forceinline__ int v_st(int k, int c) { const int kk = (k & ~0xC) | ((k & 4) << 1) | ((k & 8) >> 1); return ((kk >> 3) * 2 + (c >> 5)) * 512 + ((kk & 7) * 32 + (c & 31)) * 2; }
__device__ __forceinline__ int v_rd_base(int lane) { return ((lane & 3) << 3) | (((lane >> 2) & 3) << 6) | (((lane >> 4) & 1) << 5) | (((lane >> 5) & 1) << 8); }
constexpr int v_rd_off(int d0, int ks, int half) { return d0 * 512 + ks * 2048 + half * 1024; }
template <int OFF> __device__ __forceinline__ s16x4 tr_read(int vb) {
  s16x4 r; asm volatile("ds_read_b64_tr_b16 %0, %1 offset:%2" : "=&v"(r) : "v"(vb), "i"(OFF) : "memory"); return r;
}
__device__ __forceinline__ void pv_d0(f32x16* o, int vb, bf16x8 pa0, bf16x8 pa1, bf16x8 pa2, bf16x8 pa3) {
  const s16x4 l0 = tr_read<v_rd_off(0, 0, 0)>(vb), h0 = tr_read<v_rd_off(0, 0, 1)>(vb), l1 = tr_read<v_rd_off(0, 1, 0)>(vb), h1 = tr_read<v_rd_off(0, 1, 1)>(vb);
  const s16x4 l2 = tr_read<v_rd_off(0, 2, 0)>(vb), h2 = tr_read<v_rd_off(0, 2, 1)>(vb), l3 = tr_read<v_rd_off(0, 3, 0)>(vb), h3 = tr_read<v_rd_off(0, 3, 1)>(vb);
  const s16x4 m0 = tr_read<v_rd_off(1, 0, 0)>(vb), n0 = tr_read<v_rd_off(1, 0, 1)>(vb), m1 = tr_read<v_rd_off(1, 1, 0)>(vb), n1 = tr_read<v_rd_off(1, 1, 1)>(vb);
  const s16x4 m2 = tr_read<v_rd_off(1, 2, 0)>(vb), n2 = tr_read<v_rd_off(1, 2, 1)>(vb), m3 = tr_read<v_rd_off(1, 3, 0)>(vb), n3 = tr_read<v_rd_off(1, 3, 1)>(vb);
  asm volatile("s_waitcnt lgkmcnt(0)" ::: "memory"); SBAR();
#define PK(L, H) (bf16x8){L[0], L[1], L[2], L[3], H[0], H[1], H[2], H[3]}
  o[0] = __builtin_amdgcn_mfma_f32_32x32x16_bf16(pa0, PK(l0, h0), o[0], 0, 0, 0);
  o[1] = __builtin_amdgcn_mfma_f32_32x32x16_bf16(pa0, PK(m0, n0), o[1], 0, 0, 0);
  o[0] = __builtin_amdgcn_mfma_f32_32x32x16_bf16(pa1, PK(l1, h1), o[0], 0, 0, 0);
  o[1] = __builtin_amdgcn_mfma_f32_32x32x16_bf16(pa1, PK(m1, n1), o[1], 0, 0, 0);
  o[0] = __builtin_amdgcn_mfma_f32_32x32x16_bf16(pa2, PK(l2, h2), o[0], 0, 0, 0);
  o[1] = __builtin_amdgcn_mfma_f32_32x32x16_bf16(pa2, PK(m2, n2), o[1], 0, 0, 0);
  o[0] = __builtin_amdgcn_mfma_f32_32x32x16_bf16(pa3, PK(l3, h3), o[0], 0, 0, 0);
  o[1] = __builtin_amdgcn_mfma_f32_32x32x16_bf16(pa3, PK(m3, n3), o[1], 0, 0, 0);
#undef PK
}

__device__ __forceinline__ void attn_unit(bf16_t* Qrows, int h, const bf16_t* KVb, const bf16_t* KPb, int nkeys, bool rope, int s0, const float* ropetab, int dry) {
  unsigned char* lds = dyn_shm;
  const int tid = tid_(), wid = tid >> 6, lane = tid & 63, r32 = lane & 31, hi = lane >> 5;
  unsigned char* V_lds = lds; unsigned char* K_lds = lds + 3 * SHM_V;
  float* ws = (float*)(lds + 3 * SHM_V + 3 * SHM_K) + wid * 64; float* li_l = ws; float* al_l = ws + 32;
  float m_reg = -1e30f, l_reg = 0; f32x16 o[2] = {}; bf16x8 qr[6];
  __syncthreads();
  {
    const int row = wid * 32 + r32;
    const bf16_t* Qn = Qrows + (size_t)row * 1536 + h * 64 + hi * 8;
#pragma unroll
    for (int d0 = 0; d0 < 4; ++d0) qr[d0] = *reinterpret_cast<const bf16x8*>(Qn + d0 * 16);
    const bf16_t* Qp = Qrows + (size_t)row * 1536 + 1024 + h * 32;
    const int s = s0 + row;
#pragma unroll
    for (int blk = 0; blk < 2; ++blk) {
      bf16x8 x1 = *reinterpret_cast<const bf16x8*>(Qp + blk * 16), x2 = *reinterpret_cast<const bf16x8*>(Qp + blk * 16 + 8);
      if (rope) {
        const int pos = blk == 0 ? (s >> 6) : (s & 63);
        const float* tb = ropetab + pos * 16;
        float ov[8];
#pragma unroll
        for (int j = 0; j < 8; ++j) {
          float a = bf2f((bf16_t)x1[j]), b = bf2f((bf16_t)x2[j]), cs = tb[2 * j], sn = tb[2 * j + 1];
          ov[j] = hi == 0 ? a * cs - b * sn : b * cs + a * sn;
        }
        u32x4 w = {cvtpk(ov[0], ov[1]), cvtpk(ov[2], ov[3]), cvtpk(ov[4], ov[5]), cvtpk(ov[6], ov[7])};
        qr[4 + blk] = *reinterpret_cast<bf16x8*>(&w);
      } else {
        qr[4 + blk] = hi == 0 ? x1 : x2;
      }
    }
  }
  const int vrow = tid >> 3, vc = (tid & 7) * 8, vst = v_st(vrow, vc);
  const bf16_t* vsrc = KVb + (size_t)vrow * 2048 + h * 128 + 64 + vc;
  const bool kact = tid < 384;
  const int kr = kact ? tid / 12 : 0, kc = kact ? (tid % 12) * 8 : 0;
  const bf16_t* ksrc = kc < 64 ? KVb + (size_t)kr * 2048 + h * 128 + kc : KPb + (size_t)kr * 32 + (kc - 64);
  const long kstride = kc < 64 ? 2048 : 32;
  const int kst0 = KSWZ(kr, kc * 2), kst1 = KSWZ(32 + kr, kc * 2);
  const int vb0 = (int)(uintptr_t)V_lds + v_rd_base(lane);
  struct { bf16x8 vs, ks0, ks1; } sr_[2];
#define SLOAD(i, k0) do { sr_[i].vs = *reinterpret_cast<const bf16x8*>(vsrc + (size_t)(k0) * 2048); \
    if (kact) { sr_[i].ks0 = *reinterpret_cast<const bf16x8*>(ksrc + (long)(k0) * kstride); sr_[i].ks1 = *reinterpret_cast<const bf16x8*>(ksrc + (long)((k0) + 32) * kstride); } } while (0)
#define SWRITE(b, i) do { *(bf16x8*)(V_lds + (b) * SHM_V + vst) = sr_[i].vs; \
    if (kact) { *(bf16x8*)(K_lds + (b) * SHM_K + kst0) = sr_[i].ks0; *(bf16x8*)(K_lds + (b) * SHM_K + kst1) = sr_[i].ks1; } } while (0)
#define RESC(a) do { if (__any((a) < 1.f)) { if (hi == 0) al_l[r32] = (a); asm volatile("s_waitcnt lgkmcnt(0)" ::: "memory"); \
    for (int d = 0; d < 2; ++d) for (int r = 0; r < 16; ++r) o[d][r] *= al_l[crow(r, hi)]; } } while (0)
  f32x16 pA0, pA1, pB0, pB1; float alA, alB; bf16x8 pa0, pa1, pa2, pa3; const int NT = nkeys / 64;
  constexpr int SE = 0, SO = 1;
  SLOAD(SE, 0); SWRITE(0, SE); SLOAD(SO, 64); __syncthreads();
  qkt(pA0, pA1, K_lds, qr, r32, hi, 0.f); partialSM(pA0, pA1, m_reg, alA, true);
  SWRITE(1, SO); if (2 < NT) SLOAD(SE, 128);
  int bc = 1;
  for (int j = 1; j + 1 < NT; j += 2) {
    const int bp = bc == 0 ? 2 : bc - 1, bn = bc == 2 ? 0 : bc + 1;
    __syncthreads();
    SBAR(); qkt(pB0, pB1, K_lds + bc * SHM_K, qr, r32, hi, -m_reg);
    finishSM(pA0, pA1, alA, l_reg, pa0, pa1, pa2, pa3); SBAR();
    SLOAD(SO, (j + 2) * 64); SBAR();
    pv_d0(o, vb0 + bp * SHM_V, pa0, pa1, pa2, pa3); partialSM(pB0, pB1, m_reg, alB, false);
    SWRITE(bn, SE);
    RESC(alB);
    __syncthreads();
    SBAR(); qkt(pA0, pA1, K_lds + bn * SHM_K, qr, r32, hi, -m_reg);
    finishSM(pB0, pB1, alB, l_reg, pa0, pa1, pa2, pa3); SBAR();
    if (j + 3 < NT) SLOAD(SE, (j + 3) * 64); SBAR();
    pv_d0(o, vb0 + bc * SHM_V, pa0, pa1, pa2, pa3); partialSM(pA0, pA1, m_reg, alA, false);
    SWRITE(bp, SO);
    RESC(alA);
    bc = bp;
  }
  { const int bp = bc == 0 ? 2 : bc - 1;
    __syncthreads();
    SBAR(); qkt(pB0, pB1, K_lds + bc * SHM_K, qr, r32, hi, -m_reg);
    finishSM(pA0, pA1, alA, l_reg, pa0, pa1, pa2, pa3); SBAR();
    pv_d0(o, vb0 + bp * SHM_V, pa0, pa1, pa2, pa3); partialSM(pB0, pB1, m_reg, alB, false);
    RESC(alB);
    finishSM(pB0, pB1, alB, l_reg, pa0, pa1, pa2, pa3); SBAR();
    pv_d0(o, vb0 + bc * SHM_V, pa0, pa1, pa2, pa3); }
  if (hi == 0) li_l[r32] = l_reg; asm volatile("s_waitcnt lgkmcnt(0)" ::: "memory");
  float rli[16];
#pragma unroll
  for (int r = 0; r < 16; ++r) rli[r] = __builtin_amdgcn_rcpf(li_l[crow(r, hi)]);
  bf16_t* Ow = Qrows + (size_t)(wid * 32) * 1536 + h * 64;
  if (!dry)
#pragma unroll
  for (int r = 0; r < 16; ++r) { int orow = crow(r, hi);
#pragma unroll
    for (int d0 = 0; d0 < 2; ++d0) Ow[(size_t)orow * 1536 + d0 * 32 + r32] = f2bf(o[d0][r] * rli[r]); }
#undef SLOAD
#undef SWRITE
#undef RESC
}

__device__ __forceinline__ void attn_phase(KP p, int dry) {
  bf16_t* Q = (bf16_t*)(p->ws + WS_Q); const bf16_t* KV = (const bf16_t*)(p->ws + WS_KV); const bf16_t* KP = (const bf16_t*)(p->ws + WS_KPE);
  const float* ropetab = (const float*)(p->ws + WS_ROPE);
  const int xcd = bid_() & 7, slot = bid_() >> 3;
  const int G = gdim_();
  const int nit = G == 256 ? 6 : (1536 + G - 1) / G;
  for (int i = 0; i < nit; ++i) {
    int u;
    if (G == 256) u = i < 4 ? ((i * 16 + xcd * 2 + (slot >> 4)) << 4) + (slot & 15) : 1024 + (i - 4) * 256 + xcd * 32 + slot;
    else { u = bid_() + i * G; if (u >= 1536) break; }
    const bool samp = u < 1024;
    const int pair = samp ? u >> 4 : u - 1024, qb = samp ? u & 15 : 0, b = pair >> 4, h = pair & 15;
    const size_t qrow = samp ? (size_t)(MP + b * DSEQ + qb * 256) : (size_t)(b * SEQ);
    const size_t krow = samp ? (size_t)(MP + b * SKEYS) : (size_t)(b * SEQ);
    attn_unit(Q + qrow * 1536, h, KV + krow * 2048, KP + krow * 32, samp ? SKEYS : SEQ, samp, qb * 256, ropetab, dry);
  }
}

__device__ void mod_gemv_item(KP p, int it) {
  float* lds = (float*)dyn_shm;
  const int l = it / 96, n0 = (it % 96) * 64, tid = tid_();
  const float* wmod = p->in[l == 0 ? 7 : 24]; const float* bmod = p->in[l == 0 ? 8 : 25];
  __syncthreads();
  for (int e = tid; e < 5 * 1024; e += 512) { int c = e >> 10, k = e & 1023; float v = c == 0 ? p->in[6][k] : p->in[5][(c - 1) * 1024 + k]; lds[e] = v / (1.f + __expf(-v)); }
  __syncthreads();
  const int col = tid & 63, ks = tid >> 6;
  float a0 = 0, a1 = 0, a2 = 0, a3 = 0, a4 = 0;
  const float* wp = wmod + (size_t)(ks * 128) * 6144 + n0 + col;
#pragma unroll 8
  for (int k = 0; k < 128; ++k) { float w = wp[(size_t)k * 6144]; int kk = ks * 128 + k;
    a0 += lds[kk] * w; a1 += lds[1024 + kk] * w; a2 += lds[2048 + kk] * w; a3 += lds[3072 + kk] * w; a4 += lds[4096 + kk] * w; }
  float* red = lds + 5 * 1024;
  red[(ks * 5 + 0) * 64 + col] = a0; red[(ks * 5 + 1) * 64 + col] = a1; red[(ks * 5 + 2) * 64 + col] = a2; red[(ks * 5 + 3) * 64 + col] = a3; red[(ks * 5 + 4) * 64 + col] = a4;
  __syncthreads();
  if (tid < 320) { int c = tid >> 6, cc = tid & 63; float s = 0;
#pragma unroll
    for (int k8 = 0; k8 < 8; ++k8) s += red[(k8 * 5 + c) * 64 + cc];
    ((float*)(p->ws + WS_MOD))[(l * 5 + c) * 6144 + n0 + cc] = s + bmod[n0 + cc]; }
}

struct CvtMat { const float* src; int K, N, Npad; bf16_t* dst; int ldk, perm; };
__device__ __forceinline__ CvtMat get_mat(KP p, int layer, int i) {
  bf16_t* WB = (bf16_t*)(p->ws + WS_WB);
  if (layer == 0) {
    switch (i) {
      case 0: return CvtMat{p->in[11], 1024, 1536, 1536, WB + W0_IN, 1024, 0};
      case 1: return CvtMat{p->in[21], 1024, 1024, 1024, WB + W0_OUT, 1024, 0};
      case 2: return CvtMat{p->in[22], 1024, 4096, 4096, WB + W0_W1, 1024, 0};
      default: return CvtMat{p->in[23], 4096, 1024, 1024, WB + W0_W2, 4096, 0};
    }
  } else {
    switch (i) {
      case 0: return CvtMat{p->in[28], 1024, 672, 768, WB + W1_IN, 1024, 0};
      case 1: return CvtMat{p->in[30], 384, 1536, 1536, WB + W1_QB, 384, 1};
      case 2: return CvtMat{p->in[32], 256, 2048, 2048, WB + W1_KVB, 256, 0};
      case 3: return CvtMat{p->in[33], 1024, 1024, 1024, WB + W1_OUT, 1024, 0};
      case 4: return CvtMat{p->in[34], 1024, 4096, 4096, WB + W1_W1, 1024, 0};
      default: return CvtMat{p->in[35], 4096, 1024, 1024, WB + W1_W2, 4096, 0};
    }
  }
}
struct CvtTile { const float* src; int K, N; bf16_t* dst; int ldk, perm, k0, n0; float wsc; };
__device__ __forceinline__ CvtTile cvt_desc(KP p, int layer, int t, int total) {
  bf16_t* WB = (bf16_t*)(p->ws + WS_WB);
  const int nm = layer == 0 ? 4 : 6;
  if (t < total) {
    int tt = t, i = 0;
    for (; i < nm - 1; ++i) { CvtMat m = get_mat(p, layer, i); int c = (m.K / 64) * (m.Npad / 64); if (tt < c) break; tt -= c; }
    const CvtMat m = get_mat(p, layer, i);
    const int nn = m.Npad / 64;
    return CvtTile{m.src, m.K, m.N, m.dst, m.ldk, m.perm, (tt / nn) * 64, (tt % nn) * 64, m.perm ? ATT_SCALE * 1.4426950408889634f : 1.f};
  }
  const int e = t - total;
  if (e < 32) {
    const int dg = e >> 3, nb = e & 7, dir = dg >> 1, gate = dg & 1;
    return CvtTile{p->in[gate == 0 ? 14 : 16] + (size_t)(dir * 8 + nb) * 4096, 64, 64, WB + W0_G + (size_t)e * 4096, 64, 0, 0, 0, -1.4426950408889634f};
  }
  const int e2 = e - 32, gi = e2 >> 2, q = e2 & 3;
  return CvtTile{p->in[19] + (size_t)gi * 16384, 128, 128, WB + W0_P + (size_t)gi * 16384, 128, 0, (q >> 1) * 64, (q & 1) * 64, 1.f};
}
__device__ __forceinline__ void cvt_load(const CvtTile& d, int tid, f32x4& v0, f32x4& v1) {
  const int kk = tid >> 4, n4 = (tid & 15) * 4;
  const f32x4 zero = {0.f, 0.f, 0.f, 0.f};
  const bool ok = d.n0 + n4 < d.N;
  const float* sp = d.src + (size_t)(d.k0 + kk) * d.N + d.n0 + (ok ? n4 : 0);
  v0 = ok ? *(const f32x4*)sp : zero;
  v1 = ok ? *(const f32x4*)(sp + (size_t)32 * d.N) : zero;
}
__device__ void cvt_weights(KP p, int layer, int start, int stride) {
  float* tile = (float*)dyn_shm;
  const int total = layer == 0 ? 384 + 256 + 1024 + 1024 : 192 + 144 + 128 + 256 + 1024 + 1024;
  const int all = total + (layer == 0 ? 32 + 16 : 0);
  const int tid = tid_();
  int t = start;
  if (t >= all) return;
  CvtTile d = cvt_desc(p, layer, t, total);
  f32x4 v0, v1; cvt_load(d, tid, v0, v1);
  for (;;) {
    const int kk = tid >> 4, n4 = (tid & 15) * 4;
    __syncthreads();
    tile[kk * 65 + n4 + 0] = v0[0]; tile[kk * 65 + n4 + 1] = v0[1]; tile[kk * 65 + n4 + 2] = v0[2]; tile[kk * 65 + n4 + 3] = v0[3];
    tile[(kk + 32) * 65 + n4 + 0] = v1[0]; tile[(kk + 32) * 65 + n4 + 1] = v1[1]; tile[(kk + 32) * 65 + n4 + 2] = v1[2]; tile[(kk + 32) * 65 + n4 + 3] = v1[3];
    __syncthreads();
    const int tn = t + stride; const bool more = tn < all;
    CvtTile dn = d;
    if (more) { dn = cvt_desc(p, layer, tn, total); cvt_load(dn, tid, v0, v1); }
    {
      int n = tid >> 3, k8 = (tid & 7) * 8, ng = d.n0 + n;
      if (d.perm) { int hh = ng / 96, dd = ng % 96; ng = dd < 64 ? hh * 64 + dd : 1024 + hh * 32 + (dd - 64); }
      float v[8];
#pragma unroll
      for (int j = 0; j < 8; ++j) v[j] = tile[(k8 + j) * 65 + n];
      const float wsc = d.wsc;
      u32x4 w = {cvtpk(v[0] * wsc, v[1] * wsc), cvtpk(v[2] * wsc, v[3] * wsc), cvtpk(v[4] * wsc, v[5] * wsc), cvtpk(v[6] * wsc, v[7] * wsc)};
      *(u32x4*)(d.dst + (size_t)ng * d.ldk + d.k0 + k8) = w;
    }
    if (!more) break;
    t = tn; d = dn;
  }
}

__device__ __forceinline__ void mod_row_store(bf16_t* H, int row, int lane, const f32x4 (&x)[4], const f32x4 (&gv)[4], float ss, const float* modl, int chunk_shift) {
  const float rstd = rsqrtf(ss * (1.f / DM) + EPS);
  const float* mc = modl + cond_of_row(row) * 6144 + chunk_shift * 1024;
#pragma unroll
  for (int i = 0; i < 4; ++i) {
    const int col = (i * 64 + lane) * 4;
    f32x4 sh = *(const f32x4*)(mc + col), sc = *(const f32x4*)(mc + 1024 + col);
    f32x4 y = x[i] * rstd * gv[i] * (sc + 1.f) + sh;
    u32x2 w; w.x = cvtpk(y[0], y[1]); w.y = cvtpk(y[2], y[3]);
    *(u32x2*)(H + (size_t)row * DM + col) = w;
  }
}
__device__ void modulate_phase(KP p, const float* src0, const float* src1, const float* g, const float* modl, int chunk_shift) {
  bf16_t* H = (bf16_t*)(p->ws + WS_H);
  const int tid = tid_(); const int wid = tid >> 6, lane = tid & 63;
  f32x4 gv[4];
#pragma unroll
  for (int i = 0; i < 4; ++i) gv[i] = *(const f32x4*)(g + (i * 64 + lane) * 4);
  const int stride = gdim_() * 8;
  for (int row = bid_() * 8 + wid; row < M; row += 2 * stride) {
    const int row2 = row + stride; const bool v2 = row2 < M; const int r2 = v2 ? row2 : row;
    const float* xp = row < MP ? src0 + (size_t)row * DM : src1 + (size_t)(row - MP) * DM;
    const float* xq = r2 < MP ? src0 + (size_t)r2 * DM : src1 + (size_t)(r2 - MP) * DM;
    f32x4 x[4], z[4]; float ss = 0, s2 = 0;
#pragma unroll
    for (int i = 0; i < 4; ++i) { x[i] = *(const f32x4*)(xp + (i * 64 + lane) * 4); z[i] = *(const f32x4*)(xq + (i * 64 + lane) * 4); }
#pragma unroll
    for (int i = 0; i < 4; ++i) { ss += x[i][0] * x[i][0] + x[i][1] * x[i][1] + x[i][2] * x[i][2] + x[i][3] * x[i][3]; s2 += z[i][0] * z[i][0] + z[i][1] * z[i][1] + z[i][2] * z[i][2] + z[i][3] * z[i][3]; }
    ss = wave_sum(ss, lane); s2 = wave_sum(s2, lane);
    mod_row_store(H, row, lane, x, gv, ss, modl, chunk_shift);
    if (v2) mod_row_store(H, row2, lane, z, gv, s2, modl, chunk_shift);
  }
}
__device__ void final_norm_phase(KP p, int dry) {
  float* X = p->out; const float* g = p->in[36];
  const int tid = tid_(); const int wid = tid >> 6, lane = tid & 63;
  f32x4 gv[4];
#pragma unroll
  for (int i = 0; i < 4; ++i) gv[i] = *(const f32x4*)(g + (i * 64 + lane) * 4);
  const int stride = gdim_() * 8;
  for (int row = bid_() * 8 + wid; row < M; row += 2 * stride) {
    const int row2 = row + stride; const bool v2 = row2 < M; const int r2 = v2 ? row2 : row;
    float* xp = X + (size_t)row * DM; float* xq = X + (size_t)r2 * DM;
    f32x4 x[4], z[4]; float ss = 0, s2 = 0;
#pragma unroll
    for (int i = 0; i < 4; ++i) { x[i] = *(const f32x4*)(xp + (i * 64 + lane) * 4); z[i] = *(const f32x4*)(xq + (i * 64 + lane) * 4); }
#pragma unroll
    for (int i = 0; i < 4; ++i) { ss += x[i][0] * x[i][0] + x[i][1] * x[i][1] + x[i][2] * x[i][2] + x[i][3] * x[i][3]; s2 += z[i][0] * z[i][0] + z[i][1] * z[i][1] + z[i][2] * z[i][2] + z[i][3] * z[i][3]; }
    ss = wave_sum(ss, lane); s2 = wave_sum(s2, lane);
    const float rstd = rsqrtf(ss * (1.f / DM) + EPS), rstd2 = rsqrtf(s2 * (1.f / DM) + EPS);
    if (!dry) {
#pragma unroll
      for (int i = 0; i < 4; ++i) *(f32x4*)(xp + (i * 64 + lane) * 4) = x[i] * rstd * gv[i];
      if (v2) {
#pragma unroll
        for (int i = 0; i < 4; ++i) *(f32x4*)(xq + (i * 64 + lane) * 4) = z[i] * rstd2 * gv[i];
      }
    }
  }
}
struct L1Row { f32x4 qa, qb, kv; float kp; };
__device__ __forceinline__ f32x4 bf4_to_f32(u32x2 w) {
  return (f32x4){__uint_as_float(w.x << 16), __uint_as_float(w.x & 0xffff0000u), __uint_as_float(w.y << 16), __uint_as_float(w.y & 0xffff0000u)};
}
__device__ __forceinline__ void l1_row_load(const bf16_t* Z1, int row, int lane, L1Row& r) {
  const bf16_t* z = Z1 + (size_t)row * 768;
  const u32x2 zero = {0u, 0u};
  r.qa = bf4_to_f32(lane < 48 ? *(const u32x2*)(z + lane * 4) : zero);
  r.qb = bf4_to_f32(lane < 48 ? *(const u32x2*)(z + 192 + lane * 4) : zero);
  r.kv = bf4_to_f32(*(const u32x2*)(z + 384 + lane * 4));
  r.kp = lane < 32 ? bf2f(z[640 + lane]) : 0.f;
}
__device__ __forceinline__ void l1_row_finish(KP p, int row, int lane, const L1Row& r, const f32x4& gqa, const f32x4& gqb, const f32x4& gk) {
  bf16_t* CQN = (bf16_t*)(p->ws + WS_CQN); bf16_t* CKVN = (bf16_t*)(p->ws + WS_CKVN); bf16_t* KPE = (bf16_t*)(p->ws + WS_KPE);
  const float* ropetab = (const float*)(p->ws + WS_ROPE);
  float ss = r.qa[0] * r.qa[0] + r.qa[1] * r.qa[1] + r.qa[2] * r.qa[2] + r.qa[3] * r.qa[3] + r.qb[0] * r.qb[0] + r.qb[1] * r.qb[1] + r.qb[2] * r.qb[2] + r.qb[3] * r.qb[3];
  ss = wave_sum(ss, lane);
  const float rstd = rsqrtf(ss * (1.f / 384) + EPS);
  if (lane < 48) {
    const f32x4 ya = r.qa * rstd * gqa, yb = r.qb * rstd * gqb;
    u32x2 wa; wa.x = cvtpk(ya[0], ya[1]); wa.y = cvtpk(ya[2], ya[3]);
    u32x2 wb; wb.x = cvtpk(yb[0], yb[1]); wb.y = cvtpk(yb[2], yb[3]);
    *(u32x2*)(CQN + (size_t)row * 384 + lane * 4) = wa; *(u32x2*)(CQN + (size_t)row * 384 + 192 + lane * 4) = wb;
  }
  const float s2 = wave_sum(r.kv[0] * r.kv[0] + r.kv[1] * r.kv[1] + r.kv[2] * r.kv[2] + r.kv[3] * r.kv[3], lane);
  const float r2 = rsqrtf(s2 * (1.f / 256) + EPS);
  const f32x4 y = r.kv * r2 * gk;
  int krow; bool rope; int s = 0;
  if (row < MP) { krow = row; rope = false; *(f32x4*)(p->out + O_CKV + (size_t)row * 256 + lane * 4) = y; }
  else { int b = (row - MP) >> 12; s = (row - MP) & 4095; krow = MP + b * SKEYS + s; rope = true; }
  u32x2 w; w.x = cvtpk(y[0], y[1]); w.y = cvtpk(y[2], y[3]);
  *(u32x2*)(CKVN + (size_t)krow * 256 + lane * 4) = w;
  const float kp = r.kp;
  const float partner = lane_xor(kp, lane, 8);
  if (!rope) { if (lane < 32) { p->out[O_KPE + (size_t)row * 32 + lane] = kp; KPE[(size_t)krow * 32 + lane] = f2bf(kp); } }
  else if (lane < 32) {
    int pos = lane < 16 ? (s >> 6) : (s & 63); int j = lane & 7;
    float cs = ropetab[pos * 16 + 2 * j], sn = ropetab[pos * 16 + 2 * j + 1];
    float ov = (lane & 8) == 0 ? kp * cs - partner * sn : kp * cs + partner * sn;
    KPE[(size_t)krow * 32 + lane] = f2bf(ov);
  }
}
__device__ void l1_rows_phase(KP p) {
  const bf16_t* Z1 = (const bf16_t*)(p->ws + WS_Z1);
  bf16_t* CKVN = (bf16_t*)(p->ws + WS_CKVN); bf16_t* KPE = (bf16_t*)(p->ws + WS_KPE);
  const int tid = tid_(); const int wid = tid >> 6, lane = tid & 63;
  const int l48 = lane < 48 ? lane : 0;
  const f32x4 gqa = *(const f32x4*)(p->in[29] + l48 * 4), gqb = *(const f32x4*)(p->in[29] + 192 + l48 * 4), gk = *(const f32x4*)(p->in[31] + lane * 4);
  const int stride = gdim_() * 8;
  for (int row = bid_() * 8 + wid; row < M; row += 2 * stride) {
    const int row2 = row + stride; const bool v2 = row2 < M;
    L1Row ra, rb;
    l1_row_load(Z1, row, lane, ra); l1_row_load(Z1, v2 ? row2 : row, lane, rb);
    l1_row_finish(p, row, lane, ra, gqa, gqb, gk);
    if (v2) l1_row_finish(p, row2, lane, rb, gqa, gqb, gk);
  }
  for (int idx = bid_() * 8 + wid; idx < NB_S * PAST; idx += stride) {
    const int b = idx >> 9, j = idx & 511, krow = MP + b * SKEYS + DSEQ + j;
    f32x4 kv = *(const f32x4*)(p->in[3] + ((size_t)(b * PAST + j)) * 256 + lane * 4);
    u32x2 w; w.x = cvtpk(kv[0], kv[1]); w.y = cvtpk(kv[2], kv[3]);
    *(u32x2*)(CKVN + (size_t)krow * 256 + lane * 4) = w;
    if (lane < 32) KPE[(size_t)krow * 32 + lane] = f2bf(p->in[4][((size_t)(b * PAST + j)) * 32 + lane]);
  }
}

__device__ __forceinline__ float fast_sigmoid(float x) { return __builtin_amdgcn_rcpf(1.f + __expf(-x)); }
__device__ __forceinline__ float fast_gelu(float x) {
  float u = 0.7978845608028654f * (x + 0.044715f * x * x * x);
  float e = __expf(2.f * u);
  float th = 1.f - 2.f * __builtin_amdgcn_rcpf(e + 1.f);
  return 0.5f * x * (1.f + th);
}
__device__ __forceinline__ float bperm(int srclane, float v) { return __int_as_float(__builtin_amdgcn_ds_bpermute(srclane << 2, __float_as_int(v))); }
__device__ __forceinline__ void scan4(float& P, float& H, int lane, int stepl, int oq) {
  { const float Pp = bperm(lane - stepl, P), Hp = bperm(lane - stepl, H); if (oq >= 1) { H = P * Hp + H; P = Pp * P; } }
  { const float Pp = bperm(lane - 2 * stepl, P), Hp = bperm(lane - 2 * stepl, H); if (oq >= 2) { H = P * Hp + H; P = Pp * P; } }
}
__device__ void lru_item(KP p, int cidx, int nb, int mode) {
  const bf16_t* Z0 = (const bf16_t*)(p->ws + WS_Z0); bf16_t* H = (bf16_t*)(p->ws + WS_H);
  const bf16_t* Wg = (const bf16_t*)(p->ws + WS_WB) + W0_G;
  const float* LS8 = (const float*)(p->ws + WS_LS8);
  float2* SUM = (float2*)(p->ws + WS_SUM);
  float* xrL = (float*)dyn_shm;
  float* xc = xrL + 67 * 64;
  bf16_t* xcb = (bf16_t*)(xc + 64 * 64);
  float* Hs = (float*)(xcb + 64 * 72);
  const int tid = tid_(), lane = tid & 63, fr = lane & 15, fq = lane >> 4;
  const int wid = __builtin_amdgcn_readfirstlane(tid >> 6), dir = wid >> 2, wq = wid & 3;
  const int t0 = cidx * 64;
  int s0, s1, bsamp = -1;
  if (t0 < MP) { s0 = (t0 / SEQ) * SEQ; s1 = s0 + SEQ; } else { bsamp = (t0 - MP) / DSEQ; s0 = MP + bsamp * DSEQ; s1 = s0 + DSEQ; }
  const int c0 = s0 / 64, c1 = s1 / 64;
  const int chc = tid & 63, cgc = nb * 64 + chc;
  const int ch = wq * 16 + fr, cg_ = nb * 64 + ch;
  const int oq = dir ? 3 - fq : fq, stepl = dir ? -16 : 16, lastl = fr + (dir ? 0 : 48);
  unsigned xv[5];
#pragma unroll
  for (int i = 0; i < 5; ++i) { int e = tid + i * 512; int r = e >> 5, c2 = (e & 31) * 2, t = t0 - 2 + r;
    xv[i] = (e < 67 * 32 && t >= s0 && t < s1) ? *(const unsigned*)(Z0 + (size_t)t * 1536 + nb * 64 + c2) : 0u; }
  const float* cw = p->in[12];
  const float w0 = cw[cgc], w1 = cw[512 + cgc], w2 = cw[1024 + cgc], w3 = cw[1536 + cgc], bb = p->in[13][cgc];
  const float ba = -1.4426950408889634f * p->in[15][dir * 512 + cg_], bi = -1.4426950408889634f * p->in[17][dir * 512 + cg_], l8 = LS8[dir * 512 + cg_];
  bf16x8 wa[2], wi[2];
  { const bf16_t* pa = Wg + (size_t)((dir * 2 + 0) * 8 + nb) * 4096 + (size_t)ch * 64 + fq * 8; const bf16_t* pi = pa + 8 * 4096;
    wa[0] = *(const bf16x8*)pa; wa[1] = *(const bf16x8*)(pa + 32); wi[0] = *(const bf16x8*)pi; wi[1] = *(const bf16x8*)(pi + 32); }
  unsigned gz[4] = {0u, 0u, 0u, 0u};
  if (mode == 1) {
#pragma unroll
    for (int i = 0; i < 4; ++i) { int e = tid + i * 512; int t = e >> 5, c2 = (e & 31) * 2; gz[i] = *(const unsigned*)(Z0 + (size_t)(t0 + t) * 1536 + 512 + nb * 64 + c2); }
  }
  float cP = 1.f, cH = 0.f;
  if (mode == 1) {
    int lo, hi;
    if (dir == 0) { const int n = cidx - c0, q = (n + 3) >> 2; lo = c0 + fq * q; hi = lo + q < cidx ? lo + q : cidx;
      for (int c = lo; c < hi; c += 4) { float2 sm[4];
#pragma unroll
        for (int j = 0; j < 4; ++j) sm[j] = (c + j < hi) ? SUM[((size_t)(c + j) * 2) * 512 + cg_] : make_float2(1.f, 0.f);
#pragma unroll
        for (int j = 0; j < 4; ++j) { cH = sm[j].x * cH + sm[j].y; cP *= sm[j].x; } }
    } else { const int n = c1 - 1 - cidx, q = (n + 3) >> 2; hi = c1 - 1 - fq * q; lo = hi - q > cidx ? hi - q : cidx;
      for (int c = hi; c > lo; c -= 4) { float2 sm[4];
#pragma unroll
        for (int j = 0; j < 4; ++j) sm[j] = (c - j > lo) ? SUM[((size_t)(c - j) * 2 + 1) * 512 + cg_] : make_float2(1.f, 0.f);
#pragma unroll
        for (int j = 0; j < 4; ++j) { cH = sm[j].x * cH + sm[j].y; cP *= sm[j].x; } }
    }
  }
  __syncthreads();
#pragma unroll
  for (int i = 0; i < 5; ++i) { int e = tid + i * 512; if (e < 67 * 32) { int r = e >> 5, c2 = (e & 31) * 2;
    xrL[r * 64 + c2] = bf2f((bf16_t)(xv[i] & 0xffff)); xrL[r * 64 + c2 + 1] = bf2f((bf16_t)(xv[i] >> 16)); } }
  __syncthreads();
#pragma unroll
  for (int i = 0; i < 8; ++i) { int t = (tid >> 6) + 8 * i;
    float v = bb + w0 * xrL[t * 64 + chc] + w1 * xrL[(t + 1) * 64 + chc] + w2 * xrL[(t + 2) * 64 + chc] + w3 * xrL[(t + 3) * 64 + chc];
    xc[t * 64 + chc] = v; xcb[t * 72 + chc] = f2bf(v); }
  __syncthreads();
  float av[4][4], uv[4][4], Pt[4], Ht[4], Pe[4], He[4];
#pragma unroll
  for (int mt = 0; mt < 4; ++mt) {
    const bf16x8 a0 = *(const bf16x8*)(xcb + (mt * 16 + fr) * 72 + fq * 8), a1 = *(const bf16x8*)(xcb + (mt * 16 + fr) * 72 + 32 + fq * 8);
    f32x4 ga = {0.f, 0.f, 0.f, 0.f}, gi = {0.f, 0.f, 0.f, 0.f};
    ga = __builtin_amdgcn_mfma_f32_16x16x32_bf16(a0, wa[0], ga, 0, 0, 0); ga = __builtin_amdgcn_mfma_f32_16x16x32_bf16(a1, wa[1], ga, 0, 0, 0);
    gi = __builtin_amdgcn_mfma_f32_16x16x32_bf16(a0, wi[0], gi, 0, 0, 0); gi = __builtin_amdgcn_mfma_f32_16x16x32_bf16(a1, wi[1], gi, 0, 0, 0);
#pragma unroll
    for (int j = 0; j < 4; ++j) {
      const float ea = 1.f + __builtin_amdgcn_exp2f(fminf(ga[j] + ba, 57.f)), ei = 1.f + __builtin_amdgcn_exp2f(fminf(gi[j] + bi, 57.f));
      const float rc = __builtin_amdgcn_rcpf(ea * ei);
      const float r = rc * ei, ii = rc * ea;
      const float l2 = r * l8;
      const float a = __builtin_amdgcn_exp2f(l2);
      const float x2 = l2 * (2.f * 0.6931471805599453f);
      const float ser = -x2 * fmaf(x2, fmaf(x2, fmaf(x2, fmaf(x2, fmaf(x2, 1.f / 720.f, 1.f / 120.f), 1.f / 24.f), 1.f / 6.f), 0.5f), 1.f);
      const float om = x2 > -0.25f ? ser : 1.f - a * a;
      av[mt][j] = a; uv[mt][j] = __builtin_amdgcn_sqrtf(om) * ii * xc[(mt * 16 + fq * 4 + j) * 64 + ch];
    }
    float P = 1.f, Hh = 0.f;
    if (dir == 0) {
#pragma unroll
      for (int j = 0; j < 4; ++j) { Hh = av[mt][j] * Hh + uv[mt][j]; P *= av[mt][j]; }
    } else {
#pragma unroll
      for (int j = 3; j >= 0; --j) { Hh = av[mt][j] * Hh + uv[mt][j]; P *= av[mt][j]; }
    }
    scan4(P, Hh, lane, stepl, oq);
    const float Pp = bperm(lane - stepl, P), Hp = bperm(lane - stepl, Hh);
    Pe[mt] = oq >= 1 ? Pp : 1.f; He[mt] = oq >= 1 ? Hp : 0.f;
    Pt[mt] = bperm(lastl, P); Ht[mt] = bperm(lastl, Hh);
  }
  if (mode == 0) {
    float P = 1.f, Hh = 0.f;
    if (dir == 0) {
#pragma unroll
      for (int mt = 0; mt < 4; ++mt) { Hh = Pt[mt] * Hh + Ht[mt]; P *= Pt[mt]; }
    } else {
#pragma unroll
      for (int mt = 3; mt >= 0; --mt) { Hh = Pt[mt] * Hh + Ht[mt]; P *= Pt[mt]; }
    }
    if (fq == 0) SUM[((size_t)cidx * 2 + dir) * 512 + cg_] = make_float2(P, Hh);
    return;
  }
  scan4(cP, cH, lane, 16, fq);
  const float tP = bperm(fr + 48, cP), tH = bperm(fr + 48, cH);
  float c = bsamp >= 0 ? p->in[2][(bsamp * 2 + dir) * 512 + cg_] : 0.f;
  c = tP * c + tH;
  float* hp = Hs + dir * 4096 + ch;
  if (dir == 0) {
#pragma unroll
    for (int mt = 0; mt < 4; ++mt) { float s = Pe[mt] * c + He[mt];
#pragma unroll
      for (int j = 0; j < 4; ++j) { s = av[mt][j] * s + uv[mt][j]; hp[(mt * 16 + fq * 4 + j) * 64] = s; }
      c = Pt[mt] * c + Ht[mt]; }
    if (bsamp < 0 && cidx == c1 - 1 && fq == 0) p->out[O_LRU + (size_t)((t0 / SEQ) * 2 + 0) * 512 + cg_] = c;
  } else {
#pragma unroll
    for (int mt = 3; mt >= 0; --mt) { float s = Pe[mt] * c + He[mt];
#pragma unroll
      for (int j = 3; j >= 0; --j) { s = av[mt][j] * s + uv[mt][j]; hp[(mt * 16 + fq * 4 + j) * 64] = s; }
      c = Pt[mt] * c + Ht[mt]; }
    if (bsamp < 0 && cidx == c0 && fq == 0) p->out[O_LRU + (size_t)((t0 / SEQ) * 2 + 1) * 512 + cg_] = c;
  }
  __syncthreads();
#pragma unroll
  for (int i = 0; i < 4; ++i) { int e = tid + i * 512; int t = e >> 5, c2 = (e & 31) * 2;
    float g0 = bf2f((bf16_t)(gz[i] & 0xffff)), g1 = bf2f((bf16_t)(gz[i] >> 16));
    float y0 = (Hs[t * 64 + c2] + Hs[4096 + t * 64 + c2]) * fast_gelu(g0);
    float y1 = (Hs[t * 64 + c2 + 1] + Hs[4096 + t * 64 + c2 + 1]) * fast_gelu(g1);
    *(unsigned*)(H + (size_t)(t0 + t) * DM + nb * 64 + c2) = cvtpk(y0, y1); }
}

__device__ void pool_item(KP p, int cidx, int gi) {
  const bf16_t* Z0 = (const bf16_t*)(p->ws + WS_Z0); bf16_t* H = (bf16_t*)(p->ws + WS_H);
  const bf16_t* Wp = (const bf16_t*)(p->ws + WS_WB) + W0_P + (size_t)gi * 16384;
  float* xp = (float*)dyn_shm;
  bf16_t* dL = (bf16_t*)(xp + 80 * 128);
  const int tid = tid_(), wid = tid >> 6, lane = tid & 63, fr = lane & 15, fq = lane >> 4;
  const int t0 = cidx * 64;
  int s0, s1;
  if (t0 < MP) { s0 = (t0 / SEQ) * SEQ; s1 = s0 + SEQ; } else { int b = (t0 - MP) / DSEQ; s0 = MP + b * DSEQ; s1 = s0 + DSEQ; }
  __syncthreads();
  for (int e = tid; e < 80 * 64; e += 512) { int r = e >> 6, c2 = (e & 63) * 2, t = t0 - 8 + r;
    float a = 0.f, b = 0.f;
    if (t >= s0 && t < s1) { unsigned v = *(const unsigned*)(Z0 + (size_t)t * 1536 + 1024 + gi * 128 + c2); a = bf2f((bf16_t)(v & 0xffff)); b = bf2f((bf16_t)(v >> 16)); }
    xp[r * 128 + c2] = a; xp[r * 128 + c2 + 1] = b; }
  __syncthreads();
  const int w = 2 << gi, left = w >> 1, right = w - 1 - left;
  {
    const int c = tid & 127, tq = tid >> 7, tb = tq * 16;
    float S = 0.f;
    for (int k = tb - left; k <= tb + right; ++k) S += xp[(k + 8) * 128 + c];
#pragma unroll
    for (int i = 0; i < 16; ++i) { const int t = tb + i, tg = t0 + t;
      const int lo = tg - left < s0 ? s0 : tg - left, hi = tg + right > s1 - 1 ? s1 - 1 : tg + right;
      const float d = S * __builtin_amdgcn_rcpf((float)(hi - lo + 1)) - xp[(t + 8) * 128 + c];
      dL[t * 136 + c] = f2bf(d);
      S += xp[(t + 1 + right + 8) * 128 + c] - xp[(t - left + 8) * 128 + c]; }
  }
  __syncthreads();
  {
    bf16x8 wf[4];
#pragma unroll
    for (int ks = 0; ks < 4; ++ks) wf[ks] = *(const bf16x8*)(Wp + (size_t)(wid * 16 + fr) * 128 + ks * 32 + fq * 8);
    const f32x4 sc = *(const f32x4*)(p->in[20] + gi * 128 + wid * 16 + fq * 4);
#pragma unroll
    for (int mt = 0; mt < 4; ++mt) {
      f32x4 acc = {0.f, 0.f, 0.f, 0.f};
#pragma unroll
      for (int ks = 0; ks < 4; ++ks) {
        bf16x8 df = *(const bf16x8*)(dL + (mt * 16 + fr) * 136 + ks * 32 + fq * 8);
        acc = __builtin_amdgcn_mfma_f32_16x16x32_bf16(wf[ks], df, acc, 0, 0, 0);
      }
      acc = acc * sc;
      u32x2 o; o.x = cvtpk(acc[0], acc[1]); o.y = cvtpk(acc[2], acc[3]);
      *(u32x2*)(H + (size_t)(t0 + mt * 16 + fr) * DM + 512 + gi * 128 + wid * 16 + fq * 4) = o;
    }
  }
}

__global__ void __launch_bounds__(512, 2) fwd_megakernel(Params kparams) {
  cg::grid_group grid = cg::this_grid();
  KP p = (KP)__builtin_amdgcn_kernarg_segment_ptr();
  unsigned char* ws = p->ws;
  bf16_t* WB = (bf16_t*)(ws + WS_WB);
  bf16_t* H = (bf16_t*)(ws + WS_H);
  float* X = p->out;
  const float* MOD = (const float*)(ws + WS_MOD);
  volatile LAS unsigned* xst = (volatile LAS unsigned*)(dyn_shm + LDS_MAIN);
  if (threadIdx.x == 0) { xst[0] = 0u; xst[1] = 0u; }
  __syncthreads();
  (void)xcd_barrier_post((unsigned*)(ws + WS_BAR), xst);
  int rep = 0;
  const int p_lo = p->p_lo, p_hi = p->p_hi, probe = p->pad, coop = p->coop;
  for (int ph = p_lo; ph < p_hi; ++ph) {
    asm volatile("" : "+s"(p));
    const int G = gdim_(), bid = bid_();
    unsigned char* ws = p->ws; bf16_t* WB = (bf16_t*)(ws + WS_WB); bf16_t* H = (bf16_t*)(ws + WS_H); float* X = p->out; const float* MOD = (const float*)(ws + WS_MOD);
#if PROBE_PH >= 0
    const int dry = (ph == probe && rep == 0) ? 1 : 0;
#else
    const int dry = 0;
#endif
    if (PROBE_PH == 99 && probe == 99 && ph == 1) { XcdBarrier xb; xb.bar = (unsigned*)(ws + WS_BAR); xb.st = (volatile LAS unsigned*)(dyn_shm + LDS_MAIN); for (int q = 0; q < 10; ++q) xcd_barrier(xb); }
    GemmDesc g1{nullptr, nullptr, 0, 0, 0, 0, 0, 0, nullptr, 0, nullptr, nullptr, nullptr, 0, 0};
    bool isg = false;
    const float* MODL = MOD + (ph >= 11 ? 5 * 6144 : 0);
    const bf16_t* U = (const bf16_t*)(ws + WS_U);
    switch (ph) {
      case 0: {
        for (int it = bid; it < 192; it += G) mod_gemv_item(p, it);
        if (bid == G - 1) { int t = tid_(); int pos = t >> 3, j = t & 7;
          float inv = exp2f(-(float)j * 0.125f * 13.287712379549449f);
          float s, c; my_sincos((float)pos * inv, s, c);
          float* rt = (float*)(ws + WS_ROPE); rt[t * 2] = c; rt[t * 2 + 1] = s; }
        if (bid == G - 2) { int t = tid_(); float* l8 = (float*)(ws + WS_LS8);
          for (int e = t; e < 1024; e += 512) l8[e] = -8.f * 1.4426950408889634f * log1pf(__expf(-p->in[18][e])); }
      } break;
      case 2: g1 = GemmDesc{H, WB + W0_IN, 1024, 1024, M, 1536, 1024, 0, ws + WS_Z0, 1536, nullptr, nullptr, nullptr, 0, 0}; isg = true; break;
      case 5: g1 = GemmDesc{H, WB + W0_OUT, 1024, 1024, M, 1024, 1024, 2, X, 1024, p->in[0], p->in[1], MOD + 2 * 1024, 0, 0}; isg = true; break;
      case 7: case 9: case 19: case 21: { int ro = (ph == 7 || ph == 19) ? 0 : MH;
        g1 = GemmDesc{H + (size_t)ro * DM, WB + (ph < 11 ? W0_W1 : W1_W1), 1024, 1024, MH, 4096, 1024, 1, ws + WS_U, 4096, nullptr, nullptr, nullptr, 0, 0}; isg = true; } break;
      case 8: case 10: case 20: case 22: { int ro = (ph == 8 || ph == 20) ? 0 : MH;
        g1 = GemmDesc{U, WB + (ph < 11 ? W0_W2 : W1_W2), 4096, 4096, MH, 1024, 4096, 2, X, 1024, X, X + (size_t)MP * DM, MODL + 5 * 1024, ro, 0}; isg = true; } break;
      case 12: g1 = GemmDesc{H, WB + W1_IN, 1024, 1024, M, 768, 1024, 0, ws + WS_Z1, 768, nullptr, nullptr, nullptr, 0, 0}; isg = true; break;
      case 13: l1_rows_phase(p); break;
      case 14: g1 = GemmDesc{(const bf16_t*)(ws + WS_CQN), WB + W1_QB, 384, 384, M, 1536, 384, 0, ws + WS_Q, 1536, nullptr, nullptr, nullptr, 0, 0}; isg = true; break;
      case 15: g1 = GemmDesc{(const bf16_t*)(ws + WS_CKVN), WB + W1_KVB, 256, 256, KROWS, 2048, 256, 0, ws + WS_KV, 2048, nullptr, nullptr, nullptr, 0, 0}; isg = true; break;
#ifndef NO_ATTN
      case 16: attn_phase(p, dry); break;
#endif
      case 17: g1 = GemmDesc{(const bf16_t*)(ws + WS_Q), WB + W1_OUT, 1536, 1024, M, 1024, 1024, 2, X, 1024, X, X + (size_t)MP * DM, MODL + 2 * 1024, 0, 0}; isg = true; break;
      case 23: final_norm_phase(p, dry); break;
      default: break;
    }
    if (ph == 1 || ph == 6 || ph == 11 || ph == 18) {
      const bool first = ph == 1;
      modulate_phase(p, first ? p->in[0] : X, first ? p->in[1] : X + (size_t)MP * DM, p->in[ph == 1 ? 9 : ph == 6 ? 10 : ph == 11 ? 26 : 27], MODL, (ph == 1 || ph == 11) ? 0 : 3);
    }
    if (ph == 0 || ph == 11) cvt_weights(p, ph == 0 ? 0 : 1, ph == 0 ? (bid + G - 192 % G) % G : bid, G);
#ifndef NO_LRU
    if (ph == 3 || ph == 4) {
      const int nit = ph == 3 ? 3072 + 1536 : 3072;
      for (int it = bid; it < nit; it += G) { if (it < 3072) lru_item(p, it >> 3, it & 7, ph - 3); else pool_item(p, (it - 3072) >> 2, (it - 3072) & 3); }
    }
#endif
#ifndef NO_GEMM
    g1.dry = (dry && g1.mode == 2 && ph != 5) ? 1 : 0;
    if (isg) gemm_phase(g1);
#endif
    if (coop && ph + 1 < p_hi && ph != 14) {
      if (ph == 0 && !dry) grid.sync(); else { XcdBarrier xb; xb.bar = (unsigned*)(ws + WS_BAR); xb.st = (volatile LAS unsigned*)(dyn_shm + LDS_MAIN); xcd_barrier(xb); } }
#if PROBE_PH >= 0
    if (dry) { rep = 1; --ph; }
#endif
  }
}

#ifndef MK_SPLIT
#define MK_SPLIT 0
#endif
extern "C" void kernel_launch(void* const* d_in, const int* in_sizes, int n_in, void* d_out, int out_size, void* d_ws, size_t ws_size, hipStream_t stream) {
  static int grid = 0;
  if (grid == 0) {
    if (n_in != 37 || ws_size < WS_END) { fprintf(stderr, "kernel_launch: bad n_in %d or ws %zu < %zu\n", n_in, ws_size, (size_t)WS_END); grid = -1; return; }
    int dev = 0, cus = 0, per_cu = 0;
    hipGetDevice(&dev); hipDeviceGetAttribute(&cus, hipDeviceAttributeMultiprocessorCount, dev);
    if (hipFuncSetAttribute((const void*)fwd_megakernel, hipFuncAttributeMaxDynamicSharedMemorySize, LDS_BYTES) != hipSuccess) { fprintf(stderr, "kernel_launch: hipFuncSetAttribute failed\n"); grid = -1; return; }
    if (hipOccupancyMaxActiveBlocksPerMultiprocessor(&per_cu, (const void*)fwd_megakernel, 512, LDS_BYTES) != hipSuccess || per_cu < 1) { fprintf(stderr, "kernel_launch: occupancy query gave %d\n", per_cu); grid = -1; return; }
    grid = cus;
  }
  if (grid < 0) return;
  if (hipMemsetAsync((char*)d_ws + WS_BAR, 0, XCD_BAR_WORDS * 4, stream) != hipSuccess) { fprintf(stderr, "kernel_launch: memset failed\n"); return; }
  Params p{};
  for (int i = 0; i < 37; ++i) p.in[i] = (const float*)d_in[i];
  p.out = (float*)d_out; p.ws = (unsigned char*)d_ws; p.pad = PROBE_PH;
#if MK_SPLIT
  for (int ph = 0; ph < NPH; ++ph) {
    p.p_lo = ph; p.p_hi = ph + 1; p.coop = 0;
    hipLaunchKernelGGL(fwd_megakernel, dim3(grid), dim3(512), LDS_BYTES, stream, p);
  }
#else
  p.p_lo = 0; p.p_hi = NPH; p.coop = 1;
  void* args[] = {&p};
  hipError_t e = hipLaunchCooperativeKernel((const void*)fwd_megakernel, dim3(grid), dim3(512), args, LDS_BYTES, stream);
  if (e != hipSuccess) fprintf(stderr, "cooperative launch failed: %s (grid %d)\n", hipGetErrorString(e), grid);
#endif
}
```

```cpp
#include <hip/hip_runtime.h>
#include <hip/hip_cooperative_groups.h>
#include <cstdio>
#include <cstdint>
namespace cg = cooperative_groups;
#ifndef PROBE_PH
#define PROBE_PH -1
#endif

typedef unsigned short bf16_t;
typedef short bf16x8 __attribute__((ext_vector_type(8)));
typedef short s16x4 __attribute__((ext_vector_type(4)));
typedef float f32x4 __attribute__((ext_vector_type(4)));
typedef float f32x16 __attribute__((ext_vector_type(16)));
typedef unsigned u32x4 __attribute__((ext_vector_type(4)));
typedef unsigned u32x2 __attribute__((ext_vector_type(2)));

constexpr int DM = 1024, MP = 8192, MS = 16384, M = MP + MS, DFF = 4096;
constexpr int SEQ = 256, DSEQ = 4096, PAST = 512, NB_S = 4;
constexpr int KROWS = MP + NB_S * (DSEQ + PAST);
constexpr int SKEYS = DSEQ + PAST;
constexpr int MH = M / 2;
constexpr float EPS = 1e-6f;
constexpr int NPH = 24;

constexpr size_t MiB = 1u << 20;
constexpr size_t WS_MOD = 0;
constexpr size_t WS_ROPE = 256 * 1024;
constexpr size_t WS_LS8 = 260 * 1024;
constexpr size_t WS_SUM = 512 * 1024;
constexpr size_t WS_BAR = 3840 * 1024;
constexpr size_t WS_WB = 4 * MiB;
constexpr size_t WS_R1 = 26 * MiB;
constexpr size_t WS_H = WS_R1;
constexpr size_t WS_Z0 = WS_R1 + 48 * MiB;
constexpr size_t WS_U = WS_R1 + 48 * MiB;
constexpr size_t WS_KV = WS_R1;
constexpr size_t WS_Q = WS_R1 + 104 * MiB;
constexpr size_t WS_Z1 = WS_R1 + 104 * MiB;
constexpr size_t WS_CQN = WS_R1 + 176 * MiB;
constexpr size_t WS_CKVN = WS_R1 + 194 * MiB;
constexpr size_t WS_KPE = WS_R1 + 207 * MiB;
constexpr size_t WS_END = WS_R1 + 209 * MiB;
constexpr size_t W0_IN = 0, W0_OUT = 1572864, W0_W1 = 2621440, W0_W2 = 6815744, W0_G = 11010048, W0_P = 11141120;
constexpr size_t W1_IN = 0, W1_QB = 786432, W1_KVB = 1376256, W1_OUT = 1900544, W1_W1 = 2949120, W1_W2 = 7143424;
constexpr size_t O_Y = 0, O_LRU = 25165824, O_CKV = 25198592, O_KPE = 27295744;

struct Params {
  const float* in[37];
  float* out;
  unsigned char* ws;
  int p_lo, p_hi, coop, pad;
};

typedef const __attribute__((address_space(4))) Params* KP;
extern __shared__ __attribute__((aligned(16))) unsigned char dyn_shm[];
constexpr int LDS_MAIN = 139264;
constexpr int LDS_BYTES = LDS_MAIN + 16;

__device__ __forceinline__ unsigned cvtpk(float lo, float hi) {
  unsigned r; asm volatile("v_cvt_pk_bf16_f32 %0, %1, %2" : "=v"(r) : "v"(lo), "v"(hi)); return r;
}
__device__ __forceinline__ float bf2f(bf16_t b) { return __uint_as_float(((unsigned)b) << 16); }
__device__ __forceinline__ bf16_t f2bf(float f) { return (bf16_t)(cvtpk(f, f) & 0xffffu); }
__device__ __forceinline__ float sigmoidf_(float x) { return 1.f / (1.f + __expf(-x)); }
__device__ __forceinline__ float gelu_tanh(float x) {
  float u = 0.7978845608028654f * (x + 0.044715f * x * x * x);
  float e = __expf(2.f * u);
  float th = 1.f - 2.f / (e + 1.f);
  return 0.5f * x * (1.f + th);
}
__device__ __forceinline__ float lane_xor(float v, int lane, int o) { return __int_as_float(__builtin_amdgcn_ds_bpermute((lane ^ o) << 2, __float_as_int(v))); }
__device__ __forceinline__ float wave_sum(float v, int lane) {
#pragma unroll
  for (int o = 32; o > 0; o >>= 1) v += lane_xor(v, lane, o);
  return v;
}
__device__ __forceinline__ void my_sincos(float a, float& s, float& c) {
  float k = rintf(a * 0.63661977236758134f);
  float r = fmaf(k, -1.5707962513e+00f, a);
  r = fmaf(k, -7.5497894159e-08f, r);
  r = fmaf(k, -5.3903029534e-15f, r);
  float r2 = r * r;
  float sp = r + r * r2 * (-1.6666667163e-01f + r2 * (8.3333337680e-03f + r2 * (-1.9841270114e-04f + r2 * 2.7557314297e-06f)));
  float cp = 1.f + r2 * (-0.5f + r2 * (4.1666667908e-02f + r2 * (-1.3888889225e-03f + r2 * 2.4801587642e-05f)));
  int q = ((int)k) & 3;
  float ss = (q & 1) ? cp : sp, cc = (q & 1) ? sp : cp;
  s = (q & 2) ? -ss : ss;
  c = ((q + 1) & 2) ? -cc : cc;
}
__device__ __forceinline__ int bid_() { int b = blockIdx.x; asm volatile("" : "+s"(b)); return b; }
__device__ __forceinline__ int gdim_() { int g = gridDim.x; asm volatile("" : "+s"(g)); return g; }
__device__ __forceinline__ int tid_() { int t = threadIdx.x; asm volatile("" : "+v"(t)); return t; }
__device__ __forceinline__ int cond_of_row(int row) { return row < MP ? 0 : 1 + ((row - MP) >> 12); }


#define XB_TMO      128
#define XB_XCNT(j)  (256  + 64 * (j))
#define XB_XSUB(j)  (1280 + 64 * (j))
#define XB_XGEN(j)  (2304 + 64 * (j))
#define XB_TOP      3328
#define XB_TOPGEN   3392
#define XCD_BAR_WORDS 3456
#define XB_SPIN_CAP (1u << 20)
#define LAS __attribute__((address_space(3)))
__device__ __forceinline__ unsigned xb_ld(unsigned* p)              { return __hip_atomic_load(p, __ATOMIC_RELAXED, __HIP_MEMORY_SCOPE_AGENT); }
__device__ __forceinline__ unsigned xb_add(unsigned* p, unsigned v) { return __hip_atomic_fetch_add(p, v, __ATOMIC_RELAXED, __HIP_MEMORY_SCOPE_AGENT); }
__device__ __forceinline__ unsigned xb_xcc_id() { return (unsigned)__builtin_amdgcn_s_getreg((3 << 11) | 20) & 0xFu; }
#define XB_SPIN(cond, bar) do { unsigned _sp = 0; while (cond) { __builtin_amdgcn_s_sleep(1); \
    if ((++_sp & 255u) == 0u) { if (xb_ld(&(bar)[XB_TMO])) break; if (_sp > XB_SPIN_CAP) { atomicAdd(&(bar)[XB_TMO], 1u); break; } } } } while (0)
struct XcdBarrier { unsigned* bar; volatile LAS unsigned* st; };
__device__ __forceinline__ XcdBarrier xcd_barrier_post(unsigned* bar, volatile LAS unsigned* st) {
  XcdBarrier b; b.bar = bar; b.st = st;
  if (threadIdx.x == 0) (void)xb_add(&bar[XB_XCNT(xb_xcc_id())], 1u);
  return b;
}
__device__ __forceinline__ void xcd_barrier_complete(unsigned* bar, unsigned x, unsigned& nloc, unsigned& nx) {
  const unsigned G = (unsigned)gdim_();
  unsigned sum, cnt, mine, sp = 0u;
  for (;;) {
    sum = 0u; cnt = 0u; mine = 0u;
#pragma unroll
    for (unsigned j = 0; j < 16; ++j) { const unsigned c = xb_ld(&bar[XB_XCNT(j)]); sum += c; cnt += (c > 0u) ? 1u : 0u; mine = (j == x) ? c : mine; }
    if (sum == G) break;
    __builtin_amdgcn_s_sleep(1);
    if ((++sp & 255u) == 0u) { if (xb_ld(&bar[XB_TMO])) break; if (sp > XB_SPIN_CAP) { atomicAdd(&bar[XB_TMO], 1u); break; } }
  }
  nloc = mine > 0u ? mine : 1u; nx = cnt > 0u ? cnt : 1u;
}
__device__ __forceinline__ void xcd_barrier(const XcdBarrier& b) {
  asm volatile("s_waitcnt vmcnt(0)" ::: "memory");
  __syncthreads();
  if (threadIdx.x == 0) {
    unsigned* bar = b.bar; unsigned bx = xb_xcc_id(); asm volatile("" : "+s"(bx));
    __builtin_amdgcn_s_waitcnt(0);
    unsigned nloc = b.st[0], nx = b.st[1];
    if (nloc == 0u) { xcd_barrier_complete(bar, bx, nloc, nx); b.st[0] = nloc; b.st[1] = nx; }
    const unsigned old = xb_add(&bar[XB_XSUB(bx)], 1u);
    const unsigned gen = old / nloc;
    if (old + 1u == (gen + 1u) * nloc) {
      __builtin_amdgcn_fence(__ATOMIC_RELEASE, "agent");
      asm volatile("s_waitcnt vmcnt(0)" ::: "memory");
      const unsigned og = xb_add(&bar[XB_TOP], 1u);
      const unsigned tg = og / nx;
      if (og + 1u == (tg + 1u) * nx) xb_add(&bar[XB_TOPGEN], 1u);
      else XB_SPIN(xb_ld(&bar[XB_TOPGEN]) == tg, bar);
      __builtin_amdgcn_fence(__ATOMIC_ACQUIRE, "agent");
      xb_add(&bar[XB_XGEN(bx)], 1u);
      asm volatile("s_waitcnt vmcnt(0)" ::: "memory");
    } else {
      XB_SPIN(xb_ld(&bar[XB_XGEN(bx)]) == gen, bar);
      __builtin_amdgcn_fence(__ATOMIC_ACQUIRE, "agent");
      asm volatile("s_waitcnt vmcnt(0)" ::: "memory");
    }
  }
  __syncthreads();
}

constexpr int BM = 256, BK = 64, HALF = 128, HT = HALF * BK, NXCD = 8, WGM = 8;
__device__ __forceinline__ int lds_byte(int r, int c) {
  int st = (r >> 4) * 2 + (c >> 5), rr = r & 15, cc = c & 31, ob = rr * 64 + cc * 2;
  return st * 1024 + (ob ^ (((ob >> 9) & 1) << 5));
}
__device__ __forceinline__ void stage_rc(int b, int& R, int& C) {
  int st = b / 1024, sb = b % 1024, swz = sb ^ (((sb >> 9) & 1) << 5);
  R = (st >> 1) * 16 + swz / 64; C = (st & 1) * 32 + (swz % 64) / 2;
}

struct GemmDesc {
  const bf16_t* A; const bf16_t* Bt; int lda, ldb, Mrows, N, K;
  int mode;
  void* out; int ldc;
  const float* src0; const float* src1; const float* gate; int row_off; int dry;
};

__device__ __forceinline__ void gemm_epi(const GemmDesc& g, int row, int col, f32x4 v) {
#if PROBE_PH >= 0
  if (g.dry) return;
#endif
  if (g.mode == 0) {
    u32x2 w; w.x = cvtpk(v[0], v[1]); w.y = cvtpk(v[2], v[3]);
    *(u32x2*)((bf16_t*)g.out + (size_t)row * g.ldc + col) = w;
  } else if (g.mode == 1) {
    float a = fmaxf(v[0], 0.f), b = fmaxf(v[1], 0.f), c = fmaxf(v[2], 0.f), d = fmaxf(v[3], 0.f);
    u32x2 w; w.x = cvtpk(a * a, b * b); w.y = cvtpk(c * c, d * d);
    *(u32x2*)((bf16_t*)g.out + (size_t)row * g.ldc + col) = w;
  } else if (g.mode == 2) {
    int rg = row + g.row_off;
    const float* sp = rg < MP ? g.src0 + (size_t)rg * DM + col : g.src1 + (size_t)(rg - MP) * DM + col;
    f32x4 x = *(const f32x4*)sp;
    f32x4 gt = *(const f32x4*)(g.gate + cond_of_row(rg) * 6144 + col);
    *(f32x4*)((float*)g.out + (size_t)rg * DM + col) = x + gt * v;
  } else {
    *(f32x4*)((float*)g.out + (size_t)row * g.ldc + col) = v;
  }
}

template <int MF>
__device__ __forceinline__ void gemm_tile(const GemmDesc& g, int brow, int bcol) {
  constexpr int AH = MF * 32;
  bf16_t* shm = (bf16_t*)dyn_shm;
  const bf16_t* A = g.A; const bf16_t* Bt = g.Bt; const int lda = g.lda, ldb = g.ldb, K = g.K;
#define SA(b,h) (shm+((b)*2+(h))*HT)
#define SB(b,h) (shm+(4+(b)*2+(h))*HT)
#define STAGE(P,BASE,LD,VO,br,kt) do{const unsigned char* _ub=(const unsigned char*)(BASE)+((size_t)(br)*(LD)+(size_t)(kt)*BK)*2; \
    const unsigned char* _ub2=_ub+(size_t)(LD)*128; \
    const unsigned _m0=(unsigned)(uintptr_t)(__attribute__((address_space(3))) unsigned char*)((unsigned char*)(P))+ldsw; \
    asm volatile("s_mov_b32 m0, %0\n\ts_nop 0\n\tglobal_load_lds_dwordx4 %1, %2\n\ts_mov_b32 m0, %3\n\ts_nop 0\n\tglobal_load_lds_dwordx4 %1, %4" \
      :: "s"(_m0), "v"(VO), "s"(_ub), "s"(_m0+8192u), "s"(_ub2) : "m0", "memory");}while(0)
#define LDA(dst,b,h) for(int m=0;m<MF;++m)for(int k=0;k<2;++k) \
    dst[m][k]=*reinterpret_cast<const bf16x8*>((char*)SA(b,h)+lds_byte(wr*(MF*16)+m*16+fr,k*32+fq*8))
#define LDB(dst,b,h) for(int n=0;n<2;++n)for(int k=0;k<2;++k) \
    dst[n][k]=*reinterpret_cast<const bf16x8*>((char*)SB(b,h)+lds_byte(wc*32+n*16+fr,k*32+fq*8))
#define MMA(ai,bj,At,Bt_) do{__builtin_amdgcn_s_setprio(1); \
    for(int m=0;m<MF;++m)for(int n=0;n<2;++n)for(int k=0;k<2;++k) \
      acc[ai][bj][m][n]=__builtin_amdgcn_mfma_f32_16x16x32_bf16(Bt_[n][k],At[m][k],acc[ai][bj][m][n],0,0,0); \
    __builtin_amdgcn_s_setprio(0);}while(0)
#define WAIT_V(n) asm volatile("s_waitcnt vmcnt(" #n ")":::"memory")
#define WAIT_L(n) asm volatile("s_waitcnt lgkmcnt(" #n ")":::"memory")
#define BAR __builtin_amdgcn_s_barrier()
#define SCHED __builtin_amdgcn_sched_barrier(0)
  const int tid = tid_();
  const int wid = __builtin_amdgcn_readfirstlane(tid >> 6), lane = tid & 63, wr = wid >> 2, wc = wid & 3, fr = lane & 15, fq = lane >> 4;
  const unsigned ldsw = (unsigned)wid * 1024u;
  unsigned voA, voB;
  { int r_, c_; stage_rc(tid * 16, r_, c_); voA = (unsigned)(r_ * lda + c_) * 2u; voB = (unsigned)(r_ * ldb + c_) * 2u; }
  f32x4 acc[2][2][MF][2] = {};
  bf16x8 At[MF][2], B0[2][2], B1[2][2];
  const int nt = K / BK;
  __syncthreads();
  STAGE(SB(0,0),Bt,ldb,voB,bcol,0); STAGE(SA(0,0),A,lda,voA,brow,0);
  STAGE(SB(0,1),Bt,ldb,voB,bcol+HALF,0); STAGE(SA(0,1),A,lda,voA,brow+AH,0);
  STAGE(SB(1,0),Bt,ldb,voB,bcol,1); STAGE(SA(1,0),A,lda,voA,brow,1); STAGE(SB(1,1),Bt,ldb,voB,bcol+HALF,1);
  if(wr==1)BAR;
  WAIT_V(10); BAR;
  WAIT_V(6); BAR;
  for(int t=0;t<nt-2;t+=2){
    LDB(B0,0,0); SCHED; LDA(At,0,0); STAGE(SA(1,1),A,lda,voA,brow+AH,t+1);
    if (MF == 4) WAIT_L(8); else WAIT_L(6); BAR; WAIT_L(0); MMA(0,0,At,B0); BAR; SCHED;
    LDB(B1,0,1); STAGE(SB(0,0),Bt,ldb,voB,bcol,t+2);
    BAR; WAIT_L(0); MMA(0,1,At,B1); BAR;
    LDA(At,0,1); STAGE(SA(0,0),A,lda,voA,brow,t+2);
    BAR; WAIT_L(0); MMA(1,0,At,B0); BAR; SCHED;
    STAGE(SB(0,1),Bt,ldb,voB,bcol+HALF,t+2);
    WAIT_V(6); BAR; MMA(1,1,At,B1); BAR;
    LDB(B0,1,0); SCHED; LDA(At,1,0); STAGE(SA(0,1),A,lda,voA,brow+AH,t+2);
    if (MF == 4) WAIT_L(8); else WAIT_L(6); BAR; WAIT_L(0); MMA(0,0,At,B0); BAR; SCHED;
    LDB(B1,1,1); STAGE(SB(1,0),Bt,ldb,voB,bcol,t+3);
    BAR; WAIT_L(0); MMA(0,1,At,B1); BAR;
    LDA(At,1,1); STAGE(SA(1,0),A,lda,voA,brow,t+3);
    BAR; WAIT_L(0); MMA(1,0,At,B0); BAR; SCHED;
    STAGE(SB(1,1),Bt,ldb,voB,bcol+HALF,t+3);
    WAIT_V(6); BAR; MMA(1,1,At,B1); BAR;
  }
  { LDB(B0,0,0); LDA(At,0,0); STAGE(SA(1,1),A,lda,voA,brow+AH,nt-1);
    BAR; WAIT_L(0); MMA(0,0,At,B0); BAR;
    LDB(B1,0,1); BAR; WAIT_L(0); MMA(0,1,At,B1); BAR;
    LDA(At,0,1); WAIT_V(4); BAR; WAIT_L(0); MMA(1,0,At,B0); MMA(1,1,At,B1); BAR; }
  { LDB(B0,1,0); LDA(At,1,0); WAIT_V(2); BAR; WAIT_L(0); MMA(0,0,At,B0); BAR;
    LDB(B1,1,1); WAIT_V(0); BAR; WAIT_L(0); MMA(0,1,At,B1); BAR;
    LDA(At,1,1); BAR; WAIT_L(0); MMA(1,0,At,B0); MMA(1,1,At,B1); BAR; }
  if(wr==0)BAR;
  const int tid2 = tid_(); const int wid2 = tid2 >> 6, lane2 = tid2 & 63;
  if (g.mode <= 1) {
    unsigned char* st = dyn_shm;
    const int lrow = (wid2 >> 2) * (MF * 16) + (lane2 & 15), lcol = (wid2 & 3) * 32 + (lane2 >> 4) * 4;
    const bool sq = g.mode == 1;
#pragma unroll
    for(int ai=0;ai<2;++ai)
#pragma unroll
      for(int m=0;m<MF;++m)
#pragma unroll
        for(int bj=0;bj<2;++bj)
#pragma unroll
          for(int n=0;n<2;++n) {
            f32x4 v = acc[ai][bj][m][n];
            if (sq) { v[0] = fmaxf(v[0], 0.f); v[1] = fmaxf(v[1], 0.f); v[2] = fmaxf(v[2], 0.f); v[3] = fmaxf(v[3], 0.f); v = v * v; }
            u32x2 w; w.x = cvtpk(v[0], v[1]); w.y = cvtpk(v[2], v[3]);
            *(u32x2*)(st + (lrow + ai * AH + m * 16) * 544 + (lcol + bj * HALF + n * 16) * 2) = w;
          }
    __syncthreads();
#if PROBE_PH >= 0
    if (!g.dry)
#endif
    {
      bf16_t* ob = (bf16_t*)g.out + (size_t)brow * g.ldc + bcol;
      const int r0 = wid2 * (MF * 8) + (lane2 >> 5), c16 = (lane2 & 31);
#pragma unroll 4
      for (int i = 0; i < MF * 4; ++i) {
        const int r = r0 + 2 * i;
        u32x4 w = *(const u32x4*)(st + r * 544 + c16 * 16);
        *(u32x4*)(ob + (size_t)r * g.ldc + c16 * 8) = w;
      }
    }
  } else if (g.mode == 2) {
    unsigned char* st = dyn_shm;
    const int lr0 = (wid2 >> 2) * (MF * 16) + (lane2 & 15), lcol = (wid2 & 3) * 32 + (lane2 >> 4) * 4;
#pragma unroll
    for(int ai=0;ai<2;++ai) {
#pragma unroll
      for(int m=0;m<MF;++m)
#pragma unroll
        for(int bj=0;bj<2;++bj)
#pragma unroll
          for(int n=0;n<2;++n)
            *(f32x4*)(st + (lr0 + m * 16) * 1040 + (lcol + bj * HALF + n * 16) * 4) = acc[ai][bj][m][n];
      __syncthreads();
      {
        constexpr int RPW = MF * 4;
        const int rb = wid2 * RPW;
#pragma unroll
        for (int i0 = 0; i0 < RPW; i0 += 4) {
          f32x4 xv[4], gv[4]; int rgs[4];
#pragma unroll
          for (int i = 0; i < 4; ++i) { const int r = rb + i0 + i, rg = brow + ai * AH + r + g.row_off; rgs[i] = rg;
            xv[i] = *(const f32x4*)((rg < MP ? g.src0 + (size_t)rg * DM : g.src1 + (size_t)(rg - MP) * DM) + bcol + lane2 * 4);
            gv[i] = *(const f32x4*)(g.gate + cond_of_row(rg) * 6144 + bcol + lane2 * 4); }
#pragma unroll
          for (int i = 0; i < 4; ++i) { const int r = rb + i0 + i;
            const f32x4 v = *(const f32x4*)(st + r * 1040 + lane2 * 16);
            *(f32x4*)((float*)g.out + (size_t)rgs[i] * DM + bcol + lane2 * 4) = xv[i] + gv[i] * v; }
        }
      }
      __syncthreads();
    }
  } else {
  const int erow = brow + (wid2 >> 2) * (MF * 16) + (lane2 & 15), ecol = bcol + (wid2 & 3) * 32 + (lane2 >> 4) * 4;
#pragma unroll
  for(int ai=0;ai<2;++ai)
#pragma unroll
    for(int m=0;m<MF;++m)
#pragma unroll
      for(int bj=0;bj<2;++bj)
#pragma unroll
        for(int n=0;n<2;++n)
          gemm_epi(g, erow+ai*AH+m*16, ecol+bj*HALF+n*16, acc[ai][bj][m][n]);
  }
#undef SA
#undef SB
#undef STAGE
#undef LDA
#undef LDB
#undef MMA
}

__device__ __forceinline__ void tile_of(int L, int nM, int nN, int nwg, int th, int& brow, int& bcol) {
  int wgid = L;
  { const int q = nwg / NXCD, r = nwg % NXCD, xcd = wgid % NXCD, off = wgid / NXCD; wgid = (xcd < r ? xcd * (q + 1) : r * (q + 1) + (xcd - r) * q) + off; }
  const int nig = WGM * nN, gid = wgid / nig, fm = gid * WGM, gsz = (nM - fm) < WGM ? (nM - fm) : WGM;
  brow = (fm + ((wgid % nig) % gsz)) * th; bcol = ((wgid % nig) / gsz) * BM;
}
__device__ __forceinline__ void gemm_phase(const GemmDesc& g) {
  const int G = gdim_();
  const bool m3 = (g.Mrows % 192) == 0 && g.N <= 1536;
  const int th = m3 ? 192 : 256;
  const int nM = g.Mrows / th, nN = g.N / BM, nwg = nM * nN;
  for (int L = bid_(); L < nwg; L += G) {
    int brow, bcol; tile_of(L, nM, nN, nwg, th, brow, bcol);
    if (m3) gemm_tile<3>(g, brow, bcol); else gemm_tile<4>(g, brow, bcol);
  }
}

constexpr float ATT_SCALE = 0.10206207261596577f;
constexpr float ATT_THR = 8.f;
constexpr int SHM_V = 64 * 64 * 2, SHM_K = 64 * 128 * 2;
#define KSWZ(row, colB) ((row) * 256 + ((colB) ^ (((row) & 7) << 4)))
#define SBAR() __builtin_amdgcn_sched_barrier(0)
__device__ __forceinline__ int crow(int r, int hi) { return (r & 3) + 8 * (r >> 2) + 4 * hi; }

__device__ __forceinline__ void partialSM(f32x16& p0, f32x16& p1, float& m_reg, float& alpha, bool first) {
  constexpr float THRL = ATT_THR * 1.4426950408889634f;
  float pmax = p0[0];
#pragma unroll
  for (int r = 1; r < 16; ++r) pmax = fmaxf(pmax, p0[r]);
#pragma unroll
  for (int r = 0; r < 16; ++r) pmax = fmaxf(pmax, p1[r]);
  { auto rr = __builtin_amdgcn_permlane32_swap(__float_as_uint(pmax), __float_as_uint(pmax), false, false);
    pmax = fmaxf(__uint_as_float(rr[0]), __uint_as_float(rr[1])); }
  if (first) {
    alpha = 0.f; m_reg = pmax;
#pragma unroll
    for (int r = 0; r < 16; ++r) p0[r] -= pmax;
#pragma unroll
    for (int r = 0; r < 16; ++r) p1[r] -= pmax;
  } else if (__builtin_expect(__all(pmax <= THRL), 1)) { alpha = 1.f; }
  else { const float d = fmaxf(pmax, 0.f); alpha = __builtin_amdgcn_exp2f(-d); m_reg += d;
#pragma unroll
    for (int r = 0; r < 16; ++r) p0[r] -= d;
#pragma unroll
    for (int r = 0; r < 16; ++r) p1[r] -= d;
  }
#pragma unroll
  for (int r = 0; r < 16; ++r) p0[r] = __builtin_amdgcn_exp2f(p0[r]);
}
__device__ __forceinline__ void finishSM(f32x16& p0, f32x16& p1, float alpha, float& l_reg, bf16x8& pa0, bf16x8& pa1, bf16x8& pa2, bf16x8& pa3) {
#pragma unroll
  for (int r = 0; r < 16; ++r) p1[r] = __builtin_amdgcn_exp2f(p1[r]);
  float ps = 0;
#pragma unroll
  for (int r = 0; r < 16; ++r) ps += p0[r];
#pragma unroll
  for (int r = 0; r < 16; ++r) ps += p1[r];
  { auto rr = __builtin_amdgcn_permlane32_swap(__float_as_uint(ps), __float_as_uint(ps), false, false);
    ps = __uint_as_float(rr[0]) + __uint_as_float(rr[1]); }
  l_reg = l_reg * alpha + ps;
#define PK4(P, BASE, OUT) do { unsigned a0 = cvtpk(P[BASE + 0], P[BASE + 1]), a1 = cvtpk(P[BASE + 2], P[BASE + 3]);   \
    unsigned b0 = cvtpk(P[BASE + 4], P[BASE + 5]), b1 = cvtpk(P[BASE + 6], P[BASE + 7]);                              \
    auto r0 = __builtin_amdgcn_permlane32_swap(a0, b0, false, false); auto r1 = __builtin_amdgcn_permlane32_swap(a1, b1, false, false); \
    u32x4 w = {r0[0], r1[0], r0[1], r1[1]}; OUT = *reinterpret_cast<bf16x8*>(&w); } while (0)
  PK4(p0, 0, pa0); PK4(p0, 8, pa1); PK4(p1, 0, pa2); PK4(p1, 8, pa3);
#undef PK4
}
__device__ __forceinline__ void qkt(f32x16& p0, f32x16& p1, const unsigned char* Ks, const bf16x8* qr, int r32, int hi, float init) {
#pragma unroll
  for (int r = 0; r < 16; ++r) { p0[r] = init; p1[r] = init; }
#pragma unroll
  for (int d0 = 0; d0 < 6; ++d0) { int cb = (d0 * 16 + hi * 8) * 2;
    bf16x8 b0 = *reinterpret_cast<const bf16x8*>(Ks + KSWZ(r32, cb));
    bf16x8 b1 = *reinterpret_cast<const bf16x8*>(Ks + KSWZ(32 + r32, cb));
    p0 = __builtin_amdgcn_mfma_f32_32x32x16_bf16(b0, qr[d0], p0, 0, 0, 0);
    p1 = __builtin_amdgcn_mfma_f32_32x32x16_bf16(b1, qr[d0], p1, 0, 0, 0); }
}
__device__ __forceinline__ int v_st(int k, int c) { const int kk = (k & ~0xC) | ((k & 4) << 1) | ((k & 8) >> 1); return ((kk >> 3) * 2 + (c >> 5)) * 512 + ((kk & 7) * 32 + (c & 31)) * 2; }
__device__ __forceinline__ int v_rd_base(int lane) { return ((lane & 3) << 3) | (((lane >> 2) & 3) << 6) | (((lane >> 4) & 1) << 5) | (((lane >> 5) & 1) << 8); }
constexpr int v_rd_off(int d0, int ks, int half) { return d0 * 512 + ks * 2048 + half * 1024; }
template <int OFF> __device__ __forceinline__ s16x4 tr_read(int vb) {
  s16x4 r; asm volatile("ds_read_b64_tr_b16 %0, %1 offset:%2" : "=&v"(r) : "v"(vb), "i"(OFF) : "memory"); return r;
}
__device__ __forceinline__ void pv_d0(f32x16* o, int vb, bf16x8 pa0, bf16x8 pa1, bf16x8 pa2, bf16x8 pa3) {
  const s16x4 l0 = tr_read<v_rd_off(0, 0, 0)>(vb), h0 = tr_read<v_rd_off(0, 0, 1)>(vb), l1 = tr_read<v_rd_off(0, 1, 0)>(vb), h1 = tr_read<v_rd_off(0, 1, 1)>(vb);
  const s16x4 l2 = tr_read<v_rd_off(0, 2, 0)>(vb), h2 = tr_read<v_rd_off(0, 2, 1)>(vb), l3 = tr_read<v_rd_off(0, 3, 0)>(vb), h3 = tr_read<v_rd_off(0, 3, 1)>(vb);
  const s16x4 m0 = tr_read<v_rd_off(1, 0, 0)>(vb), n0 = tr_read<v_rd_off(1, 0, 1)>(vb), m1 = tr_read<v_rd_off(1, 1, 0)>(vb), n1 = tr_read<v_rd_off(1, 1, 1)>(vb);
  const s16x4 m2 = tr_read<v_rd_off(1, 2, 0)>(vb), n2 = tr_read<v_rd_off(1, 2, 1)>(vb), m3 = tr_read<v_rd_off(1, 3, 0)>(vb), n3 = tr_read<v_rd_off(1, 3, 1)>(vb);
  asm volatile("s_waitcnt lgkmcnt(0)" ::: "memory"); SBAR();
#define PK(L, H) (bf16x8){L[0], L[1], L[2], L[3], H[0], H[1], H[2], H[3]}
  o[0] = __builtin_amdgcn_mfma_f32_32x32x16_bf16(pa0, PK(l0, h0), o[0], 0, 0, 0);
  o[1] = __builtin_amdgcn_mfma_f32_32x32x16_bf16(pa0, PK(m0, n0), o[1], 0, 0, 0);
  o[0] = __builtin_amdgcn_mfma_f32_32x32x16_bf16(pa1, PK(l1, h1), o[0], 0, 0, 0);
  o[1] = __builtin_amdgcn_mfma_f32_32x32x16_bf16(pa1, PK(m1, n1), o[1], 0, 0, 0);
  o[0] = __builtin_amdgcn_mfma_f32_32x32x16_bf16(pa2, PK(l2, h2), o[0], 0, 0, 0);
  o[1] = __builtin_amdgcn_mfma_f32_32x32x16_bf16(pa2, PK(m2, n2), o[1], 0, 0, 0);
  o[0] = __builtin_amdgcn_mfma_f32_32x32x16_bf16(pa3, PK(l3, h3), o[0], 0, 0, 0);
  o[1] = __builtin_amdgcn_mfma_f32_32x32x16_bf16(pa3, PK(m3, n3), o[1], 0, 0, 0);
#undef PK
}

__device__ __forceinline__ void attn_unit(bf16_t* Qrows, int h, const bf16_t* KVb, const bf16_t* KPb, int nkeys, bool rope, int s0, const float* ropetab, int dry) {
  unsigned char* lds = dyn_shm;
  const int tid = tid_(), wid = tid >> 6, lane = tid & 63, r32 = lane & 31, hi = lane >> 5;
  unsigned char* V_lds = lds; unsigned char* K_lds = lds + 3 * SHM_V;
  float* ws = (float*)(lds + 3 * SHM_V + 3 * SHM_K) + wid * 64; float* li_l = ws; float* al_l = ws + 32;
  float m_reg = -1e30f, l_reg = 0; f32x16 o[2] = {}; bf16x8 qr[6];
  __syncthreads();
  {
    const int row = wid * 32 + r32;
    const bf16_t* Qn = Qrows + (size_t)row * 1536 + h * 64 + hi * 8;
#pragma unroll
    for (int d0 = 0; d0 < 4; ++d0) qr[d0] = *reinterpret_cast<const bf16x8*>(Qn + d0 * 16);
    const bf16_t* Qp = Qrows + (size_t)row * 1536 + 1024 + h * 32;
    const int s = s0 + row;
#pragma unroll
    for (int blk = 0; blk < 2; ++blk) {
      bf16x8 x1 = *reinterpret_cast<const bf16x8*>(Qp + blk * 16), x2 = *reinterpret_cast<const bf16x8*>(Qp + blk * 16 + 8);
      if (rope) {
        const int pos = blk == 0 ? (s >> 6) : (s & 63);
        const float* tb = ropetab + pos * 16;
        float ov[8];
#pragma unroll
        for (int j = 0; j < 8; ++j) {
          float a = bf2f((bf16_t)x1[j]), b = bf2f((bf16_t)x2[j]), cs = tb[2 * j], sn = tb[2 * j + 1];
          ov[j] = hi == 0 ? a * cs - b * sn : b * cs + a * sn;
        }
        u32x4 w = {cvtpk(ov[0], ov[1]), cvtpk(ov[2], ov[3]), cvtpk(ov[4], ov[5]), cvtpk(ov[6], ov[7])};
        qr[4 + blk] = *reinterpret_cast<bf16x8*>(&w);
      } else {
        qr[4 + blk] = hi == 0 ? x1 : x2;
      }
    }
  }
  const int vrow = tid >> 3, vc = (tid & 7) * 8, vst = v_st(vrow, vc);
  const bf16_t* vsrc = KVb + (size_t)vrow * 2048 + h * 128 + 64 + vc;
  const bool kact = tid < 384;
  const int kr = kact ? tid / 12 : 0, kc = kact ? (tid % 12) * 8 : 0;
  const bf16_t* ksrc = kc < 64 ? KVb + (size_t)kr * 2048 + h * 128 + kc : KPb + (size_t)kr * 32 + (kc - 64);
  const long kstride = kc < 64 ? 2048 : 32;
  const int kst0 = KSWZ(kr, kc * 2), kst1 = KSWZ(32 + kr, kc * 2);
  const int vb0 = (int)(uintptr_t)V_lds + v_rd_base(lane);
  struct { bf16x8 vs, ks0, ks1; } sr_[2];
#define SLOAD(i, k0) do { sr_[i].vs = *reinterpret_cast<const bf16x8*>(vsrc + (size_t)(k0) * 2048); \
    if (kact) { sr_[i].ks0 = *reinterpret_cast<const bf16x8*>(ksrc + (long)(k0) * kstride); sr_[i].ks1 = *reinterpret_cast<const bf16x8*>(ksrc + (long)((k0) + 32) * kstride); } } while (0)
#define SWRITE(b, i) do { *(bf16x8*)(V_lds + (b) * SHM_V + vst) = sr_[i].vs; \
    if (kact) { *(bf16x8*)(K_lds + (b) * SHM_K + kst0) = sr_[i].ks0; *(bf16x8*)(K_lds + (b) * SHM_K + kst1) = sr_[i].ks1; } } while (0)
#define RESC(a) do { if (__any((a) < 1.f)) { if (hi == 0) al_l[r32] = (a); asm volatile("s_waitcnt lgkmcnt(0)" ::: "memory"); \
    for (int d = 0; d < 2; ++d) for (int r = 0; r < 16; ++r) o[d][r] *= al_l[crow(r, hi)]; } } while (0)
  f32x16 pA0, pA1, pB0, pB1; float alA, alB; bf16x8 pa0, pa1, pa2, pa3; const int NT = nkeys / 64;
  constexpr int SE = 0, SO = 1;
  SLOAD(SE, 0); SWRITE(0, SE); SLOAD(SO, 64); __syncthreads();
  qkt(pA0, pA1, K_lds, qr, r32, hi, 0.f); partialSM(pA0, pA1, m_reg, alA, true);
  SWRITE(1, SO); if (2 < NT) SLOAD(SE, 128);
  int bc = 1;
  for (int j = 1; j + 1 < NT; j += 2) {
    const int bp = bc == 0 ? 2 : bc - 1, bn = bc == 2 ? 0 : bc + 1;
    __syncthreads();
    SBAR(); qkt(pB0, pB1, K_lds + bc * SHM_K, qr, r32, hi, -m_reg);
    finishSM(pA0, pA1, alA, l_reg, pa0, pa1, pa2, pa3); SBAR();
    SLOAD(SO, (j + 2) * 64); SBAR();
    pv_d0(o, vb0 + bp * SHM_V, pa0, pa1, pa2, pa3); partialSM(pB0, pB1, m_reg, alB, false);
    SWRITE(bn, SE);
    RESC(alB);
    __syncthreads();
    SBAR(); qkt(pA0, pA1, K_lds + bn * SHM_K, qr, r32, hi, -m_reg);
    finishSM(pB0, pB1, alB, l_reg, pa0, pa1, pa2, pa3); SBAR();
    if (j + 3 < NT) SLOAD(SE, (j + 3) * 64); SBAR();
    pv_d0(o, vb0 + bc * SHM_V, pa0, pa1, pa2, pa3); partialSM(pA0, pA1, m_reg, alA, false);
    SWRITE(bp, SO);
    RESC(alA);
    bc = bp;
  }
  { const int bp = bc == 0 ? 2 : bc - 1;
    __syncthreads();
    SBAR(); qkt(pB0, pB1, K_lds + bc * SHM_K, qr, r32, hi, -m_reg);
    finishSM(pA0, pA1, alA, l_reg, pa0, pa1, pa2, pa3); SBAR();
    pv_d0(o, vb0 + bp * SHM_V, pa0, pa1, pa2, pa3); partialSM(pB0, pB1, m_reg, alB, false);
    RESC(alB);
    finishSM(pB0, pB1, alB, l_reg, pa0, pa1, pa2, pa3); SBAR();
    pv_d0(o, vb0 + bc * SHM_V, pa0, pa1, pa2, pa3); }
  if (hi == 0) li_l[r32] = l_reg; asm volatile("s_waitcnt lgkmcnt(0)" ::: "memory");
  float rli[16];
#pragma unroll
  for (int r = 0; r < 16; ++r) rli[r] = __builtin_amdgcn_rcpf(li_l[crow(r, hi)]);
  bf16_t* Ow = Qrows + (size_t)(wid * 32) * 1536 + h * 64;
  if (!dry)
#pragma unroll
  for (int r = 0; r < 16; ++r) { int orow = crow(r, hi);
#pragma unroll
    for (int d0 = 0; d0 < 2; ++d0) Ow[(size_t)orow * 1536 + d0 * 32 + r32] = f2bf(o[d0][r] * rli[r]); }
#undef SLOAD
#undef SWRITE
#undef RESC
}

__device__ __forceinline__ void attn_phase(KP p, int dry) {
  bf16_t* Q = (bf16_t*)(p->ws + WS_Q); const bf16_t* KV = (const bf16_t*)(p->ws + WS_KV); const bf16_t* KP = (const bf16_t*)(p->ws + WS_KPE);
  const float* ropetab = (const float*)(p->ws + WS_ROPE);
  const int xcd = bid_() & 7, slot = bid_() >> 3;
  const int G = gdim_();
  const int nit = G == 256 ? 6 : (1536 + G - 1) / G;
  for (int i = 0; i < nit; ++i) {
    int u;
    if (G == 256) u = i < 4 ? ((i * 16 + xcd * 2 + (slot >> 4)) << 4) + (slot & 15) : 1024 + (i - 4) * 256 + xcd * 32 + slot;
    else { u = bid_() + i * G; if (u >= 1536) break; }
    const bool samp = u < 1024;
    const int pair = samp ? u >> 4 : u - 1024, qb = samp ? u & 15 : 0, b = pair >> 4, h = pair & 15;
    const size_t qrow = samp ? (size_t)(MP + b * DSEQ + qb * 256) : (size_t)(b * SEQ);
    const size_t krow = samp ? (size_t)(MP + b * SKEYS) : (size_t)(b * SEQ);
    attn_unit(Q + qrow * 1536, h, KV + krow * 2048, KP + krow * 32, samp ? SKEYS : SEQ, samp, qb * 256, ropetab, dry);
  }
}

__device__ void mod_gemv_item(KP p, int it) {
  float* lds = (float*)dyn_shm;
  const int l = it / 96, n0 = (it % 96) * 64, tid = tid_();
  const float* wmod = p->in[l == 0 ? 7 : 24]; const float* bmod = p->in[l == 0 ? 8 : 25];
  __syncthreads();
  for (int e = tid; e < 5 * 1024; e += 512) { int c = e >> 10, k = e & 1023; float v = c == 0 ? p->in[6][k] : p->in[5][(c - 1) * 1024 + k]; lds[e] = v / (1.f + __expf(-v)); }
  __syncthreads();
  const int col = tid & 63, ks = tid >> 6;
  float a0 = 0, a1 = 0, a2 = 0, a3 = 0, a4 = 0;
  const float* wp = wmod + (size_t)(ks * 128) * 6144 + n0 + col;
#pragma unroll 8
  for (int k = 0; k < 128; ++k) { float w = wp[(size_t)k * 6144]; int kk = ks * 128 + k;
    a0 += lds[kk] * w; a1 += lds[1024 + kk] * w; a2 += lds[2048 + kk] * w; a3 += lds[3072 + kk] * w; a4 += lds[4096 + kk] * w; }
  float* red = lds + 5 * 1024;
  red[(ks * 5 + 0) * 64 + col] = a0; red[(ks * 5 + 1) * 64 + col] = a1; red[(ks * 5 + 2) * 64 + col] = a2; red[(ks * 5 + 3) * 64 + col] = a3; red[(ks * 5 + 4) * 64 + col] = a4;
  __syncthreads();
  if (tid < 320) { int c = tid >> 6, cc = tid & 63; float s = 0;
#pragma unroll
    for (int k8 = 0; k8 < 8; ++k8) s += red[(k8 * 5 + c) * 64 + cc];
    ((float*)(p->ws + WS_MOD))[(l * 5 + c) * 6144 + n0 + cc] = s + bmod[n0 + cc]; }
}

struct CvtMat { const float* src; int K, N, Npad; bf16_t* dst; int ldk, perm; };
__device__ __forceinline__ CvtMat get_mat(KP p, int layer, int i) {
  bf16_t* WB = (bf16_t*)(p->ws + WS_WB);
  if (layer == 0) {
    switch (i) {
      case 0: return CvtMat{p->in[11], 1024, 1536, 1536, WB + W0_IN, 1024, 0};
      case 1: return CvtMat{p->in[21], 1024, 1024, 1024, WB + W0_OUT, 1024, 0};
      case 2: return CvtMat{p->in[22], 1024, 4096, 4096, WB + W0_W1, 1024, 0};
      default: return CvtMat{p->in[23], 4096, 1024, 1024, WB + W0_W2, 4096, 0};
    }
  } else {
    switch (i) {
      case 0: return CvtMat{p->in[28], 1024, 672, 768, WB + W1_IN, 1024, 0};
      case 1: return CvtMat{p->in[30], 384, 1536, 1536, WB + W1_QB, 384, 1};
      case 2: return CvtMat{p->in[32], 256, 2048, 2048, WB + W1_KVB, 256, 0};
      case 3: return CvtMat{p->in[33], 1024, 1024, 1024, WB + W1_OUT, 1024, 0};
      case 4: return CvtMat{p->in[34], 1024, 4096, 4096, WB + W1_W1, 1024, 0};
      default: return CvtMat{p->in[35], 4096, 1024, 1024, WB + W1_W2, 4096, 0};
    }
  }
}
struct CvtTile { const float* src; int K, N; bf16_t* dst; int ldk, perm, k0, n0; float wsc; };
__device__ __forceinline__ CvtTile cvt_desc(KP p, int layer, int t, int total) {
  bf16_t* WB = (bf16_t*)(p->ws + WS_WB);
  const int nm = layer == 0 ? 4 : 6;
  if (t < total) {
    int tt = t, i = 0;
    for (; i < nm - 1; ++i) { CvtMat m = get_mat(p, layer, i); int c = (m.K / 64) * (m.Npad / 64); if (tt < c) break; tt -= c; }
    const CvtMat m = get_mat(p, layer, i);
    const int nn = m.Npad / 64;
    return CvtTile{m.src, m.K, m.N, m.dst, m.ldk, m.perm, (tt / nn) * 64, (tt % nn) * 64, m.perm ? ATT_SCALE * 1.4426950408889634f : 1.f};
  }
  const int e = t - total;
  if (e < 32) {
    const int dg = e >> 3, nb = e & 7, dir = dg >> 1, gate = dg & 1;
    return CvtTile{p->in[gate == 0 ? 14 : 16] + (size_t)(dir * 8 + nb) * 4096, 64, 64, WB + W0_G + (size_t)e * 4096, 64, 0, 0, 0, -1.4426950408889634f};
  }
  const int e2 = e - 32, gi = e2 >> 2, q = e2 & 3;
  return CvtTile{p->in[19] + (size_t)gi * 16384, 128, 128, WB + W0_P + (size_t)gi * 16384, 128, 0, (q >> 1) * 64, (q & 1) * 64, 1.f};
}
__device__ __forceinline__ void cvt_load(const CvtTile& d, int tid, f32x4& v0, f32x4& v1) {
  const int kk = tid >> 4, n4 = (tid & 15) * 4;
  const f32x4 zero = {0.f, 0.f, 0.f, 0.f};
  const bool ok = d.n0 + n4 < d.N;
  const float* sp = d.src + (size_t)(d.k0 + kk) * d.N + d.n0 + (ok ? n4 : 0);
  v0 = ok ? *(const f32x4*)sp : zero;
  v1 = ok ? *(const f32x4*)(sp + (size_t)32 * d.N) : zero;
}
__device__ void cvt_weights(KP p, int layer, int start, int stride) {
  float* tile = (float*)dyn_shm;
  const int total = layer == 0 ? 384 + 256 + 1024 + 1024 : 192 + 144 + 128 + 256 + 1024 + 1024;
  const int all = total + (layer == 0 ? 32 + 16 : 0);
  const int tid = tid_();
  int t = start;
  if (t >= all) return;
  CvtTile d = cvt_desc(p, layer, t, total);
  f32x4 v0, v1; cvt_load(d, tid, v0, v1);
  for (;;) {
    const int kk = tid >> 4, n4 = (tid & 15) * 4;
    __syncthreads();
    tile[kk * 65 + n4 + 0] = v0[0]; tile[kk * 65 + n4 + 1] = v0[1]; tile[kk * 65 + n4 + 2] = v0[2]; tile[kk * 65 + n4 + 3] = v0[3];
    tile[(kk + 32) * 65 + n4 + 0] = v1[0]; tile[(kk + 32) * 65 + n4 + 1] = v1[1]; tile[(kk + 32) * 65 + n4 + 2] = v1[2]; tile[(kk + 32) * 65 + n4 + 3] = v1[3];
    __syncthreads();
    const int tn = t + stride; const bool more = tn < all;
    CvtTile dn = d;
    if (more) { dn = cvt_desc(p, layer, tn, total); cvt_load(dn, tid, v0, v1); }
    {
      int n = tid >> 3, k8 = (tid & 7) * 8, ng = d.n0 + n;
      if (d.perm) { int hh = ng / 96, dd = ng % 96; ng = dd < 64 ? hh * 64 + dd : 1024 + hh * 32 + (dd - 64); }
      float v[8];
#pragma unroll
      for (int j = 0; j < 8; ++j) v[j] = tile[(k8 + j) * 65 + n];
      const float wsc = d.wsc;
      u32x4 w = {cvtpk(v[0] * wsc, v[1] * wsc), cvtpk(v[2] * wsc, v[3] * wsc), cvtpk(v[4] * wsc, v[5] * wsc), cvtpk(v[6] * wsc, v[7] * wsc)};
      *(u32x4*)(d.dst + (size_t)ng * d.ldk + d.k0 + k8) = w;
    }
    if (!more) break;
    t = tn; d = dn;
  }
}

__device__ __forceinline__ void mod_row_store(bf16_t* H, int row, int lane, const f32x4 (&x)[4], const f32x4 (&gv)[4], float ss, const float* modl, int chunk_shift) {
  const float rstd = rsqrtf(ss * (1.f / DM) + EPS);
  const float* mc = modl + cond_of_row(row) * 6144 + chunk_shift * 1024;
#pragma unroll
  for (int i = 0; i < 4; ++i) {
    const int col = (i * 64 + lane) * 4;
    f32x4 sh = *(const f32x4*)(mc + col), sc = *(const f32x4*)(mc + 1024 + col);
    f32x4 y = x[i] * rstd * gv[i] * (sc + 1.f) + sh;
    u32x2 w; w.x = cvtpk(y[0], y[1]); w.y = cvtpk(y[2], y[3]);
    *(u32x2*)(H + (size_t)row * DM + col) = w;
  }
}
__device__ void modulate_phase(KP p, const float* src0, const float* src1, const float* g, const float* modl, int chunk_shift) {
  bf16_t* H = (bf16_t*)(p->ws + WS_H);
  const int tid = tid_(); const int wid = tid >> 6, lane = tid & 63;
  f32x4 gv[4];
#pragma unroll
  for (int i = 0; i < 4; ++i) gv[i] = *(const f32x4*)(g + (i * 64 + lane) * 4);
  const int stride = gdim_() * 8;
  for (int row = bid_() * 8 + wid; row < M; row += 2 * stride) {
    const int row2 = row + stride; const bool v2 = row2 < M; const int r2 = v2 ? row2 : row;
    const float* xp = row < MP ? src0 + (size_t)row * DM : src1 + (size_t)(row - MP) * DM;
    const float* xq = r2 < MP ? src0 + (size_t)r2 * DM : src1 + (size_t)(r2 - MP) * DM;
    f32x4 x[4], z[4]; float ss = 0, s2 = 0;
#pragma unroll
    for (int i = 0; i < 4; ++i) { x[i] = *(const f32x4*)(xp + (i * 64 + lane) * 4); z[i] = *(const f32x4*)(xq + (i * 64 + lane) * 4); }
#pragma unroll
    for (int i = 0; i < 4; ++i) { ss += x[i][0] * x[i][0] + x[i][1] * x[i][1] + x[i][2] * x[i][2] + x[i][3] * x[i][3]; s2 += z[i][0] * z[i][0] + z[i][1] * z[i][1] + z[i][2] * z[i][2] + z[i][3] * z[i][3]; }
    ss = wave_sum(ss, lane); s2 = wave_sum(s2, lane);
    mod_row_store(H, row, lane, x, gv, ss, modl, chunk_shift);
    if (v2) mod_row_store(H, row2, lane, z, gv, s2, modl, chunk_shift);
  }
}
__device__ void final_norm_phase(KP p, int dry) {
  float* X = p->out; const float* g = p->in[36];
  const int tid = tid_(); const int wid = tid >> 6, lane = tid & 63;
  f32x4 gv[4];
#pragma unroll
  for (int i = 0; i < 4; ++i) gv[i] = *(const f32x4*)(g + (i * 64 + lane) * 4);
  const int stride = gdim_() * 8;
  for (int row = bid_() * 8 + wid; row < M; row += 2 * stride) {
    const int row2 = row + stride; const bool v2 = row2 < M; const int r2 = v2 ? row2 : row;
    float* xp = X + (size_t)row * DM; float* xq = X + (size_t)r2 * DM;
    f32x4 x[4], z[4]; float ss = 0, s2 = 0;
#pragma unroll
    for (int i = 0; i < 4; ++i) { x[i] = *(const f32x4*)(xp + (i * 64 + lane) * 4); z[i] = *(const f32x4*)(xq + (i * 64 + lane) * 4); }
#pragma unroll
    for (int i = 0; i < 4; ++i) { ss += x[i][0] * x[i][0] + x[i][1] * x[i][1] + x[i][2] * x[i][2] + x[i][3] * x[i][3]; s2 += z[i][0] * z[i][0] + z[i][1] * z[i][1] + z[i][2] * z[i][2] + z[i][3] * z[i][3]; }
    ss = wave_sum(ss, lane); s2 = wave_sum(s2, lane);
    const float rstd = rsqrtf(ss * (1.f / DM) + EPS), rstd2 = rsqrtf(s2 * (1.f / DM) + EPS);
    if (!dry) {
#pragma unroll
      for (int i = 0; i < 4; ++i) *(f32x4*)(xp + (i * 64 + lane) * 4) = x[i] * rstd * gv[i];
      if (v2) {
#pragma unroll
        for (int i = 0; i < 4; ++i) *(f32x4*)(xq + (i * 64 + lane) * 4) = z[i] * rstd2 * gv[i];
      }
    }
  }
}
struct L1Row { f32x4 qa, qb, kv; float kp; };
__device__ __forceinline__ f32x4 bf4_to_f32(u32x2 w) {
  return (f32x4){__uint_as_float(w.x << 16), __uint_as_float(w.x & 0xffff0000u), __uint_as_float(w.y << 16), __uint_as_float(w.y & 0xffff0000u)};
}
__device__ __forceinline__ void l1_row_load(const bf16_t* Z1, int row, int lane, L1Row& r) {
  const bf16_t* z = Z1 + (size_t)row * 768;
  const u32x2 zero = {0u, 0u};
  r.qa = bf4_to_f32(lane < 48 ? *(const u32x2*)(z + lane * 4) : zero);
  r.qb = bf4_to_f32(lane < 48 ? *(const u32x2*)(z + 192 + lane * 4) : zero);
  r.kv = bf4_to_f32(*(const u32x2*)(z + 384 + lane * 4));
  r.kp = lane < 32 ? bf2f(z[640 + lane]) : 0.f;
}
__device__ __forceinline__ void l1_row_finish(KP p, int row, int lane, const L1Row& r, const f32x4& gqa, const f32x4& gqb, const f32x4& gk) {
  bf16_t* CQN = (bf16_t*)(p->ws + WS_CQN); bf16_t* CKVN = (bf16_t*)(p->ws + WS_CKVN); bf16_t* KPE = (bf16_t*)(p->ws + WS_KPE);
  const float* ropetab = (const float*)(p->ws + WS_ROPE);
  float ss = r.qa[0] * r.qa[0] + r.qa[1] * r.qa[1] + r.qa[2] * r.qa[2] + r.qa[3] * r.qa[3] + r.qb[0] * r.qb[0] + r.qb[1] * r.qb[1] + r.qb[2] * r.qb[2] + r.qb[3] * r.qb[3];
  ss = wave_sum(ss, lane);
  const float rstd = rsqrtf(ss * (1.f / 384) + EPS);
  if (lane < 48) {
    const f32x4 ya = r.qa * rstd * gqa, yb = r.qb * rstd * gqb;
    u32x2 wa; wa.x = cvtpk(ya[0], ya[1]); wa.y = cvtpk(ya[2], ya[3]);
    u32x2 wb; wb.x = cvtpk(yb[0], yb[1]); wb.y = cvtpk(yb[2], yb[3]);
    *(u32x2*)(CQN + (size_t)row * 384 + lane * 4) = wa; *(u32x2*)(CQN + (size_t)row * 384 + 192 + lane * 4) = wb;
  }
  const float s2 = wave_sum(r.kv[0] * r.kv[0] + r.kv[1] * r.kv[1] + r.kv[2] * r.kv[2] + r.kv[3] * r.kv[3], lane);
  const float r2 = rsqrtf(s2 * (1.f / 256) + EPS);
  const f32x4 y = r.kv * r2 * gk;
  int krow; bool rope; int s = 0;
  if (row < MP) { krow = row; rope = false; *(f32x4*)(p->out + O_CKV + (size_t)row * 256 + lane * 4) = y; }
  else { int b = (row - MP) >> 12; s = (row - MP) & 4095; krow = MP + b * SKEYS + s; rope = true; }
  u32x2 w; w.x = cvtpk(y[0], y[1]); w.y = cvtpk(y[2], y[3]);
  *(u32x2*)(CKVN + (size_t)krow * 256 + lane * 4) = w;
  const float kp = r.kp;
  const float partner = lane_xor(kp, lane, 8);
  if (!rope) { if (lane < 32) { p->out[O_KPE + (size_t)row * 32 + lane] = kp; KPE[(size_t)krow * 32 + lane] = f2bf(kp); } }
  else if (lane < 32) {
    int pos = lane < 16 ? (s >> 6) : (s & 63); int j = lane & 7;
    float cs = ropetab[pos * 16 + 2 * j], sn = ropetab[pos * 16 + 2 * j + 1];
    float ov = (lane & 8) == 0 ? kp * cs - partner * sn : kp * cs + partner * sn;
    KPE[(size_t)krow * 32 + lane] = f2bf(ov);
  }
}
__device__ void l1_rows_phase(KP p) {
  const bf16_t* Z1 = (const bf16_t*)(p->ws + WS_Z1);
  bf16_t* CKVN = (bf16_t*)(p->ws + WS_CKVN); bf16_t* KPE = (bf16_t*)(p->ws + WS_KPE);
  const int tid = tid_(); const int wid = tid >> 6, lane = tid & 63;
  const int l48 = lane < 48 ? lane : 0;
  const f32x4 gqa = *(const f32x4*)(p->in[29] + l48 * 4), gqb = *(const f32x4*)(p->in[29] + 192 + l48 * 4), gk = *(const f32x4*)(p->in[31] + lane * 4);
  const int stride = gdim_() * 8;
  for (int row = bid_() * 8 + wid; row < M; row += 2 * stride) {
    const int row2 = row + stride; const bool v2 = row2 < M;
    L1Row ra, rb;
    l1_row_load(Z1, row, lane, ra); l1_row_load(Z1, v2 ? row2 : row, lane, rb);
    l1_row_finish(p, row, lane, ra, gqa, gqb, gk);
    if (v2) l1_row_finish(p, row2, lane, rb, gqa, gqb, gk);
  }
  for (int idx = bid_() * 8 + wid; idx < NB_S * PAST; idx += stride) {
    const int b = idx >> 9, j = idx & 511, krow = MP + b * SKEYS + DSEQ + j;
    f32x4 kv = *(const f32x4*)(p->in[3] + ((size_t)(b * PAST + j)) * 256 + lane * 4);
    u32x2 w; w.x = cvtpk(kv[0], kv[1]); w.y = cvtpk(kv[2], kv[3]);
    *(u32x2*)(CKVN + (size_t)krow * 256 + lane * 4) = w;
    if (lane < 32) KPE[(size_t)krow * 32 + lane] = f2bf(p->in[4][((size_t)(b * PAST + j)) * 32 + lane]);
  }
}

__device__ __forceinline__ float fast_sigmoid(float x) { return __builtin_amdgcn_rcpf(1.f + __expf(-x)); }
__device__ __forceinline__ float fast_gelu(float x) {
  float u = 0.7978845608028654f * (x + 0.044715f * x * x * x);
  float e = __expf(2.f * u);
  float th = 1.f - 2.f * __builtin_amdgcn_rcpf(e + 1.f);
  return 0.5f * x * (1.f + th);
}
__device__ __forceinline__ float bperm(int srclane, float v) { return __int_as_float(__builtin_amdgcn_ds_bpermute(srclane << 2, __float_as_int(v))); }
__device__ __forceinline__ void scan4(float& P, float& H, int lane, int stepl, int oq) {
  { const float Pp = bperm(lane - stepl, P), Hp = bperm(lane - stepl, H); if (oq >= 1) { H = P * Hp + H; P = Pp * P; } }
  { const float Pp = bperm(lane - 2 * stepl, P), Hp = bperm(lane - 2 * stepl, H); if (oq >= 2) { H = P * Hp + H; P = Pp * P; } }
}
__device__ void lru_item(KP p, int cidx, int nb0, int mode) {
  const bf16_t* Z0 = (const bf16_t*)(p->ws + WS_Z0); bf16_t* H = (bf16_t*)(p->ws + WS_H);
  const bf16_t* Wg = (const bf16_t*)(p->ws + WS_WB) + W0_G;
  const float* LS8 = (const float*)(p->ws + WS_LS8);
  float2* SUM = (float2*)(p->ws + WS_SUM);
  constexpr int UB = 58368;
  const int tid = tid_(), lane = tid & 63, fr = lane & 15, fq = lane >> 4;
  const int wid = __builtin_amdgcn_readfirstlane(tid >> 6), dir = wid >> 2, wq = wid & 3;
  const int t0 = cidx * 64;
  int s0, s1, bsamp = -1;
  if (t0 < MP) { s0 = (t0 / SEQ) * SEQ; s1 = s0 + SEQ; } else { bsamp = (t0 - MP) / DSEQ; s0 = MP + bsamp * DSEQ; s1 = s0 + DSEQ; }
  const int c0 = s0 / 64, c1 = s1 / 64;
  const int chc = tid & 63;
  const int ch = wq * 16 + fr;
  const int oq = dir ? 3 - fq : fq, stepl = dir ? -16 : 16, lastl = fr + (dir ? 0 : 48);
  unsigned xv[2][5], gz[2][4];
  float w0[2], w1[2], w2[2], w3[2], bb[2], ba[2], bi[2], l8[2], cP[2], cH[2];
  bf16x8 wa[2][2], wi[2][2];
#pragma unroll
  for (int u = 0; u < 2; ++u) {
    const int nb = nb0 + u, cgc = nb * 64 + chc, cg_ = nb * 64 + ch;
#pragma unroll
    for (int i = 0; i < 5; ++i) { int e = tid + i * 512; int r = e >> 5, c2 = (e & 31) * 2, t = t0 - 2 + r;
      xv[u][i] = (e < 67 * 32 && t >= s0 && t < s1) ? *(const unsigned*)(Z0 + (size_t)t * 1536 + nb * 64 + c2) : 0u; }
    const float* cw = p->in[12];
    w0[u] = cw[cgc]; w1[u] = cw[512 + cgc]; w2[u] = cw[1024 + cgc]; w3[u] = cw[1536 + cgc]; bb[u] = p->in[13][cgc];
    ba[u] = -1.4426950408889634f * p->in[15][dir * 512 + cg_]; bi[u] = -1.4426950408889634f * p->in[17][dir * 512 + cg_]; l8[u] = LS8[dir * 512 + cg_];
    { const bf16_t* pa = Wg + (size_t)((dir * 2 + 0) * 8 + nb) * 4096 + (size_t)ch * 64 + fq * 8; const bf16_t* pi = pa + 8 * 4096;
      wa[u][0] = *(const bf16x8*)pa; wa[u][1] = *(const bf16x8*)(pa + 32); wi[u][0] = *(const bf16x8*)pi; wi[u][1] = *(const bf16x8*)(pi + 32); }
#pragma unroll
    for (int i = 0; i < 4; ++i) { int e = tid + i * 512; int t = e >> 5, c2 = (e & 31) * 2;
      gz[u][i] = mode == 1 ? *(const unsigned*)(Z0 + (size_t)(t0 + t) * 1536 + 512 + nb * 64 + c2) : 0u; }
    float cPu = 1.f, cHu = 0.f;
    if (mode == 1) {
      int lo, hi;
      if (dir == 0) { const int n = cidx - c0, q = (n + 3) >> 2; lo = c0 + fq * q; hi = lo + q < cidx ? lo + q : cidx;
        for (int c = lo; c < hi; c += 4) { float2 sm[4];
#pragma unroll
          for (int j = 0; j < 4; ++j) sm[j] = (c + j < hi) ? SUM[((size_t)(c + j) * 2) * 512 + cg_] : make_float2(1.f, 0.f);
#pragma unroll
          for (int j = 0; j < 4; ++j) { cHu = sm[j].x * cHu + sm[j].y; cPu *= sm[j].x; } }
      } else { const int n = c1 - 1 - cidx, q = (n + 3) >> 2; hi = c1 - 1 - fq * q; lo = hi - q > cidx ? hi - q : cidx;
        for (int c = hi; c > lo; c -= 4) { float2 sm[4];
#pragma unroll
          for (int j = 0; j < 4; ++j) sm[j] = (c - j > lo) ? SUM[((size_t)(c - j) * 2 + 1) * 512 + cg_] : make_float2(1.f, 0.f);
#pragma unroll
          for (int j = 0; j < 4; ++j) { cHu = sm[j].x * cHu + sm[j].y; cPu *= sm[j].x; } }
      }
    }
    cP[u] = cPu; cH[u] = cHu;
  }
  __syncthreads();
#pragma unroll
  for (int u = 0; u < 2; ++u) { float* xrL = (float*)(dyn_shm + u * UB + 25600);
#pragma unroll
    for (int i = 0; i < 5; ++i) { int e = tid + i * 512; if (e < 67 * 32) { int r = e >> 5, c2 = (e & 31) * 2;
      xrL[r * 64 + c2] = bf2f((bf16_t)(xv[u][i] & 0xffff)); xrL[r * 64 + c2 + 1] = bf2f((bf16_t)(xv[u][i] >> 16)); } } }
  __syncthreads();
#pragma unroll
  for (int u = 0; u < 2; ++u) { float* xc = (float*)(dyn_shm + u * UB); bf16_t* xcb = (bf16_t*)(dyn_shm + u * UB + 16384); const float* xrL = (const float*)(dyn_shm + u * UB + 25600);
#pragma unroll
    for (int i = 0; i < 8; ++i) { int t = (tid >> 6) + 8 * i;
      float v = bb[u] + w0[u] * xrL[t * 64 + chc] + w1[u] * xrL[(t + 1) * 64 + chc] + w2[u] * xrL[(t + 2) * 64 + chc] + w3[u] * xrL[(t + 3) * 64 + chc];
      xc[t * 64 + chc] = v; xcb[t * 72 + chc] = f2bf(v); } }
  __syncthreads();
#pragma unroll
  for (int u = 0; u < 2; ++u) {
    const int nb = nb0 + u, cg_ = nb * 64 + ch;
    const float* xc = (const float*)(dyn_shm + u * UB); const bf16_t* xcb = (const bf16_t*)(dyn_shm + u * UB + 16384); float* Hs = (float*)(dyn_shm + u * UB + 25600);
    float av[4][4], uv[4][4], Pt[4], Ht[4], Pe[4], He[4];
#pragma unroll
    for (int mt = 0; mt < 4; ++mt) {
      const bf16x8 a0 = *(const bf16x8*)(xcb + (mt * 16 + fr) * 72 + fq * 8), a1 = *(const bf16x8*)(xcb + (mt * 16 + fr) * 72 + 32 + fq * 8);
      f32x4 ga = {0.f, 0.f, 0.f, 0.f}, gi = {0.f, 0.f, 0.f, 0.f};
      ga = __builtin_amdgcn_mfma_f32_16x16x32_bf16(a0, wa[u][0], ga, 0, 0, 0); ga = __builtin_amdgcn_mfma_f32_16x16x32_bf16(a1, wa[u][1], ga, 0, 0, 0);
      gi = __builtin_amdgcn_mfma_f32_16x16x32_bf16(a0, wi[u][0], gi, 0, 0, 0); gi = __builtin_amdgcn_mfma_f32_16x16x32_bf16(a1, wi[u][1], gi, 0, 0, 0);
#pragma unroll
      for (int j = 0; j < 4; ++j) {
        const float ea = 1.f + __builtin_amdgcn_exp2f(fminf(ga[j] + ba[u], 57.f)), ei = 1.f + __builtin_amdgcn_exp2f(fminf(gi[j] + bi[u], 57.f));
        const float rc = __builtin_amdgcn_rcpf(ea * ei);
        const float r = rc * ei, ii = rc * ea;
        const float l2 = r * l8[u];
        const float a = __builtin_amdgcn_exp2f(l2);
        const float x2 = l2 * (2.f * 0.6931471805599453f);
        const float ser = -x2 * fmaf(x2, fmaf(x2, fmaf(x2, fmaf(x2, fmaf(x2, 1.f / 720.f, 1.f / 120.f), 1.f / 24.f), 1.f / 6.f), 0.5f), 1.f);
        const float om = x2 > -0.25f ? ser : 1.f - a * a;
        av[mt][j] = a; uv[mt][j] = __builtin_amdgcn_sqrtf(om) * ii * xc[(mt * 16 + fq * 4 + j) * 64 + ch];
      }
      float P = 1.f, Hh = 0.f;
      if (dir == 0) {
#pragma unroll
        for (int j = 0; j < 4; ++j) { Hh = av[mt][j] * Hh + uv[mt][j]; P *= av[mt][j]; }
      } else {
#pragma unroll
        for (int j = 3; j >= 0; --j) { Hh = av[mt][j] * Hh + uv[mt][j]; P *= av[mt][j]; }
      }
      scan4(P, Hh, lane, stepl, oq);
      const float Pp = bperm(lane - stepl, P), Hp = bperm(lane - stepl, Hh);
      Pe[mt] = oq >= 1 ? Pp : 1.f; He[mt] = oq >= 1 ? Hp : 0.f;
      Pt[mt] = bperm(lastl, P); Ht[mt] = bperm(lastl, Hh);
    }
    if (mode == 0) {
      float P = 1.f, Hh = 0.f;
      if (dir == 0) {
#pragma unroll
        for (int mt = 0; mt < 4; ++mt) { Hh = Pt[mt] * Hh + Ht[mt]; P *= Pt[mt]; }
      } else {
#pragma unroll
        for (int mt = 3; mt >= 0; --mt) { Hh = Pt[mt] * Hh + Ht[mt]; P *= Pt[mt]; }
      }
      if (fq == 0) SUM[((size_t)cidx * 2 + dir) * 512 + cg_] = make_float2(P, Hh);
    } else {
      float cPu = cP[u], cHu = cH[u];
      scan4(cPu, cHu, lane, 16, fq);
      const float tP = bperm(fr + 48, cPu), tH = bperm(fr + 48, cHu);
      float c = bsamp >= 0 ? p->in[2][(bsamp * 2 + dir) * 512 + cg_] : 0.f;
      c = tP * c + tH;
      float* hp = Hs + dir * 4096 + ch;
      if (dir == 0) {
#pragma unroll
        for (int mt = 0; mt < 4; ++mt) { float s = Pe[mt] * c + He[mt];
#pragma unroll
          for (int j = 0; j < 4; ++j) { s = av[mt][j] * s + uv[mt][j]; hp[(mt * 16 + fq * 4 + j) * 64] = s; }
          c = Pt[mt] * c + Ht[mt]; }
        if (bsamp < 0 && cidx == c1 - 1 && fq == 0) p->out[O_LRU + (size_t)((t0 / SEQ) * 2 + 0) * 512 + cg_] = c;
      } else {
#pragma unroll
        for (int mt = 3; mt >= 0; --mt) { float s = Pe[mt] * c + He[mt];
#pragma unroll
          for (int j = 3; j >= 0; --j) { s = av[mt][j] * s + uv[mt][j]; hp[(mt * 16 + fq * 4 + j) * 64] = s; }
          c = Pt[mt] * c + Ht[mt]; }
        if (bsamp < 0 && cidx == c0 && fq == 0) p->out[O_LRU + (size_t)((t0 / SEQ) * 2 + 1) * 512 + cg_] = c;
      }
    }
  }
  if (mode == 0) return;
  __syncthreads();
#pragma unroll
  for (int u = 0; u < 2; ++u) { const float* Hs = (const float*)(dyn_shm + u * UB + 25600); const int nb = nb0 + u;
#pragma unroll
    for (int i = 0; i < 4; ++i) { int e = tid + i * 512; int t = e >> 5, c2 = (e & 31) * 2;
      float g0 = bf2f((bf16_t)(gz[u][i] & 0xffff)), g1 = bf2f((bf16_t)(gz[u][i] >> 16));
      float y0 = (Hs[t * 64 + c2] + Hs[4096 + t * 64 + c2]) * fast_gelu(g0);
      float y1 = (Hs[t * 64 + c2 + 1] + Hs[4096 + t * 64 + c2 + 1]) * fast_gelu(g1);
      *(unsigned*)(H + (size_t)(t0 + t) * DM + nb * 64 + c2) = cvtpk(y0, y1); } }
}

__device__ void pool_item(KP p, int cidx, int gi) {
  const bf16_t* Z0 = (const bf16_t*)(p->ws + WS_Z0); bf16_t* H = (bf16_t*)(p->ws + WS_H);
  const bf16_t* Wp = (const bf16_t*)(p->ws + WS_WB) + W0_P + (size_t)gi * 16384;
  float* xp = (float*)dyn_shm;
  bf16_t* dL = (bf16_t*)(xp + 80 * 128);
  const int tid = tid_(), wid = tid >> 6, lane = tid & 63, fr = lane & 15, fq = lane >> 4;
  const int t0 = cidx * 64;
  int s0, s1;
  if (t0 < MP) { s0 = (t0 / SEQ) * SEQ; s1 = s0 + SEQ; } else { int b = (t0 - MP) / DSEQ; s0 = MP + b * DSEQ; s1 = s0 + DSEQ; }
  __syncthreads();
  for (int e = tid; e < 80 * 64; e += 512) { int r = e >> 6, c2 = (e & 63) * 2, t = t0 - 8 + r;
    float a = 0.f, b = 0.f;
    if (t >= s0 && t < s1) { unsigned v = *(const unsigned*)(Z0 + (size_t)t * 1536 + 1024 + gi * 128 + c2); a = bf2f((bf16_t)(v & 0xffff)); b = bf2f((bf16_t)(v >> 16)); }
    xp[r * 128 + c2] = a; xp[r * 128 + c2 + 1] = b; }
  __syncthreads();
  const int w = 2 << gi, left = w >> 1, right = w - 1 - left;
  {
    const int c = tid & 127, tq = tid >> 7, tb = tq * 16;
    float S = 0.f;
    for (int k = tb - left; k <= tb + right; ++k) S += xp[(k + 8) * 128 + c];
#pragma unroll
    for (int i = 0; i < 16; ++i) { const int t = tb + i, tg = t0 + t;
      const int lo = tg - left < s0 ? s0 : tg - left, hi = tg + right > s1 - 1 ? s1 - 1 : tg + right;
      const float d = S * __builtin_amdgcn_rcpf((float)(hi - lo + 1)) - xp[(t + 8) * 128 + c];
      dL[t * 136 + c] = f2bf(d);
      S += xp[(t + 1 + right + 8) * 128 + c] - xp[(t - left + 8) * 128 + c]; }
  }
  __syncthreads();
  {
    bf16x8 wf[4];
#pragma unroll
    for (int ks = 0; ks < 4; ++ks) wf[ks] = *(const bf16x8*)(Wp + (size_t)(wid * 16 + fr) * 128 + ks * 32 + fq * 8);
    const f32x4 sc = *(const f32x4*)(p->in[20] + gi * 128 + wid * 16 + fq * 4);
#pragma unroll
    for (int mt = 0; mt < 4; ++mt) {
      f32x4 acc = {0.f, 0.f, 0.f, 0.f};
#pragma unroll
      for (int ks = 0; ks < 4; ++ks) {
        bf16x8 df = *(const bf16x8*)(dL + (mt * 16 + fr) * 136 + ks * 32 + fq * 8);
        acc = __builtin_amdgcn_mfma_f32_16x16x32_bf16(wf[ks], df, acc, 0, 0, 0);
      }
      acc = acc * sc;
      u32x2 o; o.x = cvtpk(acc[0], acc[1]); o.y = cvtpk(acc[2], acc[3]);
      *(u32x2*)(H + (size_t)(t0 + mt * 16 + fr) * DM + 512 + gi * 128 + wid * 16 + fq * 4) = o;
    }
  }
}

__global__ void __launch_bounds__(512, 2) fwd_megakernel(Params kparams) {
  cg::grid_group grid = cg::this_grid();
  KP p = (KP)__builtin_amdgcn_kernarg_segment_ptr();
  unsigned char* ws = p->ws;
  bf16_t* WB = (bf16_t*)(ws + WS_WB);
  bf16_t* H = (bf16_t*)(ws + WS_H);
  float* X = p->out;
  const float* MOD = (const float*)(ws + WS_MOD);
  volatile LAS unsigned* xst = (volatile LAS unsigned*)(dyn_shm + LDS_MAIN);
  if (threadIdx.x == 0) { xst[0] = 0u; xst[1] = 0u; }
  __syncthreads();
  (void)xcd_barrier_post((unsigned*)(ws + WS_BAR), xst);
  int rep = 0;
  const int p_lo = p->p_lo, p_hi = p->p_hi, probe = p->pad, coop = p->coop;
  for (int ph = p_lo; ph < p_hi; ++ph) {
    asm volatile("" : "+s"(p));
    const int G = gdim_(), bid = bid_();
    unsigned char* ws = p->ws; bf16_t* WB = (bf16_t*)(ws + WS_WB); bf16_t* H = (bf16_t*)(ws + WS_H); float* X = p->out; const float* MOD = (const float*)(ws + WS_MOD);
#if PROBE_PH >= 0
    const int dry = (ph == probe && rep == 0) ? 1 : 0;
#else
    const int dry = 0;
#endif
    if (PROBE_PH == 99 && probe == 99 && ph == 1) { XcdBarrier xb; xb.bar = (unsigned*)(ws + WS_BAR); xb.st = (volatile LAS unsigned*)(dyn_shm + LDS_MAIN); for (int q = 0; q < 10; ++q) xcd_barrier(xb); }
    GemmDesc g1{nullptr, nullptr, 0, 0, 0, 0, 0, 0, nullptr, 0, nullptr, nullptr, nullptr, 0, 0};
    bool isg = false;
    const float* MODL = MOD + (ph >= 11 ? 5 * 6144 : 0);
    const bf16_t* U = (const bf16_t*)(ws + WS_U);
    switch (ph) {
      case 0: {
        for (int it = bid; it < 192; it += G) mod_gemv_item(p, it);
        if (bid == G - 1) { int t = tid_(); int pos = t >> 3, j = t & 7;
          float inv = exp2f(-(float)j * 0.125f * 13.287712379549449f);
          float s, c; my_sincos((float)pos * inv, s, c);
          float* rt = (float*)(ws + WS_ROPE); rt[t * 2] = c; rt[t * 2 + 1] = s; }
        if (bid == G - 2) { int t = tid_(); float* l8 = (float*)(ws + WS_LS8);
          for (int e = t; e < 1024; e += 512) l8[e] = -8.f * 1.4426950408889634f * log1pf(__expf(-p->in[18][e])); }
      } break;
      case 2: g1 = GemmDesc{H, WB + W0_IN, 1024, 1024, M, 1536, 1024, 0, ws + WS_Z0, 1536, nullptr, nullptr, nullptr, 0, 0}; isg = true; break;
      case 5: g1 = GemmDesc{H, WB + W0_OUT, 1024, 1024, M, 1024, 1024, 2, X, 1024, p->in[0], p->in[1], MOD + 2 * 1024, 0, 0}; isg = true; break;
      case 7: case 9: case 19: case 21: { int ro = (ph == 7 || ph == 19) ? 0 : MH;
        g1 = GemmDesc{H + (size_t)ro * DM, WB + (ph < 11 ? W0_W1 : W1_W1), 1024, 1024, MH, 4096, 1024, 1, ws + WS_U, 4096, nullptr, nullptr, nullptr, 0, 0}; isg = true; } break;
      case 8: case 10: case 20: case 22: { int ro = (ph == 8 || ph == 20) ? 0 : MH;
        g1 = GemmDesc{U, WB + (ph < 11 ? W0_W2 : W1_W2), 4096, 4096, MH, 1024, 4096, 2, X, 1024, X, X + (size_t)MP * DM, MODL + 5 * 1024, ro, 0}; isg = true; } break;
      case 12: g1 = GemmDesc{H, WB + W1_IN, 1024, 1024, M, 768, 1024, 0, ws + WS_Z1, 768, nullptr, nullptr, nullptr, 0, 0}; isg = true; break;
      case 13: l1_rows_phase(p); break;
      case 14: g1 = GemmDesc{(const bf16_t*)(ws + WS_CQN), WB + W1_QB, 384, 384, M, 1536, 384, 0, ws + WS_Q, 1536, nullptr, nullptr, nullptr, 0, 0}; isg = true; break;
      case 15: g1 = GemmDesc{(const bf16_t*)(ws + WS_CKVN), WB + W1_KVB, 256, 256, KROWS, 2048, 256, 0, ws + WS_KV, 2048, nullptr, nullptr, nullptr, 0, 0}; isg = true; break;
#ifndef NO_ATTN
      case 16: attn_phase(p, dry); break;
#endif
      case 17: g1 = GemmDesc{(const bf16_t*)(ws + WS_Q), WB + W1_OUT, 1536, 1024, M, 1024, 1024, 2, X, 1024, X, X + (size_t)MP * DM, MODL + 2 * 1024, 0, 0}; isg = true; break;
      case 23: final_norm_phase(p, dry); break;
      default: break;
    }
    if (ph == 1 || ph == 6 || ph == 11 || ph == 18) {
      const bool first = ph == 1;
      modulate_phase(p, first ? p->in[0] : X, first ? p->in[1] : X + (size_t)MP * DM, p->in[ph == 1 ? 9 : ph == 6 ? 10 : ph == 11 ? 26 : 27], MODL, (ph == 1 || ph == 11) ? 0 : 3);
    }
    if (ph == 0 || ph == 11) cvt_weights(p, ph == 0 ? 0 : 1, ph == 0 ? (bid + G - 192 % G) % G : bid, G);
#ifndef NO_LRU
    if (ph == 3 || ph == 4) {
      const int nit = ph == 3 ? 3072 + 1536 : 3072;
      const int nit2 = ph == 3 ? 1536 + 1536 : 1536;
      for (int it = bid; it < nit2; it += G) { if (it < 1536) lru_item(p, it >> 2, (it & 3) * 2, ph - 3); else pool_item(p, (it - 1536) >> 2, (it - 1536) & 3); }
    }
#endif
#ifndef NO_GEMM
    g1.dry = (dry && g1.mode == 2 && ph != 5) ? 1 : 0;
    if (isg) gemm_phase(g1);
#endif
    if (coop && ph + 1 < p_hi && ph != 14) {
      if (ph == 0 && !dry) grid.sync(); else { XcdBarrier xb; xb.bar = (unsigned*)(ws + WS_BAR); xb.st = (volatile LAS unsigned*)(dyn_shm + LDS_MAIN); xcd_barrier(xb); } }
#if PROBE_PH >= 0
    if (dry) { rep = 1; --ph; }
#endif
  }
}

#ifndef MK_SPLIT
#define MK_SPLIT 0
#endif
extern "C" void kernel_launch(void* const* d_in, const int* in_sizes, int n_in, void* d_out, int out_size, void* d_ws, size_t ws_size, hipStream_t stream) {
  static int grid = 0;
  if (grid == 0) {
    if (n_in != 37 || ws_size < WS_END) { fprintf(stderr, "kernel_launch: bad n_in %d or ws %zu < %zu\n", n_in, ws_size, (size_t)WS_END); grid = -1; return; }
    int dev = 0, cus = 0, per_cu = 0;
    hipGetDevice(&dev); hipDeviceGetAttribute(&cus, hipDeviceAttributeMultiprocessorCount, dev);
    if (hipFuncSetAttribute((const void*)fwd_megakernel, hipFuncAttributeMaxDynamicSharedMemorySize, LDS_BYTES) != hipSuccess) { fprintf(stderr, "kernel_launch: hipFuncSetAttribute failed\n"); grid = -1; return; }
    if (hipOccupancyMaxActiveBlocksPerMultiprocessor(&per_cu, (const void*)fwd_megakernel, 512, LDS_BYTES) != hipSuccess || per_cu < 1) { fprintf(stderr, "kernel_launch: occupancy query gave %d\n", per_cu); grid = -1; return; }
    grid = cus;
  }
  if (grid < 0) return;
  if (hipMemsetAsync((char*)d_ws + WS_BAR, 0, XCD_BAR_WORDS * 4, stream) != hipSuccess) { fprintf(stderr, "kernel_launch: memset failed\n"); return; }
  Params p{};
  for (int i = 0; i < 37; ++i) p.in[i] = (const float*)d_in[i];
  p.out = (float*)d_out; p.ws = (unsigned char*)d_ws; p.pad = PROBE_PH;
#if MK_SPLIT
  for (int ph = 0; ph < NPH; ++ph) {
    p.p_lo = ph; p.p_hi = ph + 1; p.coop = 0;
    hipLaunchKernelGGL(fwd_megakernel, dim3(grid), dim3(512), LDS_BYTES, stream, p);
  }
#else
  p.p_lo = 0; p.p_hi = NPH; p.coop = 1;
  void* args[] = {&p};
  hipError_t e = hipLaunchCooperativeKernel((const void*)fwd_megakernel, dim3(grid), dim3(512), args, LDS_BYTES, stream);
  if (e != hipSuccess) fprintf(stderr, "cooperative launch failed: %s (grid %d)\n", hipGetErrorString(e), grid);
#endif
}
```
